# Optimizing an MI355X kernel written in HIP

```python
import math
import jax, jax.numpy as jnp
from jax import lax
import numpy as np

D_MODEL = 2048
BATCH = 2
SEQ = 8192
DEPTH = 1

HEAD_DIM = 128
HEADS_PER_GROUP = 4
ATTN_GROUPS = ((128, 1), (512, 4), (2048, 16))
N_ATTN_HEADS = HEADS_PER_GROUP * len(ATTN_GROUPS)
ATTN_OUT_WIDTH = HEADS_PER_GROUP * HEAD_DIM
HQ = N_ATTN_HEADS * HEAD_DIM
SSM_WIDTH = D_MODEL // 2
SSM_GROUP = 16
SSM_GROUPS = SSM_WIDTH // SSM_GROUP
SSM_STATE = 64
D_FF = -(-8 * D_MODEL // (3 * 256)) * 256
IN_SIZES = (HQ, HQ, HQ, SSM_WIDTH, D_MODEL, D_MODEL)
IN_WIDTH = sum(IN_SIZES)
IN_SPLITS = tuple(int(i) for i in np.cumsum(IN_SIZES)[:-1])
EPS = 1e-6
DT_MIN = 1e-3
DT_MAX = 1e-1

kernel_name = 'hybrid_dilated_attn_s5_gated'


def rms_norm(x, gain):
    xf = x.astype(jnp.float32)
    y = xf * lax.rsqrt(jnp.mean(xf * xf, axis=-1, keepdims=True) + EPS)
    return (y * gain.astype(jnp.float32)).astype(x.dtype)


def alibi_slopes(n):
    return jnp.exp2(-8.0 * jnp.arange(1, n + 1, dtype=jnp.float32) / n)


def dilated_window_attention(q, k, v, slopes, window, dilation):
    b, s, h, e = q.shape
    blk = window // dilation
    sub_len = -(-s // dilation)
    n_blk = -(-sub_len // blk)
    s_pad = n_blk * blk * dilation

    def to_blocks(t):
        t = jnp.pad(t, ((0, 0), (0, s_pad - s), (0, 0), (0, 0)))
        t = t.reshape(b, n_blk * blk, dilation, h, e).transpose(0, 2, 1, 3, 4)
        return t.reshape(b, dilation, n_blk, blk, h, e)

    def with_prev(t):
        prev = jnp.pad(t, ((0, 0), (0, 0), (1, 0), (0, 0), (0, 0), (0, 0)))[:, :, :-1]
        return jnp.concatenate([prev, t], axis=3)

    def from_blocks(t):
        f = t.shape[-1]
        t = t.reshape(b, dilation, n_blk * blk, h, f).transpose(0, 2, 1, 3, 4)
        return t.reshape(b, s_pad, h, f)[:, :s]

    qb = to_blocks(q)
    kw = with_prev(to_blocks(k))
    vw = with_prev(to_blocks(v))
    scores = jnp.einsum('brnqhe,brnkhe->brnhqk', qb, kw).astype(jnp.float32) * (e ** -0.5)
    qi = jnp.arange(blk)[:, None]
    ki = jnp.arange(2 * blk)[None, :]
    dist = blk + qi - ki
    blk_idx = jnp.arange(n_blk)[:, None, None]
    valid = ((dist >= 0) & (dist <= blk))[None] & (blk_idx * blk - blk + ki[None] >= 0)
    bias = -slopes[:, None, None] * (dist * dilation).astype(jnp.float32)[None]
    scores = scores + bias[None, None, None]
    scores = jnp.where(valid[None, None, :, None], scores, -jnp.inf)
    lse = jax.nn.logsumexp(scores, axis=-1)
    probs = jnp.exp(scores - lse[..., None])
    out = jnp.einsum('brnhqk,brnkhe->brnqhe', probs.astype(v.dtype), vw)
    lse = from_blocks(lse.transpose(0, 1, 2, 4, 3)[..., None])[..., 0]
    return from_blocks(out), lse


def s5_ssm(u, a_re, a_im, log_dt, b_re, b_im, c_re, c_im, d_skip):
    bsz, s, _ = u.shape
    uf = u.astype(jnp.float32)
    ug = uf.reshape(bsz, s, SSM_GROUPS, SSM_GROUP)
    lam = lax.complex(a_re.astype(jnp.float32), a_im.astype(jnp.float32))
    dt = jnp.exp(log_dt.astype(jnp.float32))[:, None]
    lam_bar = jnp.exp(lam * dt)
    b_cplx = lax.complex(b_re.astype(jnp.float32), b_im.astype(jnp.float32))
    b_bar = ((lam_bar - 1.0) / lam)[..., None] * b_cplx
    bu = lax.complex(jnp.einsum('bsgc,gpc->sbgp', ug, jnp.real(b_bar)),
                     jnp.einsum('bsgc,gpc->sbgp', ug, jnp.imag(b_bar)))
    a_seq = jnp.broadcast_to(lam_bar[None, None], (s, 1) + lam_bar.shape)

    def combine(left, right):
        a_l, b_l = left
        a_r, b_r = right
        return a_r * a_l, a_r * b_l + b_r

    _, states = lax.associative_scan(combine, (a_seq, bu), axis=0)
    y = (jnp.einsum('sbgp,gcp->bsgc', jnp.real(states), c_re.astype(jnp.float32))
         - jnp.einsum('sbgp,gcp->bsgc', jnp.imag(states), c_im.astype(jnp.float32)))
    y = y.reshape(bsz, s, SSM_WIDTH) + d_skip.astype(jnp.float32) * uf
    return y.astype(u.dtype)


def hybrid_layer(x, norm_mix_pre, w_in, w_attn_up, ssm_a_re, ssm_a_im, ssm_log_dt, ssm_b_re, ssm_b_im,
                 ssm_c_re, ssm_c_im, ssm_d, w_glu_v, w_glu_g, w_out, norm_mix_post, norm_ffn_pre,
                 w_ffn_gate, w_ffn_up, w_ffn_down, norm_ffn_post):
    bsz, s, _ = x.shape
    h = rms_norm(x, norm_mix_pre)
    q, k, v, u, gate_a, gate_s = jnp.split(h @ w_in, IN_SPLITS, axis=-1)
    q = q.reshape(bsz, s, N_ATTN_HEADS, HEAD_DIM)
    k = k.reshape(bsz, s, N_ATTN_HEADS, HEAD_DIM)
    v = v.reshape(bsz, s, N_ATTN_HEADS, HEAD_DIM)
    slopes = alibi_slopes(N_ATTN_HEADS)
    outs, lses = [], []
    for g, (window, dilation) in enumerate(ATTN_GROUPS):
        hs = slice(g * HEADS_PER_GROUP, (g + 1) * HEADS_PER_GROUP)
        o, l = dilated_window_attention(q[:, :, hs], k[:, :, hs], v[:, :, hs], slopes[hs], window, dilation)
        outs.append(o)
        lses.append(l)
    mix_w = jax.nn.softmax(jnp.stack(lses), axis=0)
    attn = jnp.sum(mix_w[..., None] * jnp.stack(outs).astype(jnp.float32), axis=0)
    attn_branch = attn.reshape(bsz, s, ATTN_OUT_WIDTH).astype(x.dtype) @ w_attn_up
    y = jax.nn.gelu(s5_ssm(u, ssm_a_re, ssm_a_im, ssm_log_dt, ssm_b_re, ssm_b_im, ssm_c_re, ssm_c_im, ssm_d))
    ssm_branch = (y @ w_glu_v) * jax.nn.sigmoid(y @ w_glu_g)
    merged = jax.nn.sigmoid(gate_a) * attn_branch + jax.nn.sigmoid(gate_s) * ssm_branch
    x = x + rms_norm(merged @ w_out, norm_mix_post)
    h = rms_norm(x, norm_ffn_pre)
    f = (jax.nn.silu(h @ w_ffn_gate) * (h @ w_ffn_up)) @ w_ffn_down
    return x + rms_norm(f, norm_ffn_post)


def setup_inputs(seed: int = 0) -> dict:
    key = jax.random.key(seed)
    ks = jax.random.split(key, 24)

    def nrm(k, shape, scale):
        return jax.random.normal(k, shape, jnp.float32) * scale

    def gain(k, n):
        return 1.0 + 0.02 * jax.random.normal(k, (DEPTH, n), jnp.float32)

    g, p, c = SSM_GROUPS, SSM_STATE, SSM_GROUP
    return {
        'x': nrm(ks[0], (BATCH, SEQ, D_MODEL), 1.0),
        'norm_mix_pre': gain(ks[1], D_MODEL),
        'w_in': nrm(ks[2], (DEPTH, D_MODEL, IN_WIDTH), D_MODEL ** -0.5),
        'w_attn_up': nrm(ks[3], (DEPTH, ATTN_OUT_WIDTH, D_MODEL), ATTN_OUT_WIDTH ** -0.5),
        'ssm_a_re': -0.5 + 0.01 * jax.random.normal(ks[4], (DEPTH, g, p), jnp.float32),
        'ssm_a_im': jnp.pi * jnp.arange(p, dtype=jnp.float32)[None, None, :] + 0.01 * jax.random.normal(ks[5], (DEPTH, g, p), jnp.float32),
        'ssm_log_dt': jax.random.uniform(ks[6], (DEPTH, g), jnp.float32, math.log(DT_MIN), math.log(DT_MAX)),
        'ssm_b_re': nrm(ks[7], (DEPTH, g, p, c), (2 * c) ** -0.5),
        'ssm_b_im': nrm(ks[8], (DEPTH, g, p, c), (2 * c) ** -0.5),
        'ssm_c_re': nrm(ks[9], (DEPTH, g, c, p), (2 * p) ** -0.5 * 4.0),
        'ssm_c_im': nrm(ks[10], (DEPTH, g, c, p), (2 * p) ** -0.5 * 4.0),
        'ssm_d': nrm(ks[11], (DEPTH, SSM_WIDTH), 1.0),
        'w_glu_v': nrm(ks[12], (DEPTH, SSM_WIDTH, D_MODEL), SSM_WIDTH ** -0.5),
        'w_glu_g': nrm(ks[13], (DEPTH, SSM_WIDTH, D_MODEL), SSM_WIDTH ** -0.5),
        'w_out': nrm(ks[14], (DEPTH, D_MODEL, D_MODEL), D_MODEL ** -0.5),
        'norm_mix_post': gain(ks[15], D_MODEL),
        'norm_ffn_pre': gain(ks[16], D_MODEL),
        'w_ffn_gate': nrm(ks[17], (DEPTH, D_MODEL, D_FF), D_MODEL ** -0.5),
        'w_ffn_up': nrm(ks[18], (DEPTH, D_MODEL, D_FF), D_MODEL ** -0.5),
        'w_ffn_down': nrm(ks[19], (DEPTH, D_FF, D_MODEL), D_FF ** -0.5),
        'norm_ffn_post': gain(ks[20], D_MODEL),
    }


def reference(x, norm_mix_pre, w_in, w_attn_up, ssm_a_re, ssm_a_im, ssm_log_dt, ssm_b_re, ssm_b_im,
              ssm_c_re, ssm_c_im, ssm_d, w_glu_v, w_glu_g, w_out, norm_mix_post, norm_ffn_pre,
              w_ffn_gate, w_ffn_up, w_ffn_down, norm_ffn_post):
    for i in range(DEPTH):
        x = hybrid_layer(x, norm_mix_pre[i], w_in[i], w_attn_up[i], ssm_a_re[i], ssm_a_im[i], ssm_log_dt[i],
                         ssm_b_re[i], ssm_b_im[i], ssm_c_re[i], ssm_c_im[i], ssm_d[i], w_glu_v[i], w_glu_g[i],
                         w_out[i], norm_mix_post[i], norm_ffn_pre[i], w_ffn_gate[i], w_ffn_up[i],
                         w_ffn_down[i], norm_ffn_post[i])
    return x
```

```cpp
#include <hip/hip_runtime.h>
#include <hip/hip_cooperative_groups.h>
#include <cstdio>
#include <cstdint>
namespace cg = cooperative_groups;
namespace pg8 {
#define PG8_LAS __attribute__((address_space(3)))
typedef unsigned short bf16_t;
typedef short bf16x8 __attribute__((ext_vector_type(8)));
typedef float f32x4 __attribute__((ext_vector_type(4)));
typedef unsigned u32x4 __attribute__((ext_vector_type(4)));
constexpr int BM = 256, BK = 64, HALF = 128, HTB = HALF * BK * 2  , STAGE_BYTES = 8 * HTB, NXCD = 8, WGM = 8;

__host__ __device__ __forceinline__ int lds_byte(int r, int c) { const int st = (r >> 4) * 2 + (c >> 5), rr = r & 15, cc = c & 31, ob = rr * 64 + cc * 2; return st * 1024 + (ob ^ (((ob >> 9) & 1) << 5)); }
__host__ __device__ __forceinline__ void stage_rc(int b, int& R, int& C) { const int st = b / 1024, sb = b % 1024, swz = sb ^ (((sb >> 9) & 1) << 5); R = (st >> 1) * 16 + swz / 64; C = (st & 1) * 32 + (swz % 64) / 2; }
__host__ __device__ __forceinline__ int perm32(int rho) { const int n = rho >> 4, i = rho & 15; return 8 * (i >> 2) + 4 * n + (i & 3); }

struct Unit { int pm, pn; };
struct Gemm { const bf16_t* A; const bf16_t* Bt; int M, N, K, lda, ldb; };

struct StaticOrder {
    int nM, nN, nwg, G, c, rep;
    __host__ __device__ void init(int M, int N, int G_, int c_, int rep_ = 1) { nM = M / BM; nN = N / BM; nwg = nM * nN; G = G_; c = c_; rep = rep_; }
    __host__ __device__ bool next(int i, Unit& u) const {
        const long L = (long)i * G + c; if (L >= (long)nwg * rep) return false;
        int wgid = (int)(L % nwg); { const int q = nwg / NXCD, r = nwg % NXCD, xcd = wgid % NXCD, off = wgid / NXCD; wgid = (xcd < r ? xcd * (q + 1) : r * (q + 1) + (xcd - r) * q) + off; }
        const int nig = WGM * nN, gid = wgid / nig, fm = gid * WGM, gsz = (nM - fm) < WGM ? (nM - fm) : WGM;
        u.pm = fm + ((wgid % nig) % gsz); u.pn = (wgid % nig) / gsz; return true;
    }
    __device__ __forceinline__ void a_ready(const Unit&) const {}
    __device__ __forceinline__ void done(const Unit&) const {}
};

__device__ __forceinline__ unsigned cvt_pk_bf16(float lo, float hi) { unsigned r; asm volatile("v_cvt_pk_bf16_f32 %0, %1, %2" : "=v"(r) : "v"(lo), "v"(hi)); return r; }
typedef float f32x2 __attribute__((ext_vector_type(2)));
template <class Epi, class Sched, bool ALIGN_EPI = false, bool SP2 = false>
__device__ __forceinline__ void gemm_phase(PG8_LAS unsigned char* lds, const Gemm g, const Sched& S, const Epi& E) {
    int tid_ = threadIdx.x; asm volatile("" : "+v"(tid_));
    const int tid = tid_, wid = __builtin_amdgcn_readfirstlane(tid >> 6), lane = tid & 63, wr = wid >> 2, wc = wid & 3, fr = lane & 15, fq = lane >> 4;
    const int K = g.K, nt = K / BK;
    unsigned voffA[2], voffB[2];
#pragma unroll
    for (int i = 0; i < 2; ++i) { int R, C; stage_rc(tid * 16 + i * 8192, R, C); const int Rb = Epi::PERM ? ((R & ~31) + perm32(R & 31)) : R;
        voffA[i] = (unsigned)(R * g.lda + C) * 2u; voffB[i] = (unsigned)(Rb * g.ldb + C) * 2u; }
    const size_t kstep = (size_t)(BK * 2);
    const size_t hstepA = (size_t)HALF * g.lda * 2, hstepB = (size_t)HALF * g.ldb * 2;
    const size_t tstepA = 2 * hstepA, tstepB = 2 * hstepB;
    const unsigned ldsw = (unsigned)wid * 1024u;
    const int aoff = lds_byte(wr * 64 + fr, fq * 8), boff = lds_byte(wc * 32 + fr, fq * 8);
#define PG8_SA(b, h) (((b) * 2 + (h)) * HTB)
#define PG8_SB(b, h) ((4 + (b) * 2 + (h)) * HTB)
#define PG8_STAGE(bufoff, gbase, voff) do { _Pragma("unroll") for (int _i = 0; _i < 2; ++_i) \
        __builtin_amdgcn_global_load_lds((const unsigned*)((const char*)(gbase) + (voff)[_i]), (PG8_LAS unsigned*)(lds + (bufoff) + ldsw + _i * 8192), 16, 0, 0); } while (0)
#define PG8_LDA(dst, b, h) do { _Pragma("unroll") for (int m = 0; m < 4; ++m) _Pragma("unroll") for (int k = 0; k < 2; ++k) dst[m][k] = *(const PG8_LAS bf16x8*)(lds + PG8_SA(b, h) + aoff + m * 2048 + k * 1024); } while (0)
#define PG8_LDB(dst, b, h) do { _Pragma("unroll") for (int n = 0; n < 2; ++n) _Pragma("unroll") for (int k = 0; k < 2; ++k) dst[n][k] = *(const PG8_LAS bf16x8*)(lds + PG8_SB(b, h) + boff + n * 2048 + k * 1024); } while (0)
#define PG8_MMA(ai, bj, At, Bt) do { __builtin_amdgcn_s_setprio(1); _Pragma("unroll") for (int m = 0; m < 4; ++m) _Pragma("unroll") for (int n = 0; n < 2; ++n) _Pragma("unroll") for (int k = 0; k < 2; ++k) \
        acc[ai][bj][m][n] = __builtin_amdgcn_mfma_f32_16x16x32_bf16(Bt[n][k], At[m][k], acc[ai][bj][m][n], 0, 0, 0); __builtin_amdgcn_s_setprio(0); } while (0)
#define PG8_WAIT_V(n) asm volatile("s_waitcnt vmcnt(" #n ")" ::: "memory")
#define PG8_WAIT_L(n) asm volatile("s_waitcnt lgkmcnt(" #n ")" ::: "memory")
#define PG8_BAR __builtin_amdgcn_s_barrier()
#define PG8_SCHED __builtin_amdgcn_sched_barrier(0)
    Unit cur, nxt; int ui = 0;
    if (!S.next(0, cur)) return;
    f32x4 acc[2][2][4][2];
#pragma unroll
    for (int a = 0; a < 2; ++a)
#pragma unroll
        for (int b = 0; b < 2; ++b)
#pragma unroll
            for (int m = 0; m < 4; ++m)
#pragma unroll
                for (int n = 0; n < 2; ++n) acc[a][b][m][n] = (f32x4){0.f, 0.f, 0.f, 0.f};
    bf16x8 At[4][2], B0[2][2], B1[2][2];
    const char* cA = (const char*)g.A + (size_t)cur.pm * tstepA; const char* cB = (const char*)g.Bt + (size_t)cur.pn * tstepB;
    S.a_ready(cur);
    if constexpr (SP2) {
        PG8_STAGE(PG8_SB(0, 0), cB, voffB); PG8_STAGE(PG8_SB(0, 1), cB + hstepB, voffB); PG8_STAGE(PG8_SA(0, 0), cA, voffA); PG8_STAGE(PG8_SA(0, 1), cA + hstepA, voffA);
        if (wr == 1) PG8_BAR;
        PG8_WAIT_V(2); PG8_BAR;
        PG8_STAGE(PG8_SB(1, 0), cB + kstep, voffB); PG8_STAGE(PG8_SA(1, 0), cA + kstep, voffA); PG8_STAGE(PG8_SB(1, 1), cB + hstepB + kstep, voffB);
        PG8_WAIT_V(6); PG8_BAR;
    } else {
        PG8_STAGE(PG8_SB(0, 0), cB, voffB); PG8_STAGE(PG8_SA(0, 0), cA, voffA); PG8_STAGE(PG8_SB(0, 1), cB + hstepB, voffB); PG8_STAGE(PG8_SA(0, 1), cA + hstepA, voffA);
        if (wr == 1) PG8_BAR;
        PG8_WAIT_V(4); PG8_BAR;
        PG8_STAGE(PG8_SB(1, 0), cB + kstep, voffB); PG8_STAGE(PG8_SA(1, 0), cA + kstep, voffA); PG8_STAGE(PG8_SB(1, 1), cB + hstepB + kstep, voffB);
        PG8_WAIT_V(6); PG8_BAR;
    }
    for (;;) {
        const bool has_next = S.next(ui + 1, nxt);
        const char* nA = has_next ? (const char*)g.A + (size_t)nxt.pm * tstepA : cA; const char* nB = has_next ? (const char*)g.Bt + (size_t)nxt.pn * tstepB : cB;
        for (int t = 0; t < nt; t += 2) {
            const bool last = (t == nt - 2);
            const char* a1 = cA + (size_t)(t + 1) * kstep;
            const char* a2 = last ? nA : cA + (size_t)(t + 2) * kstep; const char* b2 = last ? nB : cB + (size_t)(t + 2) * kstep;
            const char* a3 = a2 + kstep; const char* b3 = b2 + kstep;
            if (last && has_next) S.a_ready(nxt);
            if constexpr (SP2) {
            PG8_LDB(B0, 0, 0); PG8_LDB(B1, 0, 1); PG8_SCHED; PG8_LDA(At, 0, 0); PG8_STAGE(PG8_SA(1, 1), a1 + hstepA, voffA);
            PG8_WAIT_V(8); PG8_WAIT_L(0); PG8_BAR; PG8_MMA(0, 0, At, B0); PG8_MMA(0, 1, At, B1); PG8_BAR; PG8_SCHED;
            PG8_LDA(At, 0, 1); PG8_STAGE(PG8_SB(0, 0), b2, voffB); PG8_STAGE(PG8_SB(0, 1), b2 + hstepB, voffB); PG8_STAGE(PG8_SA(0, 0), a2, voffA);
            PG8_WAIT_V(8); PG8_WAIT_L(0); PG8_BAR; PG8_MMA(1, 0, At, B0); PG8_MMA(1, 1, At, B1); PG8_BAR; PG8_SCHED;
            PG8_LDB(B0, 1, 0); PG8_LDB(B1, 1, 1); PG8_SCHED; PG8_LDA(At, 1, 0); PG8_STAGE(PG8_SA(0, 1), a2 + hstepA, voffA);
            PG8_WAIT_V(8); PG8_WAIT_L(0); PG8_BAR; PG8_MMA(0, 0, At, B0); PG8_MMA(0, 1, At, B1); PG8_BAR; PG8_SCHED;
            PG8_LDA(At, 1, 1); PG8_STAGE(PG8_SB(1, 0), b3, voffB); PG8_STAGE(PG8_SB(1, 1), b3 + hstepB, voffB); PG8_STAGE(PG8_SA(1, 0), a3, voffA);
            PG8_WAIT_V(8); PG8_WAIT_L(0); PG8_BAR; PG8_MMA(1, 0, At, B0); PG8_MMA(1, 1, At, B1); PG8_BAR; PG8_SCHED;
            } else {
            PG8_LDB(B0, 0, 0); PG8_SCHED; PG8_LDA(At, 0, 0); PG8_STAGE(PG8_SA(1, 1), a1 + hstepA, voffA);
            PG8_WAIT_L(8); PG8_BAR; PG8_WAIT_L(0); PG8_MMA(0, 0, At, B0); PG8_BAR; PG8_SCHED;
            PG8_LDB(B1, 0, 1); PG8_STAGE(PG8_SB(0, 0), b2, voffB);
            PG8_BAR; PG8_WAIT_L(0); PG8_MMA(0, 1, At, B1); PG8_BAR;
            PG8_LDA(At, 0, 1); PG8_STAGE(PG8_SA(0, 0), a2, voffA);
            PG8_BAR; PG8_WAIT_L(0); PG8_MMA(1, 0, At, B0); PG8_BAR; PG8_SCHED;
            PG8_STAGE(PG8_SB(0, 1), b2 + hstepB, voffB);
            PG8_WAIT_V(6); PG8_BAR; PG8_MMA(1, 1, At, B1); PG8_BAR;
            PG8_LDB(B0, 1, 0); PG8_SCHED; PG8_LDA(At, 1, 0); PG8_STAGE(PG8_SA(0, 1), a2 + hstepA, voffA);
            PG8_WAIT_L(8); PG8_BAR; PG8_WAIT_L(0); PG8_MMA(0, 0, At, B0); PG8_BAR; PG8_SCHED;
            PG8_LDB(B1, 1, 1); PG8_STAGE(PG8_SB(1, 0), b3, voffB);
            PG8_BAR; PG8_WAIT_L(0); PG8_MMA(0, 1, At, B1); PG8_BAR;
            PG8_LDA(At, 1, 1); PG8_STAGE(PG8_SA(1, 0), a3, voffA);
            PG8_BAR; PG8_WAIT_L(0); PG8_MMA(1, 0, At, B0); PG8_BAR; PG8_SCHED;
            PG8_STAGE(PG8_SB(1, 1), b3 + hstepB, voffB);
            PG8_WAIT_V(6); PG8_BAR; PG8_MMA(1, 1, At, B1); PG8_BAR;
            }
        }
        if constexpr (ALIGN_EPI) { if (wr == 0) PG8_BAR; }
        if constexpr (!Epi::AFTER_DRAIN) { E(acc, cur, wr, wc, fr, fq); S.done(cur); }
        if (!has_next) break;
#pragma unroll
        for (int a = 0; a < 2; ++a)
#pragma unroll
            for (int b = 0; b < 2; ++b)
#pragma unroll
                for (int m = 0; m < 4; ++m)
#pragma unroll
                    for (int n = 0; n < 2; ++n) acc[a][b][m][n] = (f32x4){0.f, 0.f, 0.f, 0.f};
        cur = nxt; cA = nA; cB = nB; ++ui;
        if constexpr (ALIGN_EPI) { if (wr == 1) PG8_BAR; }
    }
    PG8_WAIT_V(0);
    if constexpr (!ALIGN_EPI) { if (wr == 0) PG8_BAR; }
    PG8_BAR;
    if constexpr (Epi::AFTER_DRAIN) { E.fused(acc, cur, wr, wc, fr, fq, lds, wid, lane); S.done(cur); }
#undef PG8_SA
#undef PG8_SB
#undef PG8_STAGE
#undef PG8_LDA
#undef PG8_LDB
#undef PG8_MMA
#undef PG8_WAIT_V
#undef PG8_WAIT_L
#undef PG8_BAR
#undef PG8_SCHED
}
}
#ifndef PG8_SP2
#define PG8_SP2 true
#endif
#ifndef PG8_ALIGN
#define PG8_ALIGN true
#endif

constexpr int BATCH = 2, SEQ = 8192, DM = 2048, T = BATCH * SEQ;
constexpr int HD = 128, NH = 12, HQ = 1536, SSMW = 1024, NG = 64, NP = 64, NC = 16;
constexpr int DFF = 5632, INW = 9728, QKVU = 5632, NGATE = INW - QKVU, AOW = 512;
constexpr int CL = 16, NCHUNK = SEQ / CL;
constexpr int A3W = CL * NC + 2 * NP;
constexpr float EPS = 1e-6f, LOG2E = 1.4426950408889634f;
constexpr int NWAVES = 8, NTHR = 512;
constexpr int PADE = 64;
constexpr int LDH = DM + PADE, LDQ = 3 * HQ + PADE, LDACT = DFF + PADE, LDATT = AOW + PADE, LDY = SSMW + PADE;

constexpr size_t WS_ROWSS1 = 196608, WS_ROWSS2 = 262144, WS_PCNT1 = 327680, WS_PCNT2 = 344064;
constexpr size_t WS_ROWSS = 65536, WS_PCNT = 131072;
constexpr size_t WS_BAR = 4096, WS_BAR_BYTES = 16384;
constexpr size_t WS_WFFN = 1u << 20;
constexpr size_t WS_WDOWN = WS_WFFN + (size_t)2 * DFF * LDH * 2;
constexpr size_t WS_WOUT = WS_WDOWN + (size_t)DM * LDACT * 2;
constexpr size_t WS_WIN = WS_WOUT + (size_t)DM * LDH * 2;
constexpr size_t WS_WUP = WS_WIN + (size_t)INW * LDH * 2;
constexpr size_t WS_WGLU = WS_WUP + (size_t)DM * LDATT * 2;
constexpr size_t WS_A3 = WS_WGLU + (size_t)2 * DM * LDY * 2;
constexpr size_t WS_WT = WS_A3 + (size_t)NG * 256 * A3W * 2;
constexpr size_t WS_LAML = WS_WT + (size_t)NG * 128 * 256 * 2;
constexpr size_t WS_X1B = WS_WIN;
static_assert(WS_X1B + (size_t)T * DM * 2 <= WS_LAML, "x1 overlay fits in the dead weight/table region");
constexpr size_t WS_RA = WS_LAML + 65536;
constexpr size_t WS_UB = WS_RA + (size_t)T * LDQ * 2;
constexpr size_t WS_RH = WS_RA + (size_t)T * LDACT * 2;
static_assert(WS_UB + (size_t)T * SSMW * 2 <= WS_RH, "u buffer fits behind qkv");
constexpr size_t WS_ATTN = WS_RH, WS_Y = WS_RH + (size_t)T * LDATT * 2;
static_assert(WS_Y + (size_t)T * LDY * 2 <= WS_RH + (size_t)T * LDH * 2, "attn + y fit in the h region");
constexpr size_t WS_RF = WS_RH + (size_t)T * LDH * 2;
constexpr size_t WS_OPART = WS_RF, WS_LSE = WS_OPART + (size_t)T * NH * HD * 2, WS_E = WS_LSE + (size_t)T * NH * 4;
constexpr size_t WS_HB = WS_E + (size_t)BATCH * NCHUNK * NG * 128 * 4, WS_END = WS_HB + (size_t)BATCH * NCHUNK * NG * 128 * 2;
static_assert(WS_END <= 536870912ull, "d_ws map exceeds 512 MiB");
static_assert(WS_RF + (size_t)T * LDH * 2 <= WS_END, "ms/f fit in the partials region");

constexpr int RING_BYTES = 131072, LDS_BYTES = 147456;

#define GAS __attribute__((address_space(1)))
#define LAS __attribute__((address_space(3)))
typedef unsigned short bf16;
typedef unsigned v4u __attribute__((ext_vector_type(4)));
typedef unsigned v2u __attribute__((ext_vector_type(2)));
typedef float f32x4 __attribute__((ext_vector_type(4)));
typedef float f32x16 __attribute__((ext_vector_type(16)));
typedef short bf16x8 __attribute__((ext_vector_type(8)));
typedef short v4i16_t __attribute__((ext_vector_type(4)));
typedef float f32x2_t __attribute__((ext_vector_type(2)));
typedef __bf16 bf16x2_t __attribute__((ext_vector_type(2)));

__device__ __forceinline__ unsigned pk2(float lo, float hi) { f32x2_t v = {lo, hi}; bf16x2_t b = __builtin_convertvector(v, bf16x2_t); return __builtin_bit_cast(unsigned, b); }
__device__ __forceinline__ float bflo(unsigned w) { return __uint_as_float(w << 16); }
__device__ __forceinline__ float bfhi(unsigned w) { return __uint_as_float(w & 0xffff0000u); }
__device__ __forceinline__ float sigmoidf_(float x) { return __builtin_amdgcn_rcpf(1.0f + __expf(-x)); }
__device__ __forceinline__ float gelu_tanh(float x) { const float z = 0.7978845608028654f * (x + 0.044715f * x * x * x); const float e = __expf(2.0f * z); return 0.5f * x * (2.0f - 2.0f * __builtin_amdgcn_rcpf(1.0f + e)); }
__device__ __forceinline__ float wave_sum(float v) {
#pragma unroll
    for (int o = 1; o < 64; o <<= 1) v += __shfl_xor(v, o);
    return v;
}
__device__ __forceinline__ int crow(int reg, int h) { return (reg & 3) + 8 * (reg >> 2) + 4 * h; }
#define MFMA32(a, b, c) __builtin_amdgcn_mfma_f32_32x32x16_bf16((a), (b), (c), 0, 0, 0)

namespace pg8 {
__device__ __forceinline__ u32x4 pack8(const f32x4 v0, const f32x4 v1) { u32x4 w; w.x = pk2(v0[0], v0[1]); w.y = pk2(v0[2], v0[3]); w.z = pk2(v1[0], v1[1]); w.w = pk2(v1[2], v1[3]); return w; }
__device__ __forceinline__ void unpack8(const u32x4 w, f32x4& v0, f32x4& v1) { v0 = (f32x4){bflo(w.x), bfhi(w.x), bflo(w.y), bfhi(w.y)}; v1 = (f32x4){bflo(w.z), bfhi(w.z), bflo(w.w), bfhi(w.w)}; }
__device__ __forceinline__ size_t gaddr(size_t row, int col) { return ((row >> 4) * (size_t)(NGATE / 8) + (size_t)(col >> 3)) * 128 + (row & 15) * 8; }
__device__ __forceinline__ f32x4 sig4(const f32x4 v) { return (f32x4){sigmoidf_(v[0]), sigmoidf_(v[1]), sigmoidf_(v[2]), sigmoidf_(v[3])}; }

struct EpiPlain {
    static constexpr bool PERM = true, AFTER_DRAIN = false;
    bf16_t* O; int ldc;
    __device__ __forceinline__ void operator()(const f32x4 (&acc)[2][2][4][2], const Unit& u, int wr, int wc, int fr, int fq) const {
        const int row0 = u.pm * BM + wr * 64 + fr, col0 = u.pn * BM + wc * 32 + 8 * fq;
#pragma unroll
        for (int ai = 0; ai < 2; ++ai)
#pragma unroll
            for (int m = 0; m < 4; ++m) { bf16_t* rowp = O + (size_t)(row0 + ai * HALF + m * 16) * ldc + col0;
#pragma unroll
                for (int bj = 0; bj < 2; ++bj) __builtin_nontemporal_store(pack8(acc[ai][bj][m][0], acc[ai][bj][m][1]), (u32x4*)(rowp + bj * HALF)); }
    }
};
struct EpiIn {
    static constexpr bool PERM = true, AFTER_DRAIN = false;
    bf16_t* qkv; bf16_t* ubuf; bf16_t* gates;
    __device__ __forceinline__ void operator()(const f32x4 (&acc)[2][2][4][2], const Unit& u, int wr, int wc, int fr, int fq) const {
        const int row0 = u.pm * BM + wr * 64 + fr; const int colt = u.pn * BM;
        if (colt < 3 * HQ) {
            const int col0 = colt + wc * 32 + 8 * fq;
#pragma unroll
            for (int ai = 0; ai < 2; ++ai)
#pragma unroll
                for (int m = 0; m < 4; ++m) { bf16_t* rowp = qkv + (size_t)(row0 + ai * HALF + m * 16) * LDQ + col0;
#pragma unroll
                    for (int bj = 0; bj < 2; ++bj) __builtin_nontemporal_store(pack8(acc[ai][bj][m][0], acc[ai][bj][m][1]), (u32x4*)(rowp + bj * HALF)); }
        } else if (colt < QKVU) {
            const int uc0 = colt - 3 * HQ + wc * 32 + 8 * fq;
#pragma unroll
            for (int ai = 0; ai < 2; ++ai)
#pragma unroll
                for (int m = 0; m < 4; ++m) { const int row = row0 + ai * HALF + m * 16, b = row / SEQ, t = row % SEQ;
#pragma unroll
                    for (int bj = 0; bj < 2; ++bj) { const int uc = uc0 + bj * HALF;
                        __builtin_nontemporal_store(pack8(acc[ai][bj][m][0], acc[ai][bj][m][1]), (u32x4*)(ubuf + (((((size_t)(b * NG + (uc >> 4))) * 16 + (t >> 9)) * 16 + (t & 15)) * 32 + ((t >> 4) & 31)) * NC + (uc & 15))); } }
        } else {
            const int col0 = colt - QKVU + wc * 32 + 8 * fq;
#pragma unroll
            for (int ai = 0; ai < 2; ++ai)
#pragma unroll
                for (int m = 0; m < 4; ++m) { const size_t row = (size_t)(row0 + ai * HALF + m * 16);
#pragma unroll
                    for (int bj = 0; bj < 2; ++bj) __builtin_nontemporal_store(pack8(sig4(acc[ai][bj][m][0]), sig4(acc[ai][bj][m][1])), (u32x4*)(gates + gaddr(row, col0 + bj * HALF))); }
        }
    }
};
struct EpiGlu {
    static constexpr bool PERM = true, AFTER_DRAIN = false;
    const bf16_t* gates; bf16_t* ms;
    __device__ __forceinline__ void operator()(const f32x4 (&acc)[2][2][4][2], const Unit& u, int wr, int wc, int fr, int fq) const {
        const int row0 = u.pm * BM + wr * 64 + fr, col0 = u.pn * HALF + wc * 32 + 8 * fq;
#pragma unroll
        for (int ai = 0; ai < 2; ++ai)
#pragma unroll
            for (int m = 0; m < 4; ++m) { const size_t row = (size_t)(row0 + ai * HALF + m * 16);
                f32x4 g0, g1; unpack8(*(const u32x4*)(gates + gaddr(row, DM + col0)), g0, g1);
                const f32x4 v0 = acc[ai][0][m][0] * sig4(acc[ai][1][m][0]) * g0, v1 = acc[ai][0][m][1] * sig4(acc[ai][1][m][1]) * g1;
                __builtin_nontemporal_store(pack8(v0, v1), (u32x4*)(ms + row * LDH + col0)); }
    }
};
struct EpiMerge {
    static constexpr bool PERM = true, AFTER_DRAIN = false;
    const bf16_t* gates; bf16_t* ms;
    __device__ __forceinline__ void operator()(const f32x4 (&acc)[2][2][4][2], const Unit& u, int wr, int wc, int fr, int fq) const {
        const int row0 = u.pm * BM + wr * 64 + fr, col0 = u.pn * BM + wc * 32 + 8 * fq;
#pragma unroll
        for (int ai = 0; ai < 2; ++ai)
#pragma unroll
            for (int m = 0; m < 4; ++m) { const size_t row = (size_t)(row0 + ai * HALF + m * 16);
#pragma unroll
                for (int bj = 0; bj < 2; ++bj) { const int col = col0 + bj * HALF;
                    f32x4 g0, g1, s0, s1; unpack8(*(const u32x4*)(gates + gaddr(row, col)), g0, g1); unpack8(*(const u32x4*)(ms + row * LDH + col), s0, s1);
                    __builtin_nontemporal_store(pack8(g0 * acc[ai][bj][m][0] + s0, g1 * acc[ai][bj][m][1] + s1), (u32x4*)(ms + row * LDH + col)); } }
    }
};
struct EpiFfn {
    static constexpr bool PERM = true, AFTER_DRAIN = false, REMAP = false;
    bf16_t* act; const float* rowss;
    __device__ __forceinline__ void operator()(const f32x4 (&acc)[2][2][4][2], const Unit& u, int wr, int wc, int fr, int fq) const {
        const int row0 = u.pm * BM + wr * 64 + fr, col0 = u.pn * HALF + wc * 32 + 8 * fq;
#pragma unroll
        for (int ai = 0; ai < 2; ++ai)
#pragma unroll
            for (int m = 0; m < 4; ++m) { const size_t row = (size_t)(row0 + ai * HALF + m * 16);
                const float r = rsqrtf(rowss[row] * (1.f / DM) + EPS);
                const f32x4 a0 = acc[ai][0][m][0] * r, a1 = acc[ai][0][m][1] * r;
                __builtin_nontemporal_store(pack8(a0 * sig4(a0) * (acc[ai][1][m][0] * r), a1 * sig4(a1) * (acc[ai][1][m][1] * r)), (u32x4*)(act + row * LDACT + col0)); }
    }
};
struct GluPairOrder {
    StaticOrder base;
    __device__ void init(int M, int N2, int G_, int c_) { base.init(M, N2, G_, c_); }
    __device__ bool next(int i, Unit& u) const { Unit b; if (!base.next(i >> 1, b)) return false; u.pm = b.pm; u.pn = 2 * b.pn + (i & 1); return true; }
    __device__ __forceinline__ void a_ready(const Unit&) const {}
    __device__ __forceinline__ void done(const Unit&) const {}
};
struct PanelOrder {
    int G, vcu;
    __device__ void init(int G_, int bx) { G = G_; vcu = (G_ % 8 == 0) ? (bx % 8) * (G_ / 8) + bx / 8 : bx; }
    __device__ bool next(int i, Unit& u) const { const int L = i * G + vcu; if (L >= (T / BM) * (DM / BM)) return false; u.pm = L >> 3; u.pn = L & 7; return true; }
    __device__ __forceinline__ void a_ready(const Unit&) const {}
    __device__ __forceinline__ void done(const Unit&) const {}
};
struct EpiNormOut {
    static constexpr bool PERM = true, AFTER_DRAIN = false, REMAP = false;
    float* out; const bf16_t* x1b; const float* gain; float* rowss; unsigned* pcnt;
    __device__ __forceinline__ void operator()(const f32x4 (&acc)[2][2][4][2], const Unit& u, int wr, int wc, int fr, int fq) const {
        const int row0 = u.pm * BM + wr * 64 + fr;
#pragma unroll
        for (int ai = 0; ai < 2; ++ai)
#pragma unroll
            for (int m = 0; m < 4; ++m) { float q = 0.f;
#pragma unroll
                for (int bj = 0; bj < 2; ++bj)
#pragma unroll
                    for (int n = 0; n < 2; ++n) { const f32x4 v = acc[ai][bj][m][n]; q += (v[0] * v[0] + v[1] * v[1]) + (v[2] * v[2] + v[3] * v[3]); }
                q += __shfl_xor(q, 16); q += __shfl_xor(q, 32);
                if (fq == 0) { const float old = __hip_atomic_fetch_add(rowss + row0 + ai * HALF + m * 16, q, __ATOMIC_RELAXED, __HIP_MEMORY_SCOPE_AGENT); asm volatile("" :: "v"(old)); } }
        asm volatile("s_waitcnt vmcnt(0)" ::: "memory");
        unsigned* cw = pcnt + 64 * u.pm;
        if ((threadIdx.x & 63) == 0) (void)__hip_atomic_fetch_add(cw, 1u, __ATOMIC_RELAXED, __HIP_MEMORY_SCOPE_AGENT);
        { unsigned sp = 0; while ((unsigned)__builtin_amdgcn_readfirstlane(__hip_atomic_load(cw, __ATOMIC_RELAXED, __HIP_MEMORY_SCOPE_AGENT)) < 64u) { __builtin_amdgcn_s_sleep(2); if (++sp > (1u << 20)) break; } }
        asm volatile("" ::: "memory");
        const int col0 = u.pn * BM + wc * 32 + 8 * fq;
#pragma unroll
        for (int ai = 0; ai < 2; ++ai)
#pragma unroll
            for (int m = 0; m < 4; ++m) { const int row = row0 + ai * HALF + m * 16;
                const float rstd = rsqrtf(__hip_atomic_load(rowss + row, __ATOMIC_RELAXED, __HIP_MEMORY_SCOPE_AGENT) * (1.f / DM) + EPS);
#pragma unroll
                for (int bj = 0; bj < 2; ++bj) { float* op = out + (size_t)row * DM + col0 + bj * HALF; const float* gp = gain + col0 + bj * HALF;
                    f32x4 x0, x1; unpack8(*(const u32x4*)(x1b + (size_t)row * DM + col0 + bj * HALF), x0, x1); const f32x4 g0 = *(const f32x4*)gp, g1 = *(const f32x4*)(gp + 4);
                    __builtin_nontemporal_store(x0 + acc[ai][bj][m][0] * rstd * g0, (f32x4*)op); __builtin_nontemporal_store(x1 + acc[ai][bj][m][1] * rstd * g1, (f32x4*)(op + 4)); } }
    }
};
struct EpiNormMid {
    static constexpr bool PERM = true, AFTER_DRAIN = false, REMAP = false;
    const float* x; bf16_t* x1o; const float* gpost; float* rowss1; unsigned* pcnt1; float* rowss2;
    __device__ __forceinline__ static void arrive_wait(unsigned* cw) {
        asm volatile("s_waitcnt vmcnt(0)" ::: "memory");
        if ((threadIdx.x & 63) == 0) (void)__hip_atomic_fetch_add(cw, 1u, __ATOMIC_RELAXED, __HIP_MEMORY_SCOPE_AGENT);
        unsigned sp = 0; while ((unsigned)__builtin_amdgcn_readfirstlane(__hip_atomic_load(cw, __ATOMIC_RELAXED, __HIP_MEMORY_SCOPE_AGENT)) < 64u) { __builtin_amdgcn_s_sleep(2); if (++sp > (1u << 20)) break; }
        asm volatile("" ::: "memory");
    }
    __device__ __forceinline__ void operator()(const f32x4 (&acc_)[2][2][4][2], const Unit& u, int wr, int wc, int fr, int fq) const {
        f32x4 (&acc)[2][2][4][2] = const_cast<f32x4 (&)[2][2][4][2]>(acc_);
        const int row0 = u.pm * BM + wr * 64 + fr, col0 = u.pn * BM + wc * 32 + 8 * fq;
#pragma unroll
        for (int ai = 0; ai < 2; ++ai)
#pragma unroll
            for (int m = 0; m < 4; ++m) { float q = 0.f;
#pragma unroll
                for (int bj = 0; bj < 2; ++bj)
#pragma unroll
                    for (int n = 0; n < 2; ++n) { const f32x4 v = acc[ai][bj][m][n]; q += (v[0] * v[0] + v[1] * v[1]) + (v[2] * v[2] + v[3] * v[3]); }
                q += __shfl_xor(q, 16); q += __shfl_xor(q, 32);
                if (fq == 0) { const float old = __hip_atomic_fetch_add(rowss1 + row0 + ai * HALF + m * 16, q, __ATOMIC_RELAXED, __HIP_MEMORY_SCOPE_AGENT); asm volatile("" :: "v"(old)); } }
        arrive_wait(pcnt1 + 64 * u.pm);
#pragma unroll
        for (int ai = 0; ai < 2; ++ai)
#pragma unroll
            for (int m = 0; m < 4; ++m) { const int row = row0 + ai * HALF + m * 16; float q = 0.f;
                const float rstd = rsqrtf(__hip_atomic_load(rowss1 + row, __ATOMIC_RELAXED, __HIP_MEMORY_SCOPE_AGENT) * (1.f / DM) + EPS);
#pragma unroll
                for (int bj = 0; bj < 2; ++bj) { const size_t off = (size_t)row * DM + col0 + bj * HALF; const float* gp = gpost + col0 + bj * HALF;
                    const f32x4 x0 = __builtin_nontemporal_load((const f32x4*)(x + off)), x1 = __builtin_nontemporal_load((const f32x4*)(x + off + 4)), g0 = *(const f32x4*)gp, g1 = *(const f32x4*)(gp + 4);
                    const f32x4 v0 = x0 + acc[ai][bj][m][0] * rstd * g0, v1 = x1 + acc[ai][bj][m][1] * rstd * g1;
                    acc[ai][bj][m][0] = v0; acc[ai][bj][m][1] = v1;
                    *(u32x4*)(x1o + off) = pack8(v0, v1);
                    q += (v0[0] * v0[0] + v0[1] * v0[1]) + (v0[2] * v0[2] + v0[3] * v0[3]) + (v1[0] * v1[0] + v1[1] * v1[1]) + (v1[2] * v1[2] + v1[3] * v1[3]); }
                q += __shfl_xor(q, 16); q += __shfl_xor(q, 32);
                if (fq == 0) { const float old = __hip_atomic_fetch_add(rowss2 + row, q, __ATOMIC_RELAXED, __HIP_MEMORY_SCOPE_AGENT); asm volatile("" :: "v"(old)); } }
    }
};
}

struct Args {
    const float* x; const float* norm_mix_pre; const float* w_in; const float* w_attn_up;
    const float* a_re; const float* a_im; const float* log_dt; const float* b_re; const float* b_im; const float* c_re; const float* c_im; const float* ssm_d;
    const float* w_glu_v; const float* w_glu_g; const float* w_out; const float* norm_mix_post; const float* norm_ffn_pre;
    const float* w_ffn_gate; const float* w_ffn_up; const float* w_ffn_down; const float* norm_ffn_post;
    float* out; unsigned char* ws;
};

struct TrItem { const float* W; bf16* WT; const float* kg; int K, N, k0, n0, drow0; };
__device__ __forceinline__ void tr_load(const TrItem& t, float (&wv)[32], int lane) {
#pragma unroll
    for (int i = 0; i < 32; ++i) { const int kk = 2 * i + (lane >> 5); wv[i] = __builtin_nontemporal_load(t.W + (size_t)(t.k0 + kk) * t.N + t.n0 + (lane & 31)); }
    if (t.kg) {
#pragma unroll
        for (int i = 0; i < 32; ++i) wv[i] *= t.kg[t.k0 + 2 * i + (lane >> 5)]; }
}
__device__ __forceinline__ void tr_finish(const TrItem& t, const float (&wv)[32], LAS float* scr, int lane) {
    const int ldb = t.K + PADE;
#pragma unroll
    for (int i = 0; i < 32; ++i) { const int kk = 2 * i + (lane >> 5); scr[kk * 33 + (lane & 31)] = wv[i]; }
    asm volatile("s_waitcnt lgkmcnt(0)" ::: "memory");
    const int c = lane & 7;
#pragma unroll
    for (int j = 0; j < 4; ++j) { const int n = (lane >> 3) + 8 * j; const LAS float* s = scr + (8 * c) * 33 + n;
        v4u o; o.x = pk2(s[0 * 33], s[1 * 33]); o.y = pk2(s[2 * 33], s[3 * 33]); o.z = pk2(s[4 * 33], s[5 * 33]); o.w = pk2(s[6 * 33], s[7 * 33]);
        *(v4u*)(t.WT + (size_t)(t.drow0 + n) * ldb + t.k0 + 8 * c) = o; }
    asm volatile("s_waitcnt lgkmcnt(0)" ::: "memory");
}
__device__ __forceinline__ TrItem tr_make(const float* W, int K, int N, bf16* WT, int mode, int item, const float* kg = nullptr) {
    const int nblk = N / 32, kb = item / nblk, nb = item % nblk, n0 = 32 * nb;
    TrItem t; t.W = W; t.WT = WT; t.kg = kg; t.K = K; t.N = N; t.k0 = 64 * kb; t.n0 = n0; t.drow0 = (mode == 0) ? n0 : ((n0 >> 7) * 256 + (mode - 1) * 128 + (n0 & 127));
    return t;
}
__device__ __forceinline__ void p0_transpose(const float* W, int K, int N, bf16* WT, int mode, int item, LAS float* scr, int lane, const float* kg = nullptr) {
    const TrItem t = tr_make(W, K, N, WT, mode, item, kg); float wv[32]; tr_load(t, wv, lane); tr_finish(t, wv, scr, lane);
}
__device__ __forceinline__ void rms_row_to_bf16(const float* xrow, const float* gain, bf16* orow, int lane) {
    f32x4 v[8]; float s = 0.f;
#pragma unroll
    for (int j = 0; j < 8; ++j) { v[j] = *(const f32x4*)(xrow + 4 * (lane + 64 * j)); s += (v[j].x * v[j].x + v[j].y * v[j].y) + (v[j].z * v[j].z + v[j].w * v[j].w); }
    const float rstd = rsqrtf(wave_sum(s) * (1.f / DM) + EPS);
#pragma unroll
    for (int j = 0; j < 8; ++j) { const f32x4 g = *(const f32x4*)(gain + 4 * (lane + 64 * j)); v2u o; o.x = pk2(v[j].x * rstd * g.x, v[j].y * rstd * g.y); o.y = pk2(v[j].z * rstd * g.z, v[j].w * rstd * g.w);
        *(v2u*)(orow + 4 * (lane + 64 * j)) = o; }
}

__device__ __forceinline__ void rms_row2_to_bf16(const float* x0, const float* x1, const float* gain, bf16* o0, bf16* o1, int lane) {
    f32x4 v[8], w[8]; float s = 0.f, q = 0.f;
#pragma unroll
    for (int j = 0; j < 8; ++j) { v[j] = __builtin_nontemporal_load((const f32x4*)(x0 + 4 * (lane + 64 * j))); w[j] = __builtin_nontemporal_load((const f32x4*)(x1 + 4 * (lane + 64 * j))); }
#pragma unroll
    for (int j = 0; j < 8; ++j) { s += (v[j].x * v[j].x + v[j].y * v[j].y) + (v[j].z * v[j].z + v[j].w * v[j].w); q += (w[j].x * w[j].x + w[j].y * w[j].y) + (w[j].z * w[j].z + w[j].w * w[j].w); }
    const float rs = rsqrtf(wave_sum(s) * (1.f / DM) + EPS), rq = rsqrtf(wave_sum(q) * (1.f / DM) + EPS);
#pragma unroll
    for (int j = 0; j < 8; ++j) { const f32x4 g = *(const f32x4*)(gain + 4 * (lane + 64 * j));
        v2u a; a.x = pk2(v[j].x * rs * g.x, v[j].y * rs * g.y); a.y = pk2(v[j].z * rs * g.z, v[j].w * rs * g.w); *(v2u*)(o0 + 4 * (lane + 64 * j)) = a;
        v2u b; b.x = pk2(w[j].x * rq * g.x, w[j].y * rq * g.y); b.y = pk2(w[j].z * rq * g.z, w[j].w * rq * g.w); *(v2u*)(o1 + 4 * (lane + 64 * j)) = b; }
}
__device__ __forceinline__ void ssm_tables(const Args& a, int g, LAS unsigned char* lds, int tid) {
    LAS float* pw = (LAS float*)lds;
    LAS float* beta = pw + 64 * 17 * 2;
    LAS float* gam = beta + 64 * 16 * 2;
    LAS float* kt = gam + 16 * 64 * 2;
    unsigned char* ws = a.ws;
    if (tid < 64) {
        const int p = tid;
        const double dt = exp((double)a.log_dt[g]);
        const double are = (double)a.a_re[g * NP + p], aim = (double)a.a_im[g * NP + p];
        const double mag = exp(are * dt), ang = aim * dt;
        const double lr = mag * cos(ang), li = mag * sin(ang);
        const double den = are * are + aim * aim;
        const double cr = ((lr - 1.0) * are + li * aim) / den, ci = (li * are - (lr - 1.0) * aim) / den;
        double pr = 1.0, pi = 0.0;
        for (int d = 0; d <= CL; ++d) { pw[(p * 17 + d) * 2] = (float)pr; pw[(p * 17 + d) * 2 + 1] = (float)pi; const double nr = pr * lr - pi * li, ni = pr * li + pi * lr; pr = nr; pi = ni; }
        for (int c = 0; c < NC; ++c) { const double br = (double)a.b_re[(g * NP + p) * NC + c], bi = (double)a.b_im[(g * NP + p) * NC + c];
            beta[(p * 16 + c) * 2] = (float)(cr * br - ci * bi); beta[(p * 16 + c) * 2 + 1] = (float)(cr * bi + ci * br); }
        float* lamL = (float*)(ws + WS_LAML) + (g * NP + p) * 2;
        lamL[0] = pw[(p * 17 + CL) * 2]; lamL[1] = pw[(p * 17 + CL) * 2 + 1];
    }
    for (int idx = tid; idx < NC * NP; idx += NTHR) { gam[idx * 2] = a.c_re[g * NC * NP + idx]; gam[idx * 2 + 1] = a.c_im[g * NC * NP + idx]; }
    __syncthreads();
    for (int e = tid; e < CL * 256; e += NTHR) {
        const int d = e >> 8, c = (e >> 4) & 15, c2 = e & 15; float s = 0.f;
        for (int p = 0; p < NP; ++p) { const float gr = gam[(c * 64 + p) * 2], gi = gam[(c * 64 + p) * 2 + 1], wr_ = pw[(p * 17 + d) * 2], wi_ = pw[(p * 17 + d) * 2 + 1], br = beta[(p * 16 + c2) * 2], bi = beta[(p * 16 + c2) * 2 + 1];
            const float zr = gr * wr_ - gi * wi_, zi = gr * wi_ + gi * wr_; s += zr * br - zi * bi; }
        if (d == 0 && c == c2) s += a.ssm_d[g * NC + c];
        kt[e] = s;
    }
    __syncthreads();
    bf16* A3 = (bf16*)(ws + WS_A3) + (size_t)g * 256 * A3W;
    for (int cidx = tid; cidx < 256 * (A3W / 8); cidx += NTHR) {
        const int row = cidx / (A3W / 8), cc = cidx % (A3W / 8), i = row >> 4, c = row & 15; float v[8];
        if (cc < 32) { const int j = cc >> 1, c0 = (cc & 1) * 8;
#pragma unroll
            for (int e = 0; e < 8; ++e) v[e] = (j <= i) ? kt[((i - j) * 16 + c) * 16 + c0 + e] : 0.f;
        } else { const int pidx0 = (cc - 32) * 8, part = pidx0 >> 6, p0 = pidx0 & 63;
#pragma unroll
            for (int e = 0; e < 8; ++e) { const int p = p0 + e; const float gr = gam[(c * 64 + p) * 2], gi = gam[(c * 64 + p) * 2 + 1], wr_ = pw[(p * 17 + i + 1) * 2], wi_ = pw[(p * 17 + i + 1) * 2 + 1];
                v[e] = part ? -(gr * wi_ + gi * wr_) : (gr * wr_ - gi * wi_); }
        }
        v4u o; o.x = pk2(v[0], v[1]); o.y = pk2(v[2], v[3]); o.z = pk2(v[4], v[5]); o.w = pk2(v[6], v[7]);
        *(v4u*)(A3 + ((((size_t)(row >> 5)) * 24 + (cc >> 1)) * 64 + ((cc & 1) * 32 + (row & 31))) * 8) = o;
    }
    bf16* WTt = (bf16*)(ws + WS_WT) + (size_t)g * 128 * 256;
    for (int cidx = tid; cidx < 128 * 32; cidx += NTHR) {
        const int row = cidx >> 5, cc = cidx & 31, part = row >> 6, p = row & 63, j = cc >> 1, c0 = (cc & 1) * 8; float v[8];
        const float wr_ = pw[(p * 17 + (CL - 1 - j)) * 2], wi_ = pw[(p * 17 + (CL - 1 - j)) * 2 + 1];
#pragma unroll
        for (int e = 0; e < 8; ++e) { const float br = beta[(p * 16 + c0 + e) * 2], bi = beta[(p * 16 + c0 + e) * 2 + 1]; v[e] = part ? (wr_ * bi + wi_ * br) : (wr_ * br - wi_ * bi); }
        v4u o; o.x = pk2(v[0], v[1]); o.y = pk2(v[2], v[3]); o.z = pk2(v[4], v[5]); o.w = pk2(v[6], v[7]);
        *(v4u*)(WTt + ((((size_t)(row >> 5)) * 16 + (cc >> 1)) * 64 + ((cc & 1) * 32 + (row & 31))) * 8) = o;
    }
    __syncthreads();
}

__device__ __forceinline__ unsigned voff_b(int row, int ch) { return 256u * row + 16u * (ch ^ (((row & 3) << 2) | ((row >> 2) & 3))); }
__device__ __forceinline__ v4i16_t trrd(LAS unsigned char* p) { return __builtin_amdgcn_ds_read_tr16_b64_v4i16((LAS v4i16_t*)p); }
__device__ __forceinline__ void attn_wave_tile(const bf16* qkvu, bf16* opart, float* lse, int b, int h, int tile, LAS unsigned char* vl, int lane) {
    asm volatile("" : "+v"(lane));
    const int g = h >> 2, dl = 2 * g;
    const int tps = (SEQ >> dl) >> 5, res = tile / tps, m0 = (tile % tps) * 32;
    const int r32 = lane & 31, hi = lane >> 5;
    const float sl2 = exp2f(-8.0f * (float)(h + 1) / 12.0f) * LOG2E * (float)(1 << dl);
    const float sc2 = LOG2E * 0.08838834764831845f;
    const bf16* base = qkvu + (size_t)(b * SEQ + res) * LDQ + h * HD;
    const bf16* qrow = base + ((size_t)(m0 + r32) << dl) * LDQ;
    LAS unsigned char* kl = vl + 8192;
    const int lrow = lane >> 4, lch = lane & 15;
    v4u kst[8];
#pragma unroll
    for (int it = 0; it < 8; ++it) kst[it] = *(const v4u*)(base + ((size_t)(m0 + it * 4 + lrow) << dl) * LDQ + lch * 8);
#pragma unroll
    for (int it = 0; it < 8; ++it) *(LAS v4u*)(kl + voff_b(it * 4 + lrow, lch)) = kst[it];
    bf16x8 qf[8];
#pragma unroll
    for (int kk = 0; kk < 8; ++kk) qf[kk] = *(LAS bf16x8*)(kl + voff_b(r32, 2 * kk + hi));
    int Ld = r32 - 4 * hi; asm volatile("" : "+v"(Ld));
    const float bl = -sl2 * (float)Ld;
#define ATT_KLOAD(kt_) do { _Pragma("unroll") for (int it = 0; it < 8; ++it) { int kidx_ = m0 - 128 + 32 * (kt_) + it * 4 + lrow; kidx_ = kidx_ < 0 ? 0 : kidx_; \
        kst[it] = *(const v4u*)((const char*)base + (unsigned)(((unsigned)kidx_ << dl) * (unsigned)(LDQ * 2) + (unsigned)(2 * HQ) + (unsigned)(lch * 16))); } } while (0)
    ATT_KLOAD(0);
    f32x16 S[5];
    float mx = -INFINITY;
#pragma unroll
    for (int kt = 0; kt < 5; ++kt) {
#pragma unroll
        for (int it = 0; it < 8; ++it) *(LAS v4u*)(kl + voff_b(it * 4 + lrow, lch)) = kst[it];
        if (kt < 4) ATT_KLOAD(kt + 1);
        __builtin_amdgcn_sched_barrier(0);
        f32x16 s = {};
#pragma unroll
        for (int kk = 0; kk < 8; ++kk) { const bf16x8 kf = *(LAS bf16x8*)(kl + voff_b(r32, 2 * kk + hi)); s = MFMA32(kf, qf[kk], s); }
        const bool tneg = (m0 - 128 + 32 * kt) < 0;
#pragma unroll
        for (int r = 0; r < 16; ++r) { const int C = 128 - 32 * kt - ((r & 3) + 8 * (r >> 2));
            float v = fmaf(s[r], sc2, bl) - sl2 * (float)C;
            if (kt == 0) v = (C + Ld > 128) ? -INFINITY : v;
            if (kt == 4) v = (C + Ld < 0) ? -INFINITY : v;
            if (kt < 4) v = tneg ? -INFINITY : v;
            s[r] = v; mx = fmaxf(mx, v); }
        S[kt] = s;
        __builtin_amdgcn_sched_barrier(0);
    }
#undef ATT_KLOAD
    v4u vst[2][8];
#define ATT_VLOAD(buf, kt_) do { _Pragma("unroll") for (int it = 0; it < 8; ++it) { int vidx_ = m0 - 128 + 32 * (kt_) + it * 4 + (lane >> 4); vidx_ = vidx_ < 0 ? 0 : vidx_; \
        vst[buf][it] = *(const v4u*)((const char*)base + (unsigned)(((unsigned)vidx_ << dl) * (unsigned)(LDQ * 2) + (unsigned)(4 * HQ) + (unsigned)((lane & 15) * 16))); } } while (0)
    ATT_VLOAD(0, 0); ATT_VLOAD(1, 1);
    __builtin_amdgcn_sched_barrier(0);
    mx = fmaxf(mx, __shfl_xor(mx, 32));
    float l = 0.f;
    v4u Pp[5][2];
#pragma unroll
    for (int kt = 0; kt < 5; ++kt) {
#pragma unroll
        for (int r = 0; r < 16; ++r) { const float p = __builtin_amdgcn_exp2f(S[kt][r] - mx); S[kt][r] = p; l += p; }
#pragma unroll
        for (int s = 0; s < 2; ++s) { Pp[kt][s].x = pk2(S[kt][8 * s + 0], S[kt][8 * s + 1]); Pp[kt][s].y = pk2(S[kt][8 * s + 2], S[kt][8 * s + 3]); Pp[kt][s].z = pk2(S[kt][8 * s + 4], S[kt][8 * s + 5]); Pp[kt][s].w = pk2(S[kt][8 * s + 6], S[kt][8 * s + 7]); }
    }
    l += __shfl_xor(l, 32);
    f32x16 O[4];
#pragma unroll
    for (int dv = 0; dv < 4; ++dv) O[dv] = (f32x16){};
    const int q4 = (lane & 15) >> 2, p4 = lane & 3, blk = (lane >> 4) & 1;
#pragma unroll
    for (int kt = 0; kt < 5; ++kt) {
#pragma unroll
        for (int it = 0; it < 8; ++it) { const int row = it * 4 + (lane >> 4); *(LAS v4u*)(vl + voff_b(row, lane & 15)) = vst[kt & 1][it]; }
        if (kt < 3) ATT_VLOAD(kt & 1, kt + 2);
        __builtin_amdgcn_sched_barrier(0);
#pragma unroll
        for (int s = 0; s < 2; ++s) {
            const bf16x8 pf = __builtin_bit_cast(bf16x8, Pp[kt][s]);
#pragma unroll
            for (int dv = 0; dv < 4; ++dv) {
                const int c = 4 * dv + 2 * blk + (p4 >> 1);
                const v4i16_t lo = trrd(vl + voff_b(16 * s + 4 * hi + q4, c) + 8 * (p4 & 1));
                const v4i16_t hh = trrd(vl + voff_b(16 * s + 8 + 4 * hi + q4, c) + 8 * (p4 & 1));
                const bf16x8 vf = __builtin_shufflevector(lo, hh, 0, 1, 2, 3, 4, 5, 6, 7);
                O[dv] = MFMA32(vf, pf, O[dv]);
            }
        }
        __builtin_amdgcn_sched_barrier(0);
    }
#undef ATT_VLOAD
    const float inv = 1.0f / l;
    const size_t tok = (size_t)b * SEQ + ((size_t)(m0 + r32) << dl) + res;
#pragma unroll
    for (int dv = 0; dv < 4; ++dv)
#pragma unroll
        for (int gq = 0; gq < 4; ++gq) { v2u o; o.x = pk2(O[dv][4 * gq] * inv, O[dv][4 * gq + 1] * inv); o.y = pk2(O[dv][4 * gq + 2] * inv, O[dv][4 * gq + 3] * inv);
            *(LAS v2u*)(vl + voff_b(r32, 4 * dv + gq) + 8 * hi) = o; }
#pragma unroll
    for (int it = 0; it < 8; ++it) { const int row = it * 4 + (lane >> 4); const v4u v = *(LAS v4u*)(vl + voff_b(row, lane & 15));
        const size_t tk = (size_t)b * SEQ + ((size_t)(m0 + row) << dl) + res;
        *(v4u*)(opart + (tk * NH + h) * HD + (lane & 15) * 8) = v; }
    if (hi == 0) lse[tok * NH + h] = mx + __log2f(l);
}

__device__ __forceinline__ void ssm_estate_unit(const bf16* ubuf, const bf16* WTt, float* E, LAS unsigned char* el, int g, int b, int nt, int lane) {
    const int r32 = lane & 31, hi = lane >> 5, chunk = 32 * nt + r32;
    const bf16* up = ubuf + ((((size_t)(b * NG + g)) * 16 + nt) * 16 * 32 + r32) * NC + 8 * hi;
    const bf16* wp = WTt + ((size_t)g * 4 * 16 * 64 + lane) * 8;
    f32x16 acc[4];
#pragma unroll
    for (int mt = 0; mt < 4; ++mt) acc[mt] = (f32x16){};
#pragma unroll 8
    for (int j = 0; j < CL; ++j) {
        const bf16x8 bf = *(const bf16x8*)(up + j * 512);
#pragma unroll
        for (int mt = 0; mt < 4; ++mt) { const bf16x8 af = *(const bf16x8*)(wp + (mt * 16 + j) * 512); acc[mt] = MFMA32(af, bf, acc[mt]); }
    }
#pragma unroll
    for (int mt = 0; mt < 4; ++mt)
#pragma unroll
        for (int gq = 0; gq < 4; ++gq) *(LAS f32x4*)(el + r32 * 512 + (((8 * mt + 2 * gq + hi) ^ r32) * 16)) = (f32x4){acc[mt][4 * gq], acc[mt][4 * gq + 1], acc[mt][4 * gq + 2], acc[mt][4 * gq + 3]};
    float* ep = E + (((size_t)(b * NG + g)) * NCHUNK + 32 * nt) * 128;
#pragma unroll
    for (int it = 0; it < 16; ++it) { const int id = it * 64 + lane, n = id >> 5, pc = id & 31; const f32x4 v = *(LAS f32x4*)(el + id * 16); *(f32x4*)(ep + n * 128 + ((pc ^ n) * 4)) = v; }
}
template <int mg> __device__ __forceinline__ void ssm_out_unit(const bf16* ubuf, const bf16* A3, const bf16* HB, LAS unsigned char* yt, int wave, int g, int b, int nt, int lane) {
    const int r32 = lane & 31, hi = lane >> 5, chunk = 32 * nt + r32;
    const bf16* up = ubuf + ((((size_t)(b * NG + g)) * 16 + nt) * 16 * 32 + r32) * NC + 8 * hi;
    const bf16* hp = HB + ((((size_t)(b * NG + g)) * 16 + nt) * 8 * 32 + r32) * 16 + 8 * hi;
    const bf16* ap = A3 + (((size_t)(g * 8 + 4 * mg)) * 24 * 64 + lane) * 8;
    f32x16 acc[4];
#pragma unroll
    for (int mt = 0; mt < 4; ++mt) acc[mt] = (f32x16){};
    constexpr int jmax = 8 * mg + 8;
#pragma unroll 8
    for (int j = 0; j < jmax; ++j) {
        const bf16x8 bf = *(const bf16x8*)(up + j * 512);
#pragma unroll
        for (int mt = 0; mt < 4; ++mt) { const bf16x8 af = *(const bf16x8*)(ap + (mt * 24 + j) * 512); acc[mt] = MFMA32(af, bf, acc[mt]); }
    }
#pragma unroll 8
    for (int ks = 0; ks < 8; ++ks) {
        const bf16x8 bf = *(const bf16x8*)(hp + ks * 512);
#pragma unroll
        for (int mt = 0; mt < 4; ++mt) { const bf16x8 af = *(const bf16x8*)(ap + (mt * 24 + 16 + ks) * 512); acc[mt] = MFMA32(af, bf, acc[mt]); }
    }
#pragma unroll
    for (int mt = 0; mt < 4; ++mt)
#pragma unroll
        for (int gq = 0; gq < 4; ++gq) {
            const int il = 2 * mt + (gq >> 1), ch = (wave * 2 + (gq & 1)) ^ (r32 & 15);
            v2u o; o.x = pk2(gelu_tanh(acc[mt][4 * gq]), gelu_tanh(acc[mt][4 * gq + 1])); o.y = pk2(gelu_tanh(acc[mt][4 * gq + 2]), gelu_tanh(acc[mt][4 * gq + 3]));
            *(LAS v2u*)(yt + (r32 * 8 + il) * 256 + ch * 16 + 8 * hi) = o;
        }
}

template <int NR> __device__ __forceinline__ void norm1_rows(const float* x, const bf16* o, const float* gpost, const float* gpre, float* x1, bf16* h2, int m, int mstep, int lane) {
    f32x4 v[NR][8], xv[NR][8]; float s[NR], s1[NR];
#pragma unroll
    for (int r = 0; r < NR; ++r) { const size_t row = (size_t)(m + r * mstep);
#pragma unroll
        for (int j = 0; j < 4; ++j) { const v4u w = __builtin_nontemporal_load((const v4u*)(o + row * LDH + 8 * (lane + 64 * j)));
            v[r][2 * j] = (f32x4){bflo(w.x), bfhi(w.x), bflo(w.y), bfhi(w.y)}; v[r][2 * j + 1] = (f32x4){bflo(w.z), bfhi(w.z), bflo(w.w), bfhi(w.w)}; }
#pragma unroll
        for (int j = 0; j < 8; ++j) xv[r][j] = __builtin_nontemporal_load((const f32x4*)(x + row * DM + 8 * (lane + 64 * (j >> 1)) + 4 * (j & 1))); }
#pragma unroll
    for (int r = 0; r < NR; ++r) { s[r] = 0.f;
#pragma unroll
        for (int j = 0; j < 8; ++j) s[r] += (v[r][j].x * v[r][j].x + v[r][j].y * v[r][j].y) + (v[r][j].z * v[r][j].z + v[r][j].w * v[r][j].w); }
#pragma unroll
    for (int r = 0; r < NR; ++r) { const size_t row = (size_t)(m + r * mstep); const float rstd = rsqrtf(wave_sum(s[r]) * (1.f / DM) + EPS); s1[r] = 0.f;
#pragma unroll
        for (int j = 0; j < 8; ++j) { const int e0 = 8 * (lane + 64 * (j >> 1)) + 4 * (j & 1); const f32x4 gv = *(const f32x4*)(gpost + e0);
            v[r][j] = xv[r][j] + v[r][j] * rstd * gv; s1[r] += (v[r][j].x * v[r][j].x + v[r][j].y * v[r][j].y) + (v[r][j].z * v[r][j].z + v[r][j].w * v[r][j].w); *(f32x4*)(x1 + row * DM + e0) = v[r][j]; } }
#pragma unroll
    for (int r = 0; r < NR; ++r) { const size_t row = (size_t)(m + r * mstep); const float rstd1 = rsqrtf(wave_sum(s1[r]) * (1.f / DM) + EPS);
#pragma unroll
        for (int j = 0; j < 4; ++j) { const int e0 = 8 * (lane + 64 * j); const f32x4 g0 = *(const f32x4*)(gpre + e0), g1 = *(const f32x4*)(gpre + e0 + 4);
            const f32x4 a = v[r][2 * j] * rstd1 * g0, c = v[r][2 * j + 1] * rstd1 * g1; v4u ov; ov.x = pk2(a.x, a.y); ov.y = pk2(a.z, a.w); ov.z = pk2(c.x, c.y); ov.w = pk2(c.z, c.w);
            *(v4u*)(h2 + row * LDH + e0) = ov; } }
}
template <int NR> __device__ __forceinline__ void norm2_rows(const bf16* f, const float* gpost, float* out, int m, int mstep, int lane) {
    f32x4 v[NR][8], xv[NR][8]; float s[NR];
#pragma unroll
    for (int r = 0; r < NR; ++r) { const size_t row = (size_t)(m + r * mstep);
#pragma unroll
        for (int j = 0; j < 4; ++j) { const v4u w = __builtin_nontemporal_load((const v4u*)(f + row * LDH + 8 * (lane + 64 * j)));
            v[r][2 * j] = (f32x4){bflo(w.x), bfhi(w.x), bflo(w.y), bfhi(w.y)}; v[r][2 * j + 1] = (f32x4){bflo(w.z), bfhi(w.z), bflo(w.w), bfhi(w.w)}; }
#pragma unroll
        for (int j = 0; j < 8; ++j) xv[r][j] = *(const f32x4*)(out + row * DM + 8 * (lane + 64 * (j >> 1)) + 4 * (j & 1)); }
#pragma unroll
    for (int r = 0; r < NR; ++r) { s[r] = 0.f;
#pragma unroll
        for (int j = 0; j < 8; ++j) s[r] += (v[r][j].x * v[r][j].x + v[r][j].y * v[r][j].y) + (v[r][j].z * v[r][j].z + v[r][j].w * v[r][j].w); }
#pragma unroll
    for (int r = 0; r < NR; ++r) { const size_t row = (size_t)(m + r * mstep); const float rstd = rsqrtf(wave_sum(s[r]) * (1.f / DM) + EPS);
#pragma unroll
        for (int j = 0; j < 8; ++j) { const int e0 = 8 * (lane + 64 * (j >> 1)) + 4 * (j & 1); const f32x4 gv = *(const f32x4*)(gpost + e0);
            __builtin_nontemporal_store(xv[r][j] + v[r][j] * rstd * gv, (f32x4*)(out + row * DM + e0)); } }
}

#define XB_TMO      128
#define XB_XCNT(j)  (256  + 64 * (j))
#define XB_XSUB(j)  (1280 + 64 * (j))
#define XB_XGEN(j)  (2304 + 64 * (j))
#define XB_TOP      3328
#define XB_TOPGEN   3392
#define XCD_BAR_WORDS 3456
#define XB_SPIN_CAP (1u << 18)

__device__ __forceinline__ unsigned xb_ld(unsigned* p)              { return __hip_atomic_load(p, __ATOMIC_RELAXED, __HIP_MEMORY_SCOPE_AGENT); }
__device__ __forceinline__ unsigned xb_add(unsigned* p, unsigned v) { return __hip_atomic_fetch_add(p, v, __ATOMIC_RELAXED, __HIP_MEMORY_SCOPE_AGENT); }
__device__ __forceinline__ unsigned xb_xcc_id() { return (unsigned)__builtin_amdgcn_s_getreg((3 << 11) | 20) & 0xFu; }
#define XB_SPIN(cond, bar) do { unsigned _sp = 0; while (cond) { __builtin_amdgcn_s_sleep(1); \
    if ((++_sp & 255u) == 0u) { if (xb_ld(&(bar)[XB_TMO])) break; if (_sp > XB_SPIN_CAP) { atomicAdd(&(bar)[XB_TMO], 1u); break; } } } } while (0)

struct XcdBarrier {
    unsigned* bar; unsigned x;
    volatile LAS unsigned* st;
};

__device__ __forceinline__ XcdBarrier xcd_barrier_post(unsigned* bar, volatile LAS unsigned* st) {
    XcdBarrier b; b.bar = bar; b.x = xb_xcc_id(); b.st = st;
    if (threadIdx.x == 0) (void)xb_add(&bar[XB_XCNT(b.x)], 1u);
    return b;
}
__device__ __forceinline__ void xcd_barrier_complete(unsigned* bar, unsigned x, unsigned& nloc, unsigned& nx) {
    const unsigned G = gridDim.x * gridDim.y * gridDim.z;
    unsigned sum, cnt, mine, sp = 0u;
    for (;;) {
        sum = 0u; cnt = 0u; mine = 0u;
#pragma unroll
        for (unsigned j = 0; j < 16; ++j) { const unsigned c = xb_ld(&bar[XB_XCNT(j)]); sum += c; cnt += (c > 0u) ? 1u : 0u; mine = (j == x) ? c : mine; }
        if (sum == G) break;
        __builtin_amdgcn_s_sleep(1);
        if ((++sp & 255u) == 0u) { if (xb_ld(&bar[XB_TMO])) break; if (sp > XB_SPIN_CAP) { atomicAdd(&bar[XB_TMO], 1u); break; } }
    }
    nloc = mine > 0u ? mine : 1u; nx = cnt > 0u ? cnt : 1u;
}

__device__ __forceinline__ void xcd_barrier(const XcdBarrier& b) {
    asm volatile("s_waitcnt vmcnt(0)" ::: "memory");
    __syncthreads();
    if (threadIdx.x == 0) {
        unsigned* bar = b.bar;
        __builtin_amdgcn_s_waitcnt(0);
        unsigned nloc = b.st[0], nx = b.st[1];
        if (nloc == 0u) { xcd_barrier_complete(bar, b.x, nloc, nx); b.st[0] = nloc; b.st[1] = nx; }
        const unsigned old = xb_add(&bar[XB_XSUB(b.x)], 1u);
        const unsigned gen = old / nloc;
        if (old + 1u == (gen + 1u) * nloc) {
            __builtin_amdgcn_fence(__ATOMIC_RELEASE, "agent");
            asm volatile("s_waitcnt vmcnt(0)" ::: "memory");
            const unsigned og = xb_add(&bar[XB_TOP], 1u);
            const unsigned tg = og / nx;
            if (og + 1u == (tg + 1u) * nx) xb_add(&bar[XB_TOPGEN], 1u);
            else XB_SPIN(xb_ld(&bar[XB_TOPGEN]) == tg, bar);
            __builtin_amdgcn_fence(__ATOMIC_ACQUIRE, "agent");
            xb_add(&bar[XB_XGEN(b.x)], 1u);
            asm volatile("s_waitcnt vmcnt(0)" ::: "memory");
        } else {
            XB_SPIN(xb_ld(&bar[XB_XGEN(b.x)]) == gen, bar);
            __builtin_amdgcn_fence(__ATOMIC_ACQUIRE, "agent");
            asm volatile("s_waitcnt vmcnt(0)" ::: "memory");
        }
    }
    __syncthreads();
}

#ifndef PH_SKIP
#define PH_SKIP 0
#endif
#define PH_ON(k) (((PH_SKIP) >> (k)) & 1) == 0
#ifndef PH_DUP
#define PH_DUP 0
#endif
#define PH_REP(k) for (int rep_ = 0; rep_ < 1 + (((PH_DUP) >> (k)) & 1); ++rep_)

__global__ void __launch_bounds__(NTHR, 2) mega_fwd(Args a) {
    extern __shared__ __attribute__((aligned(16))) unsigned char lds_raw[];
    cg::grid_group grid = cg::this_grid();
    LAS unsigned char* lds = (LAS unsigned char*)lds_raw;
    const int G = gridDim.x, bx = blockIdx.x, NGW = G * NWAVES;
#define PH_IDS int tid = threadIdx.x; asm volatile("" : "+v"(tid)); const int lane = tid & 63; const int wave = __builtin_amdgcn_readfirstlane(tid >> 6); const int gw = bx * NWAVES + wave; (void)lane; (void)gw; (void)wave;
    unsigned char* ws = a.ws;
    {
        for (int u = threadIdx.x; u < (LDS_BYTES - RING_BYTES) / 4; u += NTHR) ((LAS unsigned*)(lds + RING_BYTES))[u] = 0u;
        __syncthreads();
    }
    const XcdBarrier xbar = xcd_barrier_post((unsigned*)(ws + WS_BAR), (volatile LAS unsigned*)(lds + RING_BYTES + 320 + 32));
#define SEAM() xcd_barrier(xbar)
    bf16* Win_t = (bf16*)(ws + WS_WIN); bf16* Wup_t = (bf16*)(ws + WS_WUP); bf16* Wglu_t = (bf16*)(ws + WS_WGLU); bf16* Wout_t = (bf16*)(ws + WS_WOUT);
    bf16* Wffn_t = (bf16*)(ws + WS_WFFN); bf16* Wdown_t = (bf16*)(ws + WS_WDOWN);
    bf16* qkvu = (bf16*)(ws + WS_RA); bf16* ubuf = (bf16*)(ws + WS_UB); bf16* obuf = (bf16*)(ws + WS_RA); bf16* act = (bf16*)(ws + WS_RA);
    bf16* hbuf = (bf16*)(ws + WS_RH); bf16* attn = (bf16*)(ws + WS_ATTN); bf16* ybuf = (bf16*)(ws + WS_Y); bf16* h2 = (bf16*)(ws + WS_RH);
    bf16* opart = (bf16*)(ws + WS_OPART); float* lse = (float*)(ws + WS_LSE); float* Ebuf = (float*)(ws + WS_E); bf16* HB = (bf16*)(ws + WS_HB);
    bf16* msbuf = (bf16*)(ws + WS_RF); bf16* fbuf = (bf16*)(ws + WS_RF);
    bf16* gates = (bf16*)a.out;

    if (PH_ON(0)) PH_REP(0) {
        PH_IDS
        for (int i = bx * NTHR + tid; i < T; i += G * NTHR) { ((float*)(ws + WS_ROWSS))[i] = 0.f; ((float*)(ws + WS_ROWSS1))[i] = 0.f; ((float*)(ws + WS_ROWSS2))[i] = 0.f;
            if (i < 64 * 64) { ((unsigned*)(ws + WS_PCNT))[i] = 0u; ((unsigned*)(ws + WS_PCNT1))[i] = 0u; ((unsigned*)(ws + WS_PCNT2))[i] = 0u; } }
        LAS float* scr = (LAS float*)(lds + wave * 16384);
        constexpr int I_IN = (DM / 64) * (INW / 32), I_UP = (AOW / 64) * (DM / 32), I_GLU = (SSMW / 64) * (DM / 32), I_OUT = (DM / 64) * (DM / 32), I_FFN = (DM / 64) * (DFF / 32), I_DN = (DFF / 64) * (DM / 32);
        constexpr int NITEMS = I_IN;
#define P0_ITEM(t, it_) do { t = tr_make(a.w_in, DM, INW, Win_t, 0, (it_)); } while (0)
        for (int it = gw; it < NITEMS; it += 2 * NGW) {
            TrItem t0, t1; float w0[32], w1[32];
            const bool two = it + NGW < NITEMS;
            P0_ITEM(t0, it); tr_load(t0, w0, lane);
            if (two) { P0_ITEM(t1, it + NGW); tr_load(t1, w1, lane); }
            tr_finish(t0, w0, scr, lane);
            if (two) tr_finish(t1, w1, scr, lane);
        }
#undef P0_ITEM
        for (int m = gw; m < T; m += 2 * NGW) rms_row2_to_bf16(a.x + (size_t)m * DM, a.x + (size_t)(m + NGW) * DM, a.norm_mix_pre, hbuf + (size_t)m * LDH, hbuf + (size_t)(m + NGW) * LDH, lane);
    }
    grid.sync();

    if (PH_ON(1)) {
        pg8::Gemm g{hbuf, Win_t, T, INW, DM, LDH, LDH}; pg8::StaticOrder S; S.init(T, INW, G, bx, 1 + (((PH_DUP) >> 1) & 1));
        pg8::EpiIn E{qkvu, ubuf, gates};
        pg8::gemm_phase<pg8::EpiIn, pg8::StaticOrder, PG8_ALIGN, PG8_SP2>(lds, g, S, E);
        if (bx >= G / 2) {
            PH_IDS
            LAS float* scr = (LAS float*)(lds + wave * 16384);
            constexpr int I_FFN = (DM / 64) * (DFF / 32);
            constexpr int I_DN2 = (DFF / 64) * (DM / 32), I_UP2 = (AOW / 64) * (DM / 32), I_GLU2 = (SSMW / 64) * (DM / 32), I_OUT2 = (DM / 64) * (DM / 32);
            for (int it = (bx - G / 2) * NWAVES + wave; it < 2 * I_FFN + I_DN2 + I_UP2 + 2 * I_GLU2 + I_OUT2; it += (G - G / 2) * NWAVES) {
                int r = it;
                if (r < I_UP2) { p0_transpose(a.w_attn_up, AOW, DM, Wup_t, 0, r, scr, lane); continue; } r -= I_UP2;
                if (r < I_GLU2) { p0_transpose(a.w_glu_v, SSMW, DM, Wglu_t, 1, r, scr, lane); continue; } r -= I_GLU2;
                if (r < I_GLU2) { p0_transpose(a.w_glu_g, SSMW, DM, Wglu_t, 2, r, scr, lane); continue; } r -= I_GLU2;
                if (r < I_OUT2) { p0_transpose(a.w_out, DM, DM, Wout_t, 0, r, scr, lane); continue; } r -= I_OUT2;
                if (r < I_FFN) { p0_transpose(a.w_ffn_gate, DM, DFF, Wffn_t, 1, r, scr, lane, a.norm_ffn_pre); continue; } r -= I_FFN;
                if (r < I_FFN) { p0_transpose(a.w_ffn_up, DM, DFF, Wffn_t, 2, r, scr, lane, a.norm_ffn_pre); continue; } r -= I_FFN;
                p0_transpose(a.w_ffn_down, DFF, DM, Wdown_t, 0, r, scr, lane);
            }
            __syncthreads();
            if (bx >= G - NG) ssm_tables(a, bx - (G - NG), lds, tid);
        }
    }
    SEAM();

    if (PH_ON(2)) PH_REP(2) {
        PH_IDS
        LAS unsigned char* vl = lds + wave * 16384;
        PH_REP(12) for (int w = gw; w < BATCH * NH * (SEQ / 32); w += NGW) {
            const int bh = w / (SEQ / 32), tile = w % (SEQ / 32);
            attn_wave_tile(qkvu, opart, lse, bh / NH, bh % NH, tile, vl, lane);
        }
        PH_REP(13) for (int w = gw; w < NG * BATCH * (NCHUNK / 32); w += NGW) {
            const int g = w / (BATCH * (NCHUNK / 32)), r = w % (BATCH * (NCHUNK / 32));
            ssm_estate_unit(ubuf, (const bf16*)(ws + WS_WT), Ebuf, vl, g, r / (NCHUNK / 32), r % (NCHUNK / 32), lane);
        }
    }
    SEAM();

    if (PH_ON(3)) PH_REP(3) {
        PH_IDS
        for (int u = bx; u < BATCH * NG * 2; u += G) {
            const int b = u >> 7, g = (u >> 1) & 63, p = (u & 1) * 32 + (tid & 31), seg = tid >> 5;
            const float lr = ((const float*)(ws + WS_LAML))[(g * NP + p) * 2], li = ((const float*)(ws + WS_LAML))[(g * NP + p) * 2 + 1];
            const size_t base = (((size_t)(b * NG + g)) * NCHUNK + 32 * seg) * 128 + p;
            const size_t hbase = (((((size_t)(b * NG + g)) * 16 + seg) * 8 + (p >> 4)) * 32) * 16 + (p & 15);
            float er[32], ei[32];
#pragma unroll
            for (int k = 0; k < 32; ++k) { er[k] = Ebuf[base + (size_t)k * 128]; ei[k] = Ebuf[base + (size_t)k * 128 + 64]; }
            float hr = 0.f, hi_ = 0.f;
#pragma unroll
            for (int k = 0; k < 32; ++k) { const float nr = lr * hr - li * hi_ + er[k], ni = lr * hi_ + li * hr + ei[k]; hr = nr; hi_ = ni; }
            LAS float* se = (LAS float*)lds;
            se[(seg * 32 + (tid & 31)) * 2] = hr; se[(seg * 32 + (tid & 31)) * 2 + 1] = hi_;
            float pr = lr, pi = li;
#pragma unroll
            for (int q = 0; q < 5; ++q) { const float nr = pr * pr - pi * pi, ni = 2.f * pr * pi; pr = nr; pi = ni; }
            __syncthreads();
            hr = 0.f; hi_ = 0.f;
            for (int s2 = 0; s2 < seg; ++s2) { const float sr = se[(s2 * 32 + (tid & 31)) * 2], si = se[(s2 * 32 + (tid & 31)) * 2 + 1]; const float nr = pr * hr - pi * hi_ + sr, ni = pr * hi_ + pi * hr + si; hr = nr; hi_ = ni; }
#pragma unroll
            for (int k = 0; k < 32; ++k) {
                HB[hbase + k * 16] = (bf16)(pk2(hr, 0.f) & 0xffffu); HB[hbase + 4 * 512 + k * 16] = (bf16)(pk2(hi_, 0.f) & 0xffffu);
                const float nr = lr * hr - li * hi_ + er[k], ni = lr * hi_ + li * hr + ei[k]; hr = nr; hi_ = ni;
            }
            __syncthreads();
        }
        for (size_t idx = (size_t)bx * NTHR + tid; idx < (size_t)T * 64; idx += (size_t)G * NTHR) {
            const size_t tok = idx >> 6; const int j = (int)(idx >> 4) & 3, ch = (int)idx & 15;
            const float l0 = lse[tok * NH + j], l1 = lse[tok * NH + 4 + j], l2 = lse[tok * NH + 8 + j];
            const float m = fmaxf(l0, fmaxf(l1, l2));
            float w0 = __builtin_amdgcn_exp2f(l0 - m), w1 = __builtin_amdgcn_exp2f(l1 - m), w2 = __builtin_amdgcn_exp2f(l2 - m);
            const float inv = 1.0f / (w0 + w1 + w2); w0 *= inv; w1 *= inv; w2 *= inv;
            const v4u o0 = *(const v4u*)(opart + (tok * NH + j) * HD + ch * 8), o1 = *(const v4u*)(opart + (tok * NH + 4 + j) * HD + ch * 8), o2 = *(const v4u*)(opart + (tok * NH + 8 + j) * HD + ch * 8);
            v4u r;
            r.x = pk2(w0 * bflo(o0.x) + w1 * bflo(o1.x) + w2 * bflo(o2.x), w0 * bfhi(o0.x) + w1 * bfhi(o1.x) + w2 * bfhi(o2.x));
            r.y = pk2(w0 * bflo(o0.y) + w1 * bflo(o1.y) + w2 * bflo(o2.y), w0 * bfhi(o0.y) + w1 * bfhi(o1.y) + w2 * bfhi(o2.y));
            r.z = pk2(w0 * bflo(o0.z) + w1 * bflo(o1.z) + w2 * bflo(o2.z), w0 * bfhi(o0.z) + w1 * bfhi(o1.z) + w2 * bfhi(o2.z));
            r.w = pk2(w0 * bflo(o0.w) + w1 * bflo(o1.w) + w2 * bflo(o2.w), w0 * bfhi(o0.w) + w1 * bfhi(o1.w) + w2 * bfhi(o2.w));
            *(v4u*)(attn + tok * LDATT + j * HD + ch * 8) = r;
        }
    }
    SEAM();

    if (PH_ON(4)) PH_REP(4) {
        PH_IDS
        for (int bu = bx; bu < BATCH * (NCHUNK / 32) * 2 * (NG / 8); bu += G) {
            const int go = bu & 7, mg = (bu >> 3) & 1, nt = (bu >> 4) & 15, b = bu >> 8, g = go * 8 + wave;
            if (mg) ssm_out_unit<1>(ubuf, (const bf16*)(ws + WS_A3), HB, lds, wave, g, b, nt, lane);
            else ssm_out_unit<0>(ubuf, (const bf16*)(ws + WS_A3), HB, lds, wave, g, b, nt, lane);
            __syncthreads();
#pragma unroll
            for (int it = 0; it < 8; ++it) { const int id = it * NTHR + tid, row = id >> 4, ch = id & 15, n = row >> 3, il = row & 7;
                const v4u v = *(LAS v4u*)(lds + row * 256 + ((ch ^ (n & 15)) * 16));
                *(v4u*)(ybuf + (size_t)(b * SEQ + (32 * nt + n) * CL + 8 * mg + il) * LDY + go * 128 + ch * 8) = v; }
            __syncthreads();
        }
    }
    SEAM();

    if (PH_ON(5)) {
        pg8::Gemm g{ybuf, Wglu_t, T, 2 * DM, SSMW, LDY, LDY}; pg8::GluPairOrder S; S.init(T, DM, G, bx);
        pg8::EpiGlu E{gates, msbuf};
        pg8::gemm_phase<pg8::EpiGlu, pg8::GluPairOrder, PG8_ALIGN, PG8_SP2>(lds, g, S, E);
    }
    __builtin_amdgcn_fence(__ATOMIC_ACQUIRE, "agent");
    asm volatile("s_waitcnt vmcnt(0)" ::: "memory");
    __syncthreads();

    if (PH_ON(6)) {
        pg8::Gemm g{attn, Wup_t, T, DM, AOW, LDATT, LDATT}; pg8::StaticOrder S; S.init(T, DM, G, bx);
        pg8::EpiMerge E{gates, msbuf};
        pg8::gemm_phase<pg8::EpiMerge, pg8::StaticOrder, PG8_ALIGN, PG8_SP2>(lds, g, S, E);
    }
    SEAM();

    if (PH_ON(7)) {
        pg8::Gemm g{msbuf, Wout_t, T, DM, DM, LDH, LDH}; pg8::PanelOrder S; S.init(G, bx);
        pg8::EpiNormMid E{a.x, (bf16*)(ws + WS_X1B), a.norm_mix_post, (float*)(ws + WS_ROWSS1), (unsigned*)(ws + WS_PCNT1), (float*)(ws + WS_ROWSS2)};
        pg8::gemm_phase<pg8::EpiNormMid, pg8::PanelOrder, PG8_ALIGN, PG8_SP2>(lds, g, S, E);
    }
    SEAM();

    if (PH_ON(9)) {
        pg8::Gemm g{(const bf16*)(ws + WS_X1B), Wffn_t, T, 2 * DFF, DM, DM, LDH}; pg8::StaticOrder S; S.init(T, 2 * DFF, G, bx, 1 + (((PH_DUP) >> 9) & 1));
        pg8::EpiFfn E{act, (const float*)(ws + WS_ROWSS2)};
        pg8::gemm_phase<pg8::EpiFfn, pg8::StaticOrder, PG8_ALIGN, PG8_SP2>(lds, g, S, E);
    }
    SEAM();

    if (PH_ON(10)) {
        pg8::Gemm g{act, Wdown_t, T, DM, DFF, LDACT, LDACT}; pg8::PanelOrder S; S.init(G, bx);
        pg8::EpiNormOut E{a.out, (const bf16*)(ws + WS_X1B), a.norm_ffn_post, (float*)(ws + WS_ROWSS), (unsigned*)(ws + WS_PCNT)};
        pg8::gemm_phase<pg8::EpiNormOut, pg8::PanelOrder, PG8_ALIGN, PG8_SP2>(lds, g, S, E);
    }
}

extern "C" void kernel_launch(void* const* d_in, const int* in_sizes, int n_in, void* d_out, int out_size, void* d_ws, size_t ws_size, hipStream_t stream) {
    static int grid = 0;
    if (grid == 0) {
        if (n_in != 21 || in_sizes[0] != T * DM || out_size != T * DM || ws_size < WS_END) { fprintf(stderr, "kernel_launch: unexpected shapes (n_in %d, in0 %d, out %d, ws %zu < %zu); nothing launched\n", n_in, n_in > 0 ? in_sizes[0] : -1, out_size, ws_size, (size_t)WS_END); grid = -1; return; }
        int dev = 0, cus = 0, per_cu = 0;
        if (hipGetDevice(&dev) != hipSuccess || hipDeviceGetAttribute(&cus, hipDeviceAttributeMultiprocessorCount, dev) != hipSuccess) { grid = -1; return; }
        if (hipFuncSetAttribute((const void*)mega_fwd, hipFuncAttributeMaxDynamicSharedMemorySize, LDS_BYTES) != hipSuccess) { fprintf(stderr, "kernel_launch: hipFuncSetAttribute failed\n"); grid = -1; return; }
        if (hipOccupancyMaxActiveBlocksPerMultiprocessor(&per_cu, (const void*)mega_fwd, NTHR, LDS_BYTES) != hipSuccess || per_cu < 1) { fprintf(stderr, "kernel_launch: occupancy query reports %d blocks per CU; nothing launched\n", per_cu); (void)hipGetLastError(); grid = -1; return; }
        grid = cus;
    }
    if (grid < 0) return;
    Args a{};
    a.x = (const float*)d_in[0]; a.norm_mix_pre = (const float*)d_in[1]; a.w_in = (const float*)d_in[2]; a.w_attn_up = (const float*)d_in[3];
    a.a_re = (const float*)d_in[4]; a.a_im = (const float*)d_in[5]; a.log_dt = (const float*)d_in[6]; a.b_re = (const float*)d_in[7]; a.b_im = (const float*)d_in[8];
    a.c_re = (const float*)d_in[9]; a.c_im = (const float*)d_in[10]; a.ssm_d = (const float*)d_in[11];
    a.w_glu_v = (const float*)d_in[12]; a.w_glu_g = (const float*)d_in[13]; a.w_out = (const float*)d_in[14]; a.norm_mix_post = (const float*)d_in[15]; a.norm_ffn_pre = (const float*)d_in[16];
    a.w_ffn_gate = (const float*)d_in[17]; a.w_ffn_up = (const float*)d_in[18]; a.w_ffn_down = (const float*)d_in[19]; a.norm_ffn_post = (const float*)d_in[20];
    a.out = (float*)d_out; a.ws = (unsigned char*)d_ws;
    if (hipMemsetAsync((char*)d_ws + WS_BAR, 0, WS_BAR_BYTES, stream) != hipSuccess) { fprintf(stderr, "kernel_launch: hipMemsetAsync failed\n"); return; }
    void* args[] = {&a};
    const hipError_t e = hipLaunchCooperativeKernel((const void*)mega_fwd, dim3(grid), dim3(NTHR), args, LDS_BYTES, stream);
    if (e != hipSuccess) fprintf(stderr, "kernel_launch: cooperative launch failed: %s (grid %d)\n", hipGetErrorString(e), grid);
}
```

```cpp
#include <hip/hip_runtime.h>
#include <hip/hip_cooperative_groups.h>
#include <cstdio>
#include <cstdint>
namespace cg = cooperative_groups;
namespace pg8 {
#define PG8_LAS __attribute__((address_space(3)))
typedef unsigned short bf16_t;
typedef short bf16x8 __attribute__((ext_vector_type(8)));
typedef float f32x4 __attribute__((ext_vector_type(4)));
typedef unsigned u32x4 __attribute__((ext_vector_type(4)));
constexpr int BM = 256, BK = 64, HALF = 128, HTB = HALF * BK * 2  , STAGE_BYTES = 8 * HTB, NXCD = 8, WGM = 8;

__host__ __device__ __forceinline__ int lds_byte(int r, int c) { const int st = (r >> 4) * 2 + (c >> 5), rr = r & 15, cc = c & 31, ob = rr * 64 + cc * 2; return st * 1024 + (ob ^ (((ob >> 9) & 1) << 5)); }
__host__ __device__ __forceinline__ void stage_rc(int b, int& R, int& C) { const int st = b / 1024, sb = b % 1024, swz = sb ^ (((sb >> 9) & 1) << 5); R = (st >> 1) * 16 + swz / 64; C = (st & 1) * 32 + (swz % 64) / 2; }
__host__ __device__ __forceinline__ int perm32(int rho) { const int n = rho >> 4, i = rho & 15; return 8 * (i >> 2) + 4 * n + (i & 3); }

struct Unit { int pm, pn; };
struct Gemm { const bf16_t* A; const bf16_t* Bt; int M, N, K, lda, ldb; };

struct StaticOrder {
    int nM, nN, nwg, G, c, rep;
    __host__ __device__ void init(int M, int N, int G_, int c_, int rep_ = 1) { nM = M / BM; nN = N / BM; nwg = nM * nN; G = G_; c = c_; rep = rep_; }
    __host__ __device__ bool next(int i, Unit& u) const {
        const long L = (long)i * G + c; if (L >= (long)nwg * rep) return false;
        int wgid = (int)(L % nwg); { const int q = nwg / NXCD, r = nwg % NXCD, xcd = wgid % NXCD, off = wgid / NXCD; wgid = (xcd < r ? xcd * (q + 1) : r * (q + 1) + (xcd - r) * q) + off; }
        const int nig = WGM * nN, gid = wgid / nig, fm = gid * WGM, gsz = (nM - fm) < WGM ? (nM - fm) : WGM;
        u.pm = fm + ((wgid % nig) % gsz); u.pn = (wgid % nig) / gsz; return true;
    }
    __device__ __forceinline__ void a_ready(const Unit&) const {}
    __device__ __forceinline__ void done(const Unit&) const {}
};

__device__ __forceinline__ unsigned cvt_pk_bf16(float lo, float hi) { unsigned r; asm volatile("v_cvt_pk_bf16_f32 %0, %1, %2" : "=v"(r) : "v"(lo), "v"(hi)); return r; }
typedef float f32x2 __attribute__((ext_vector_type(2)));
template <class Epi, class Sched, bool ALIGN_EPI = false, bool SP2 = false>
__device__ __forceinline__ void gemm_phase(PG8_LAS unsigned char* lds, const Gemm g, const Sched& S, const Epi& E) {
    int tid_ = threadIdx.x; asm volatile("" : "+v"(tid_));
    const int tid = tid_, wid = __builtin_amdgcn_readfirstlane(tid >> 6), lane = tid & 63, wr = wid >> 2, wc = wid & 3, fr = lane & 15, fq = lane >> 4;
    const int K = g.K, nt = K / BK;
    unsigned voffA[2], voffB[2];
#pragma unroll
    for (int i = 0; i < 2; ++i) { int R, C; stage_rc(tid * 16 + i * 8192, R, C); const int Rb = Epi::PERM ? ((R & ~31) + perm32(R & 31)) : R;
        voffA[i] = (unsigned)(R * g.lda + C) * 2u; voffB[i] = (unsigned)(Rb * g.ldb + C) * 2u; }
    const size_t kstep = (size_t)(BK * 2);
    const size_t hstepA = (size_t)HALF * g.lda * 2, hstepB = (size_t)HALF * g.ldb * 2;
    const size_t tstepA = 2 * hstepA, tstepB = 2 * hstepB;
    const unsigned ldsw = (unsigned)wid * 1024u;
    const int aoff = lds_byte(wr * 64 + fr, fq * 8), boff = lds_byte(wc * 32 + fr, fq * 8);
#define PG8_SA(b, h) (((b) * 2 + (h)) * HTB)
#define PG8_SB(b, h) ((4 + (b) * 2 + (h)) * HTB)
#define PG8_STAGE(bufoff, gbase, voff) do { _Pragma("unroll") for (int _i = 0; _i < 2; ++_i) \
        __builtin_amdgcn_global_load_lds((const unsigned*)((const char*)(gbase) + (voff)[_i]), (PG8_LAS unsigned*)(lds + (bufoff) + ldsw + _i * 8192), 16, 0, 0); } while (0)
#define PG8_LDA(dst, b, h) do { _Pragma("unroll") for (int m = 0; m < 4; ++m) _Pragma("unroll") for (int k = 0; k < 2; ++k) dst[m][k] = *(const PG8_LAS bf16x8*)(lds + PG8_SA(b, h) + aoff + m * 2048 + k * 1024); } while (0)
#define PG8_LDB(dst, b, h) do { _Pragma("unroll") for (int n = 0; n < 2; ++n) _Pragma("unroll") for (int k = 0; k < 2; ++k) dst[n][k] = *(const PG8_LAS bf16x8*)(lds + PG8_SB(b, h) + boff + n * 2048 + k * 1024); } while (0)
#define PG8_MMA(ai, bj, At, Bt) do { __builtin_amdgcn_s_setprio(1); _Pragma("unroll") for (int m = 0; m < 4; ++m) _Pragma("unroll") for (int n = 0; n < 2; ++n) _Pragma("unroll") for (int k = 0; k < 2; ++k) \
        acc[ai][bj][m][n] = __builtin_amdgcn_mfma_f32_16x16x32_bf16(Bt[n][k], At[m][k], acc[ai][bj][m][n], 0, 0, 0); __builtin_amdgcn_s_setprio(0); } while (0)
#define PG8_WAIT_V(n) asm volatile("s_waitcnt vmcnt(" #n ")" ::: "memory")
#define PG8_WAIT_L(n) asm volatile("s_waitcnt lgkmcnt(" #n ")" ::: "memory")
#define PG8_BAR __builtin_amdgcn_s_barrier()
#define PG8_SCHED __builtin_amdgcn_sched_barrier(0)
    Unit cur, nxt; int ui = 0;
    if (!S.next(0, cur)) return;
    f32x4 acc[2][2][4][2];
#pragma unroll
    for (int a = 0; a < 2; ++a)
#pragma unroll
        for (int b = 0; b < 2; ++b)
#pragma unroll
            for (int m = 0; m < 4; ++m)
#pragma unroll
                for (int n = 0; n < 2; ++n) acc[a][b][m][n] = (f32x4){0.f, 0.f, 0.f, 0.f};
    bf16x8 At[4][2], B0[2][2], B1[2][2];
    const char* cA = (const char*)g.A + (size_t)cur.pm * tstepA; const char* cB = (const char*)g.Bt + (size_t)cur.pn * tstepB;
    S.a_ready(cur);
    if constexpr (SP2) {
        PG8_STAGE(PG8_SB(0, 0), cB, voffB); PG8_STAGE(PG8_SB(0, 1), cB + hstepB, voffB); PG8_STAGE(PG8_SA(0, 0), cA, voffA); PG8_STAGE(PG8_SA(0, 1), cA + hstepA, voffA);
        if (wr == 1) PG8_BAR;
        PG8_WAIT_V(2); PG8_BAR;
        PG8_STAGE(PG8_SB(1, 0), cB + kstep, voffB); PG8_STAGE(PG8_SA(1, 0), cA + kstep, voffA); PG8_STAGE(PG8_SB(1, 1), cB + hstepB + kstep, voffB);
        PG8_WAIT_V(6); PG8_BAR;
    } else {
        PG8_STAGE(PG8_SB(0, 0), cB, voffB); PG8_STAGE(PG8_SA(0, 0), cA, voffA); PG8_STAGE(PG8_SB(0, 1), cB + hstepB, voffB); PG8_STAGE(PG8_SA(0, 1), cA + hstepA, voffA);
        if (wr == 1) PG8_BAR;
        PG8_WAIT_V(4); PG8_BAR;
        PG8_STAGE(PG8_SB(1, 0), cB + kstep, voffB); PG8_STAGE(PG8_SA(1, 0), cA + kstep, voffA); PG8_STAGE(PG8_SB(1, 1), cB + hstepB + kstep, voffB);
        PG8_WAIT_V(6); PG8_BAR;
    }
    for (;;) {
        const bool has_next = S.next(ui + 1, nxt);
        const char* nA = has_next ? (const char*)g.A + (size_t)nxt.pm * tstepA : cA; const char* nB = has_next ? (const char*)g.Bt + (size_t)nxt.pn * tstepB : cB;
        for (int t = 0; t < nt; t += 2) {
            const bool last = (t == nt - 2);
            const char* a1 = cA + (size_t)(t + 1) * kstep;
            const char* a2 = last ? nA : cA + (size_t)(t + 2) * kstep; const char* b2 = last ? nB : cB + (size_t)(t + 2) * kstep;
            const char* a3 = a2 + kstep; const char* b3 = b2 + kstep;
            if (last && has_next) S.a_ready(nxt);
            if constexpr (SP2) {
            PG8_LDB(B0, 0, 0); PG8_LDB(B1, 0, 1); PG8_SCHED; PG8_LDA(At, 0, 0); PG8_STAGE(PG8_SA(1, 1), a1 + hstepA, voffA);
            PG8_WAIT_V(8); PG8_WAIT_L(0); PG8_BAR; PG8_MMA(0, 0, At, B0); PG8_MMA(0, 1, At, B1); PG8_BAR; PG8_SCHED;
            PG8_LDA(At, 0, 1); PG8_STAGE(PG8_SB(0, 0), b2, voffB); PG8_STAGE(PG8_SB(0, 1), b2 + hstepB, voffB); PG8_STAGE(PG8_SA(0, 0), a2, voffA);
            PG8_WAIT_V(8); PG8_WAIT_L(0); PG8_BAR; PG8_MMA(1, 0, At, B0); PG8_MMA(1, 1, At, B1); PG8_BAR; PG8_SCHED;
            PG8_LDB(B0, 1, 0); PG8_LDB(B1, 1, 1); PG8_SCHED; PG8_LDA(At, 1, 0); PG8_STAGE(PG8_SA(0, 1), a2 + hstepA, voffA);
            PG8_WAIT_V(8); PG8_WAIT_L(0); PG8_BAR; PG8_MMA(0, 0, At, B0); PG8_MMA(0, 1, At, B1); PG8_BAR; PG8_SCHED;
            PG8_LDA(At, 1, 1); PG8_STAGE(PG8_SB(1, 0), b3, voffB); PG8_STAGE(PG8_SB(1, 1), b3 + hstepB, voffB); PG8_STAGE(PG8_SA(1, 0), a3, voffA);
            PG8_WAIT_V(8); PG8_WAIT_L(0); PG8_BAR; PG8_MMA(1, 0, At, B0); PG8_MMA(1, 1, At, B1); PG8_BAR; PG8_SCHED;
            } else {
            PG8_LDB(B0, 0, 0); PG8_SCHED; PG8_LDA(At, 0, 0); PG8_STAGE(PG8_SA(1, 1), a1 + hstepA, voffA);
            PG8_WAIT_L(8); PG8_BAR; PG8_WAIT_L(0); PG8_MMA(0, 0, At, B0); PG8_BAR; PG8_SCHED;
            PG8_LDB(B1, 0, 1); PG8_STAGE(PG8_SB(0, 0), b2, voffB);
            PG8_BAR; PG8_WAIT_L(0); PG8_MMA(0, 1, At, B1); PG8_BAR;
            PG8_LDA(At, 0, 1); PG8_STAGE(PG8_SA(0, 0), a2, voffA);
            PG8_BAR; PG8_WAIT_L(0); PG8_MMA(1, 0, At, B0); PG8_BAR; PG8_SCHED;
            PG8_STAGE(PG8_SB(0, 1), b2 + hstepB, voffB);
            PG8_WAIT_V(6); PG8_BAR; PG8_MMA(1, 1, At, B1); PG8_BAR;
            PG8_LDB(B0, 1, 0); PG8_SCHED; PG8_LDA(At, 1, 0); PG8_STAGE(PG8_SA(0, 1), a2 + hstepA, voffA);
            PG8_WAIT_L(8); PG8_BAR; PG8_WAIT_L(0); PG8_MMA(0, 0, At, B0); PG8_BAR; PG8_SCHED;
            PG8_LDB(B1, 1, 1); PG8_STAGE(PG8_SB(1, 0), b3, voffB);
            PG8_BAR; PG8_WAIT_L(0); PG8_MMA(0, 1, At, B1); PG8_BAR;
            PG8_LDA(At, 1, 1); PG8_STAGE(PG8_SA(1, 0), a3, voffA);
            PG8_BAR; PG8_WAIT_L(0); PG8_MMA(1, 0, At, B0); PG8_BAR; PG8_SCHED;
            PG8_STAGE(PG8_SB(1, 1), b3 + hstepB, voffB);
            PG8_WAIT_V(6); PG8_BAR; PG8_MMA(1, 1, At, B1); PG8_BAR;
            }
        }
        if constexpr (ALIGN_EPI) { if (wr == 0) PG8_BAR; }
        if constexpr (!Epi::AFTER_DRAIN) { E(acc, cur, wr, wc, fr, fq); S.done(cur); }
        if (!has_next) break;
#pragma unroll
        for (int a = 0; a < 2; ++a)
#pragma unroll
            for (int b = 0; b < 2; ++b)
#pragma unroll
                for (int m = 0; m < 4; ++m)
#pragma unroll
                    for (int n = 0; n < 2; ++n) acc[a][b][m][n] = (f32x4){0.f, 0.f, 0.f, 0.f};
        cur = nxt; cA = nA; cB = nB; ++ui;
        if constexpr (ALIGN_EPI) { if (wr == 1) PG8_BAR; }
    }
    PG8_WAIT_V(0);
    if constexpr (!ALIGN_EPI) { if (wr == 0) PG8_BAR; }
    PG8_BAR;
    if constexpr (Epi::AFTER_DRAIN) { E.fused(acc, cur, wr, wc, fr, fq, lds, wid, lane); S.done(cur); }
#undef PG8_SA
#undef PG8_SB
#undef PG8_STAGE
#undef PG8_LDA
#undef PG8_LDB
#undef PG8_MMA
#undef PG8_WAIT_V
#undef PG8_WAIT_L
#undef PG8_BAR
#undef PG8_SCHED
}
}
#ifndef PG8_SP2
#define PG8_SP2 true
#endif
#ifndef PG8_ALIGN
#define PG8_ALIGN true
#endif

constexpr int BATCH = 2, SEQ = 8192, DM = 2048, T = BATCH * SEQ;
constexpr int HD = 128, NH = 12, HQ = 1536, SSMW = 1024, NG = 64, NP = 64, NC = 16;
constexpr int DFF = 5632, INW = 9728, QKVU = 5632, NGATE = INW - QKVU, AOW = 512;
constexpr int CL = 16, NCHUNK = SEQ / CL;
constexpr int A3W = CL * NC + 2 * NP;
constexpr float EPS = 1e-6f, LOG2E = 1.4426950408889634f;
constexpr int NWAVES = 8, NTHR = 512;
constexpr int PADE = 64;
constexpr int LDH = DM + PADE, LDQ = 3 * HQ + PADE, LDACT = DFF + PADE, LDATT = AOW + PADE, LDY = SSMW + PADE;

constexpr size_t WS_ROWSS1 = 196608, WS_ROWSS2 = 262144, WS_PCNT1 = 327680, WS_PCNT2 = 344064;
constexpr size_t WS_ROWSS = 65536, WS_PCNT = 131072;
constexpr size_t WS_BAR = 4096, WS_BAR_BYTES = 16384;
constexpr size_t WS_WFFN = 1u << 20;
constexpr size_t WS_WDOWN = WS_WFFN + (size_t)2 * DFF * LDH * 2;
constexpr size_t WS_WOUT = WS_WDOWN + (size_t)DM * LDACT * 2;
constexpr size_t WS_WIN = WS_WOUT + (size_t)DM * LDH * 2;
constexpr size_t WS_WUP = WS_WIN + (size_t)INW * LDH * 2;
constexpr size_t WS_WGLU = WS_WUP + (size_t)DM * LDATT * 2;
constexpr size_t WS_A3 = WS_WGLU + (size_t)2 * DM * LDY * 2;
constexpr size_t WS_WT = WS_A3 + (size_t)NG * 256 * A3W * 2;
constexpr size_t WS_LAML = WS_WT + (size_t)NG * 128 * 256 * 2;
constexpr size_t WS_X1B = WS_WIN;
static_assert(WS_X1B + (size_t)T * DM * 2 <= WS_LAML, "x1 overlay fits in the dead weight/table region");
constexpr size_t WS_RA = WS_LAML + 65536;
constexpr size_t WS_UB = WS_RA + (size_t)T * LDQ * 2;
constexpr size_t WS_RH = WS_RA + (size_t)T * LDACT * 2;
static_assert(WS_UB + (size_t)T * SSMW * 2 <= WS_RH, "u buffer fits behind qkv");
constexpr size_t WS_ATTN = WS_RH, WS_Y = WS_RH + (size_t)T * LDATT * 2;
static_assert(WS_Y + (size_t)T * LDY * 2 <= WS_RH + (size_t)T * LDH * 2, "attn + y fit in the h region");
constexpr size_t WS_RF = WS_RH + (size_t)T * LDH * 2;
constexpr size_t WS_OPART = WS_RF, WS_LSE = WS_OPART + (size_t)T * NH * HD * 2, WS_E = WS_LSE + (size_t)T * NH * 4;
constexpr size_t WS_HB = WS_E + (size_t)BATCH * NCHUNK * NG * 128 * 4, WS_END = WS_HB + (size_t)BATCH * NCHUNK * NG * 128 * 2;
static_assert(WS_END <= 536870912ull, "d_ws map exceeds 512 MiB");
static_assert(WS_RF + (size_t)T * LDH * 2 <= WS_END, "ms/f fit in the partials region");

constexpr int RING_BYTES = 131072, LDS_BYTES = 147456;

#define GAS __attribute__((address_space(1)))
#define LAS __attribute__((address_space(3)))
typedef unsigned short bf16;
typedef unsigned v4u __attribute__((ext_vector_type(4)));
typedef unsigned v2u __attribute__((ext_vector_type(2)));
typedef float f32x4 __attribute__((ext_vector_type(4)));
typedef float f32x16 __attribute__((ext_vector_type(16)));
typedef short bf16x8 __attribute__((ext_vector_type(8)));
typedef short v4i16_t __attribute__((ext_vector_type(4)));
typedef float f32x2_t __attribute__((ext_vector_type(2)));
typedef __bf16 bf16x2_t __attribute__((ext_vector_type(2)));

__device__ __forceinline__ unsigned pk2(float lo, float hi) { f32x2_t v = {lo, hi}; bf16x2_t b = __builtin_convertvector(v, bf16x2_t); return __builtin_bit_cast(unsigned, b); }
__device__ __forceinline__ float bflo(unsigned w) { return __uint_as_float(w << 16); }
__device__ __forceinline__ float bfhi(unsigned w) { return __uint_as_float(w & 0xffff0000u); }
__device__ __forceinline__ float sigmoidf_(float x) { return __builtin_amdgcn_rcpf(1.0f + __expf(-x)); }
__device__ __forceinline__ float gelu_tanh(float x) { const float z = 0.7978845608028654f * (x + 0.044715f * x * x * x); const float e = __expf(2.0f * z); return 0.5f * x * (2.0f - 2.0f * __builtin_amdgcn_rcpf(1.0f + e)); }
__device__ __forceinline__ float wave_sum(float v) {
#pragma unroll
    for (int o = 1; o < 64; o <<= 1) v += __shfl_xor(v, o);
    return v;
}
__device__ __forceinline__ int crow(int reg, int h) { return (reg & 3) + 8 * (reg >> 2) + 4 * h; }
#define MFMA32(a, b, c) __builtin_amdgcn_mfma_f32_32x32x16_bf16((a), (b), (c), 0, 0, 0)

namespace pg8 {
__device__ __forceinline__ u32x4 pack8(const f32x4 v0, const f32x4 v1) { u32x4 w; w.x = pk2(v0[0], v0[1]); w.y = pk2(v0[2], v0[3]); w.z = pk2(v1[0], v1[1]); w.w = pk2(v1[2], v1[3]); return w; }
__device__ __forceinline__ void unpack8(const u32x4 w, f32x4& v0, f32x4& v1) { v0 = (f32x4){bflo(w.x), bfhi(w.x), bflo(w.y), bfhi(w.y)}; v1 = (f32x4){bflo(w.z), bfhi(w.z), bflo(w.w), bfhi(w.w)}; }
__device__ __forceinline__ size_t gaddr(size_t row, int col) { return ((row >> 4) * (size_t)(NGATE / 8) + (size_t)(col >> 3)) * 128 + (row & 15) * 8; }
__device__ __forceinline__ f32x4 sig4(const f32x4 v) { return (f32x4){sigmoidf_(v[0]), sigmoidf_(v[1]), sigmoidf_(v[2]), sigmoidf_(v[3])}; }

struct EpiPlain {
    static constexpr bool PERM = true, AFTER_DRAIN = false;
    bf16_t* O; int ldc;
    __device__ __forceinline__ void operator()(const f32x4 (&acc)[2][2][4][2], const Unit& u, int wr, int wc, int fr, int fq) const {
        const int row0 = u.pm * BM + wr * 64 + fr, col0 = u.pn * BM + wc * 32 + 8 * fq;
#pragma unroll
        for (int ai = 0; ai < 2; ++ai)
#pragma unroll
            for (int m = 0; m < 4; ++m) { bf16_t* rowp = O + (size_t)(row0 + ai * HALF + m * 16) * ldc + col0;
#pragma unroll
                for (int bj = 0; bj < 2; ++bj) __builtin_nontemporal_store(pack8(acc[ai][bj][m][0], acc[ai][bj][m][1]), (u32x4*)(rowp + bj * HALF)); }
    }
};
struct EpiIn {
    static constexpr bool PERM = true, AFTER_DRAIN = false;
    bf16_t* qkv; bf16_t* ubuf; bf16_t* gates;
    __device__ __forceinline__ void operator()(const f32x4 (&acc)[2][2][4][2], const Unit& u, int wr, int wc, int fr, int fq) const {
        const int row0 = u.pm * BM + wr * 64 + fr; const int colt = u.pn * BM;
        if (colt < 3 * HQ) {
            const int col0 = colt + wc * 32 + 8 * fq;
#pragma unroll
            for (int ai = 0; ai < 2; ++ai)
#pragma unroll
                for (int m = 0; m < 4; ++m) { bf16_t* rowp = qkv + (size_t)(row0 + ai * HALF + m * 16) * LDQ + col0;
#pragma unroll
                    for (int bj = 0; bj < 2; ++bj) __builtin_nontemporal_store(pack8(acc[ai][bj][m][0], acc[ai][bj][m][1]), (u32x4*)(rowp + bj * HALF)); }
        } else if (colt < QKVU) {
            const int uc0 = colt - 3 * HQ + wc * 32 + 8 * fq;
#pragma unroll
            for (int ai = 0; ai < 2; ++ai)
#pragma unroll
                for (int m = 0; m < 4; ++m) { const int row = row0 + ai * HALF + m * 16, b = row / SEQ, t = row % SEQ;
#pragma unroll
                    for (int bj = 0; bj < 2; ++bj) { const int uc = uc0 + bj * HALF;
                        __builtin_nontemporal_store(pack8(acc[ai][bj][m][0], acc[ai][bj][m][1]), (u32x4*)(ubuf + (((((size_t)(b * NG + (uc >> 4))) * 16 + (t >> 9)) * 16 + (t & 15)) * 32 + ((t >> 4) & 31)) * NC + (uc & 15))); } }
        } else {
            const int col0 = colt - QKVU + wc * 32 + 8 * fq;
#pragma unroll
            for (int ai = 0; ai < 2; ++ai)
#pragma unroll
                for (int m = 0; m < 4; ++m) { const size_t row = (size_t)(row0 + ai * HALF + m * 16);
#pragma unroll
                    for (int bj = 0; bj < 2; ++bj) __builtin_nontemporal_store(pack8(sig4(acc[ai][bj][m][0]), sig4(acc[ai][bj][m][1])), (u32x4*)(gates + gaddr(row, col0 + bj * HALF))); }
        }
    }
};
struct EpiGlu {
    static constexpr bool PERM = true, AFTER_DRAIN = false;
    const bf16_t* gates; bf16_t* ms;
    __device__ __forceinline__ void operator()(const f32x4 (&acc)[2][2][4][2], const Unit& u, int wr, int wc, int fr, int fq) const {
        const int row0 = u.pm * BM + wr * 64 + fr, col0 = u.pn * HALF + wc * 32 + 8 * fq;
#pragma unroll
        for (int ai = 0; ai < 2; ++ai)
#pragma unroll
            for (int m = 0; m < 4; ++m) { const size_t row = (size_t)(row0 + ai * HALF + m * 16);
                f32x4 g0, g1; unpack8(*(const u32x4*)(gates + gaddr(row, DM + col0)), g0, g1);
                const f32x4 v0 = acc[ai][0][m][0] * sig4(acc[ai][1][m][0]) * g0, v1 = acc[ai][0][m][1] * sig4(acc[ai][1][m][1]) * g1;
                __builtin_nontemporal_store(pack8(v0, v1), (u32x4*)(ms + row * LDH + col0)); }
    }
};
struct EpiMerge {
    static constexpr bool PERM = true, AFTER_DRAIN = false;
    const bf16_t* gates; bf16_t* ms;
    __device__ __forceinline__ void operator()(const f32x4 (&acc)[2][2][4][2], const Unit& u, int wr, int wc, int fr, int fq) const {
        const int row0 = u.pm * BM + wr * 64 + fr, col0 = u.pn * BM + wc * 32 + 8 * fq;
#pragma unroll
        for (int ai = 0; ai < 2; ++ai)
#pragma unroll
            for (int m = 0; m < 4; ++m) { const size_t row = (size_t)(row0 + ai * HALF + m * 16);
#pragma unroll
                for (int bj = 0; bj < 2; ++bj) { const int col = col0 + bj * HALF;
                    f32x4 g0, g1, s0, s1; unpack8(*(const u32x4*)(gates + gaddr(row, col)), g0, g1); unpack8(*(const u32x4*)(ms + row * LDH + col), s0, s1);
                    __builtin_nontemporal_store(pack8(g0 * acc[ai][bj][m][0] + s0, g1 * acc[ai][bj][m][1] + s1), (u32x4*)(ms + row * LDH + col)); } }
    }
};
struct EpiFfn {
    static constexpr bool PERM = true, AFTER_DRAIN = false, REMAP = false;
    bf16_t* act; const float* rowss;
    __device__ __forceinline__ void operator()(const f32x4 (&acc)[2][2][4][2], const Unit& u, int wr, int wc, int fr, int fq) const {
        const int row0 = u.pm * BM + wr * 64 + fr, col0 = u.pn * HALF + wc * 32 + 8 * fq;
#pragma unroll
        for (int ai = 0; ai < 2; ++ai)
#pragma unroll
            for (int m = 0; m < 4; ++m) { const size_t row = (size_t)(row0 + ai * HALF + m * 16);
                const float r = rsqrtf(rowss[row] * (1.f / DM) + EPS);
                const f32x4 a0 = acc[ai][0][m][0] * r, a1 = acc[ai][0][m][1] * r;
                __builtin_nontemporal_store(pack8(a0 * sig4(a0) * (acc[ai][1][m][0] * r), a1 * sig4(a1) * (acc[ai][1][m][1] * r)), (u32x4*)(act + row * LDACT + col0)); }
    }
};
struct PanelOrder {
    int G, vcu;
    __device__ void init(int G_, int bx) { G = G_; vcu = (G_ % 8 == 0) ? (bx % 8) * (G_ / 8) + bx / 8 : bx; }
    __device__ bool next(int i, Unit& u) const { const int L = i * G + vcu; if (L >= (T / BM) * (DM / BM)) return false; u.pm = L >> 3; u.pn = L & 7; return true; }
    __device__ __forceinline__ void a_ready(const Unit&) const {}
    __device__ __forceinline__ void done(const Unit&) const {}
};
struct EpiNormOut {
    static constexpr bool PERM = true, AFTER_DRAIN = false, REMAP = false;
    float* out; const bf16_t* x1b; const float* gain; float* rowss; unsigned* pcnt;
    __device__ __forceinline__ void operator()(const f32x4 (&acc)[2][2][4][2], const Unit& u, int wr, int wc, int fr, int fq) const {
        const int row0 = u.pm * BM + wr * 64 + fr;
#pragma unroll
        for (int ai = 0; ai < 2; ++ai)
#pragma unroll
            for (int m = 0; m < 4; ++m) { float q = 0.f;
#pragma unroll
                for (int bj = 0; bj < 2; ++bj)
#pragma unroll
                    for (int n = 0; n < 2; ++n) { const f32x4 v = acc[ai][bj][m][n]; q += (v[0] * v[0] + v[1] * v[1]) + (v[2] * v[2] + v[3] * v[3]); }
                q += __shfl_xor(q, 16); q += __shfl_xor(q, 32);
                if (fq == 0) { const float old = __hip_atomic_fetch_add(rowss + row0 + ai * HALF + m * 16, q, __ATOMIC_RELAXED, __HIP_MEMORY_SCOPE_AGENT); asm volatile("" :: "v"(old)); } }
        asm volatile("s_waitcnt vmcnt(0)" ::: "memory");
        unsigned* cw = pcnt + 64 * u.pm;
        if ((threadIdx.x & 63) == 0) (void)__hip_atomic_fetch_add(cw, 1u, __ATOMIC_RELAXED, __HIP_MEMORY_SCOPE_AGENT);
        { unsigned sp = 0; while ((unsigned)__builtin_amdgcn_readfirstlane(__hip_atomic_load(cw, __ATOMIC_RELAXED, __HIP_MEMORY_SCOPE_AGENT)) < 64u) { __builtin_amdgcn_s_sleep(2); if (++sp > (1u << 20)) break; } }
        asm volatile("" ::: "memory");
        const int col0 = u.pn * BM + wc * 32 + 8 * fq;
#pragma unroll
        for (int ai = 0; ai < 2; ++ai)
#pragma unroll
            for (int m = 0; m < 4; ++m) { const int row = row0 + ai * HALF + m * 16;
                const float rstd = rsqrtf(__hip_atomic_load(rowss + row, __ATOMIC_RELAXED, __HIP_MEMORY_SCOPE_AGENT) * (1.f / DM) + EPS);
#pragma unroll
                for (int bj = 0; bj < 2; ++bj) { float* op = out + (size_t)row * DM + col0 + bj * HALF; const float* gp = gain + col0 + bj * HALF;
                    f32x4 x0, x1; unpack8(*(const u32x4*)(x1b + (size_t)row * DM + col0 + bj * HALF), x0, x1); const f32x4 g0 = *(const f32x4*)gp, g1 = *(const f32x4*)(gp + 4);
                    __builtin_nontemporal_store(x0 + acc[ai][bj][m][0] * rstd * g0, (f32x4*)op); __builtin_nontemporal_store(x1 + acc[ai][bj][m][1] * rstd * g1, (f32x4*)(op + 4)); } }
    }
};
struct EpiNormMid {
    static constexpr bool PERM = true, AFTER_DRAIN = false, REMAP = false;
    const float* x; bf16_t* x1o; const float* gpost; float* rowss1; unsigned* pcnt1; float* rowss2;
    __device__ __forceinline__ static void arrive_wait(unsigned* cw) {
        asm volatile("s_waitcnt vmcnt(0)" ::: "memory");
        if ((threadIdx.x & 63) == 0) (void)__hip_atomic_fetch_add(cw, 1u, __ATOMIC_RELAXED, __HIP_MEMORY_SCOPE_AGENT);
        unsigned sp = 0; while ((unsigned)__builtin_amdgcn_readfirstlane(__hip_atomic_load(cw, __ATOMIC_RELAXED, __HIP_MEMORY_SCOPE_AGENT)) < 64u) { __builtin_amdgcn_s_sleep(2); if (++sp > (1u << 20)) break; }
        asm volatile("" ::: "memory");
    }
    __device__ __forceinline__ void operator()(const f32x4 (&acc_)[2][2][4][2], const Unit& u, int wr, int wc, int fr, int fq) const {
        f32x4 (&acc)[2][2][4][2] = const_cast<f32x4 (&)[2][2][4][2]>(acc_);
        const int row0 = u.pm * BM + wr * 64 + fr, col0 = u.pn * BM + wc * 32 + 8 * fq;
#pragma unroll
        for (int ai = 0; ai < 2; ++ai)
#pragma unroll
            for (int m = 0; m < 4; ++m) { float q = 0.f;
#pragma unroll
                for (int bj = 0; bj < 2; ++bj)
#pragma unroll
                    for (int n = 0; n < 2; ++n) { const f32x4 v = acc[ai][bj][m][n]; q += (v[0] * v[0] + v[1] * v[1]) + (v[2] * v[2] + v[3] * v[3]); }
                q += __shfl_xor(q, 16); q += __shfl_xor(q, 32);
                if (fq == 0) { const float old = __hip_atomic_fetch_add(rowss1 + row0 + ai * HALF + m * 16, q, __ATOMIC_RELAXED, __HIP_MEMORY_SCOPE_AGENT); asm volatile("" :: "v"(old)); } }
        arrive_wait(pcnt1 + 64 * u.pm);
#pragma unroll
        for (int ai = 0; ai < 2; ++ai)
#pragma unroll
            for (int m = 0; m < 4; ++m) { const int row = row0 + ai * HALF + m * 16; float q = 0.f;
                const float rstd = rsqrtf(__hip_atomic_load(rowss1 + row, __ATOMIC_RELAXED, __HIP_MEMORY_SCOPE_AGENT) * (1.f / DM) + EPS);
#pragma unroll
                for (int bj = 0; bj < 2; ++bj) { const size_t off = (size_t)row * DM + col0 + bj * HALF; const float* gp = gpost + col0 + bj * HALF;
                    const f32x4 x0 = __builtin_nontemporal_load((const f32x4*)(x + off)), x1 = __builtin_nontemporal_load((const f32x4*)(x + off + 4)), g0 = *(const f32x4*)gp, g1 = *(const f32x4*)(gp + 4);
                    const f32x4 v0 = x0 + acc[ai][bj][m][0] * rstd * g0, v1 = x1 + acc[ai][bj][m][1] * rstd * g1;
                    acc[ai][bj][m][0] = v0; acc[ai][bj][m][1] = v1;
                    *(u32x4*)(x1o + off) = pack8(v0, v1);
                    q += (v0[0] * v0[0] + v0[1] * v0[1]) + (v0[2] * v0[2] + v0[3] * v0[3]) + (v1[0] * v1[0] + v1[1] * v1[1]) + (v1[2] * v1[2] + v1[3] * v1[3]); }
                q += __shfl_xor(q, 16); q += __shfl_xor(q, 32);
                if (fq == 0) { const float old = __hip_atomic_fetch_add(rowss2 + row, q, __ATOMIC_RELAXED, __HIP_MEMORY_SCOPE_AGENT); asm volatile("" :: "v"(old)); } }
    }
};
}

struct Args {
    const float* x; const float* norm_mix_pre; const float* w_in; const float* w_attn_up;
    const float* a_re; const float* a_im; const float* log_dt; const float* b_re; const float* b_im; const float* c_re; const float* c_im; const float* ssm_d;
    const float* w_glu_v; const float* w_glu_g; const float* w_out; const float* norm_mix_post; const float* norm_ffn_pre;
    const float* w_ffn_gate; const float* w_ffn_up; const float* w_ffn_down; const float* norm_ffn_post;
    float* out; unsigned char* ws;
};

struct TrItem { const float* W; bf16* WT; const float* kg; int K, N, k0, n0, drow0; };
__device__ __forceinline__ void tr_load(const TrItem& t, float (&wv)[32], int lane) {
#pragma unroll
    for (int i = 0; i < 32; ++i) { const int kk = 2 * i + (lane >> 5); wv[i] = __builtin_nontemporal_load(t.W + (size_t)(t.k0 + kk) * t.N + t.n0 + (lane & 31)); }
    if (t.kg) {
#pragma unroll
        for (int i = 0; i < 32; ++i) wv[i] *= t.kg[t.k0 + 2 * i + (lane >> 5)]; }
}
__device__ __forceinline__ void tr_finish(const TrItem& t, const float (&wv)[32], LAS float* scr, int lane) {
    const int ldb = t.K + PADE;
#pragma unroll
    for (int i = 0; i < 32; ++i) { const int kk = 2 * i + (lane >> 5); scr[kk * 33 + (lane & 31)] = wv[i]; }
    asm volatile("s_waitcnt lgkmcnt(0)" ::: "memory");
    const int c = lane & 7;
#pragma unroll
    for (int j = 0; j < 4; ++j) { const int n = (lane >> 3) + 8 * j; const LAS float* s = scr + (8 * c) * 33 + n;
        v4u o; o.x = pk2(s[0 * 33], s[1 * 33]); o.y = pk2(s[2 * 33], s[3 * 33]); o.z = pk2(s[4 * 33], s[5 * 33]); o.w = pk2(s[6 * 33], s[7 * 33]);
        *(v4u*)(t.WT + (size_t)(t.drow0 + n) * ldb + t.k0 + 8 * c) = o; }
    asm volatile("s_waitcnt lgkmcnt(0)" ::: "memory");
}
__device__ __forceinline__ TrItem tr_make(const float* W, int K, int N, bf16* WT, int mode, int item, const float* kg = nullptr) {
    const int nblk = N / 32, kb = item / nblk, nb = item % nblk, n0 = 32 * nb;
    TrItem t; t.W = W; t.WT = WT; t.kg = kg; t.K = K; t.N = N; t.k0 = 64 * kb; t.n0 = n0; t.drow0 = (mode == 0) ? n0 : ((n0 >> 7) * 256 + (mode - 1) * 128 + (n0 & 127));
    return t;
}
__device__ __forceinline__ void p0_transpose(const float* W, int K, int N, bf16* WT, int mode, int item, LAS float* scr, int lane, const float* kg = nullptr) {
    const TrItem t = tr_make(W, K, N, WT, mode, item, kg); float wv[32]; tr_load(t, wv, lane); tr_finish(t, wv, scr, lane);
}
__device__ __forceinline__ void rms_row_to_bf16(const float* xrow, const float* gain, bf16* orow, int lane) {
    f32x4 v[8]; float s = 0.f;
#pragma unroll
    for (int j = 0; j < 8; ++j) { v[j] = *(const f32x4*)(xrow + 4 * (lane + 64 * j)); s += (v[j].x * v[j].x + v[j].y * v[j].y) + (v[j].z * v[j].z + v[j].w * v[j].w); }
    const float rstd = rsqrtf(wave_sum(s) * (1.f / DM) + EPS);
#pragma unroll
    for (int j = 0; j < 8; ++j) { const f32x4 g = *(const f32x4*)(gain + 4 * (lane + 64 * j)); v2u o; o.x = pk2(v[j].x * rstd * g.x, v[j].y * rstd * g.y); o.y = pk2(v[j].z * rstd * g.z, v[j].w * rstd * g.w);
        *(v2u*)(orow + 4 * (lane + 64 * j)) = o; }
}

__device__ __forceinline__ void rms_row2_to_bf16(const float* x0, const float* x1, const float* gain, bf16* o0, bf16* o1, int lane) {
    f32x4 v[8], w[8]; float s = 0.f, q = 0.f;
#pragma unroll
    for (int j = 0; j < 8; ++j) { v[j] = __builtin_nontemporal_load((const f32x4*)(x0 + 4 * (lane + 64 * j))); w[j] = __builtin_nontemporal_load((const f32x4*)(x1 + 4 * (lane + 64 * j))); }
#pragma unroll
    for (int j = 0; j < 8; ++j) { s += (v[j].x * v[j].x + v[j].y * v[j].y) + (v[j].z * v[j].z + v[j].w * v[j].w); q += (w[j].x * w[j].x + w[j].y * w[j].y) + (w[j].z * w[j].z + w[j].w * w[j].w); }
    const float rs = rsqrtf(wave_sum(s) * (1.f / DM) + EPS), rq = rsqrtf(wave_sum(q) * (1.f / DM) + EPS);
#pragma unroll
    for (int j = 0; j < 8; ++j) { const f32x4 g = *(const f32x4*)(gain + 4 * (lane + 64 * j));
        v2u a; a.x = pk2(v[j].x * rs * g.x, v[j].y * rs * g.y); a.y = pk2(v[j].z * rs * g.z, v[j].w * rs * g.w); *(v2u*)(o0 + 4 * (lane + 64 * j)) = a;
        v2u b; b.x = pk2(w[j].x * rq * g.x, w[j].y * rq * g.y); b.y = pk2(w[j].z * rq * g.z, w[j].w * rq * g.w); *(v2u*)(o1 + 4 * (lane + 64 * j)) = b; }
}
__device__ __forceinline__ void ssm_tables(const Args& a, int g, LAS unsigned char* lds, int tid) {
    LAS float* pw = (LAS float*)lds;
    LAS float* beta = pw + 64 * 17 * 2;
    LAS float* gam = beta + 64 * 16 * 2;
    LAS float* kt = gam + 16 * 64 * 2;
    unsigned char* ws = a.ws;
    if (tid < 64) {
        const int p = tid;
        const double dt = exp((double)a.log_dt[g]);
        const double are = (double)a.a_re[g * NP + p], aim = (double)a.a_im[g * NP + p];
        const double mag = exp(are * dt), ang = aim * dt;
        const double lr = mag * cos(ang), li = mag * sin(ang);
        const double den = are * are + aim * aim;
        const double cr = ((lr - 1.0) * are + li * aim) / den, ci = (li * are - (lr - 1.0) * aim) / den;
        double pr = 1.0, pi = 0.0;
        for (int d = 0; d <= CL; ++d) { pw[(p * 17 + d) * 2] = (float)pr; pw[(p * 17 + d) * 2 + 1] = (float)pi; const double nr = pr * lr - pi * li, ni = pr * li + pi * lr; pr = nr; pi = ni; }
        for (int c = 0; c < NC; ++c) { const double br = (double)a.b_re[(g * NP + p) * NC + c], bi = (double)a.b_im[(g * NP + p) * NC + c];
            beta[(p * 16 + c) * 2] = (float)(cr * br - ci * bi); beta[(p * 16 + c) * 2 + 1] = (float)(cr * bi + ci * br); }
        float* lamL = (float*)(ws + WS_LAML) + (g * NP + p) * 2;
        lamL[0] = pw[(p * 17 + CL) * 2]; lamL[1] = pw[(p * 17 + CL) * 2 + 1];
    }
    for (int idx = tid; idx < NC * NP; idx += NTHR) { gam[idx * 2] = a.c_re[g * NC * NP + idx]; gam[idx * 2 + 1] = a.c_im[g * NC * NP + idx]; }
    __syncthreads();
    for (int e = tid; e < CL * 256; e += NTHR) {
        const int d = e >> 8, c = (e >> 4) & 15, c2 = e & 15; float s = 0.f;
        for (int p = 0; p < NP; ++p) { const float gr = gam[(c * 64 + p) * 2], gi = gam[(c * 64 + p) * 2 + 1], wr_ = pw[(p * 17 + d) * 2], wi_ = pw[(p * 17 + d) * 2 + 1], br = beta[(p * 16 + c2) * 2], bi = beta[(p * 16 + c2) * 2 + 1];
            const float zr = gr * wr_ - gi * wi_, zi = gr * wi_ + gi * wr_; s += zr * br - zi * bi; }
        if (d == 0 && c == c2) s += a.ssm_d[g * NC + c];
        kt[e] = s;
    }
    __syncthreads();
    bf16* A3 = (bf16*)(ws + WS_A3) + (size_t)g * 256 * A3W;
    for (int cidx = tid; cidx < 256 * (A3W / 8); cidx += NTHR) {
        const int row = cidx / (A3W / 8), cc = cidx % (A3W / 8), i = row >> 4, c = row & 15; float v[8];
        if (cc < 32) { const int j = cc >> 1, c0 = (cc & 1) * 8;
#pragma unroll
            for (int e = 0; e < 8; ++e) v[e] = (j <= i) ? kt[((i - j) * 16 + c) * 16 + c0 + e] : 0.f;
        } else { const int pidx0 = (cc - 32) * 8, part = pidx0 >> 6, p0 = pidx0 & 63;
#pragma unroll
            for (int e = 0; e < 8; ++e) { const int p = p0 + e; const float gr = gam[(c * 64 + p) * 2], gi = gam[(c * 64 + p) * 2 + 1], wr_ = pw[(p * 17 + i + 1) * 2], wi_ = pw[(p * 17 + i + 1) * 2 + 1];
                v[e] = part ? -(gr * wi_ + gi * wr_) : (gr * wr_ - gi * wi_); }
        }
        v4u o; o.x = pk2(v[0], v[1]); o.y = pk2(v[2], v[3]); o.z = pk2(v[4], v[5]); o.w = pk2(v[6], v[7]);
        *(v4u*)(A3 + ((((size_t)(row >> 5)) * 24 + (cc >> 1)) * 64 + ((cc & 1) * 32 + (row & 31))) * 8) = o;
    }
    bf16* WTt = (bf16*)(ws + WS_WT) + (size_t)g * 128 * 256;
    for (int cidx = tid; cidx < 128 * 32; cidx += NTHR) {
        const int row = cidx >> 5, cc = cidx & 31, part = row >> 6, p = row & 63, j = cc >> 1, c0 = (cc & 1) * 8; float v[8];
        const float wr_ = pw[(p * 17 + (CL - 1 - j)) * 2], wi_ = pw[(p * 17 + (CL - 1 - j)) * 2 + 1];
#pragma unroll
        for (int e = 0; e < 8; ++e) { const float br = beta[(p * 16 + c0 + e) * 2], bi = beta[(p * 16 + c0 + e) * 2 + 1]; v[e] = part ? (wr_ * bi + wi_ * br) : (wr_ * br - wi_ * bi); }
        v4u o; o.x = pk2(v[0], v[1]); o.y = pk2(v[2], v[3]); o.z = pk2(v[4], v[5]); o.w = pk2(v[6], v[7]);
        *(v4u*)(WTt + ((((size_t)(row >> 5)) * 16 + (cc >> 1)) * 64 + ((cc & 1) * 32 + (row & 31))) * 8) = o;
    }
    __syncthreads();
}

__device__ __forceinline__ unsigned voff_b(int row, int ch) { return 256u * row + 16u * (ch ^ (((row & 3) << 2) | ((row >> 2) & 3))); }
__device__ __forceinline__ v4i16_t trrd(LAS unsigned char* p) { return __builtin_amdgcn_ds_read_tr16_b64_v4i16((LAS v4i16_t*)p); }
__device__ __forceinline__ void attn_wave_tile(const bf16* qkvu, bf16* opart, float* lse, int b, int h, int tile, LAS unsigned char* vl, int lane) {
    asm volatile("" : "+v"(lane));
    const int g = h >> 2, dl = 2 * g;
    const int tps = (SEQ >> dl) >> 5, res = tile / tps, m0 = (tile % tps) * 32;
    const int r32 = lane & 31, hi = lane >> 5;
    const float sl2 = exp2f(-8.0f * (float)(h + 1) / 12.0f) * LOG2E * (float)(1 << dl);
    const float sc2 = LOG2E * 0.08838834764831845f;
    const bf16* base = qkvu + (size_t)(b * SEQ + res) * LDQ + h * HD;
    const bf16* qrow = base + ((size_t)(m0 + r32) << dl) * LDQ;
    LAS unsigned char* kl = vl + 8192;
    const int lrow = lane >> 4, lch = lane & 15;
    v4u kst[8];
#pragma unroll
    for (int it = 0; it < 8; ++it) kst[it] = *(const v4u*)(base + ((size_t)(m0 + it * 4 + lrow) << dl) * LDQ + lch * 8);
#pragma unroll
    for (int it = 0; it < 8; ++it) *(LAS v4u*)(kl + voff_b(it * 4 + lrow, lch)) = kst[it];
    bf16x8 qf[8];
#pragma unroll
    for (int kk = 0; kk < 8; ++kk) qf[kk] = *(LAS bf16x8*)(kl + voff_b(r32, 2 * kk + hi));
    int Ld = r32 - 4 * hi; asm volatile("" : "+v"(Ld));
    const float bl = -sl2 * (float)Ld;
#define ATT_KLOAD(kt_) do { _Pragma("unroll") for (int it = 0; it < 8; ++it) { int kidx_ = m0 - 128 + 32 * (kt_) + it * 4 + lrow; kidx_ = kidx_ < 0 ? 0 : kidx_; \
        kst[it] = *(const v4u*)((const char*)base + (unsigned)(((unsigned)kidx_ << dl) * (unsigned)(LDQ * 2) + (unsigned)(2 * HQ) + (unsigned)(lch * 16))); } } while (0)
    ATT_KLOAD(0);
    f32x16 S[5];
    float mx = -INFINITY;
#pragma unroll
    for (int kt = 0; kt < 5; ++kt) {
#pragma unroll
        for (int it = 0; it < 8; ++it) *(LAS v4u*)(kl + voff_b(it * 4 + lrow, lch)) = kst[it];
        if (kt < 4) ATT_KLOAD(kt + 1);
        __builtin_amdgcn_sched_barrier(0);
        f32x16 s = {};
#pragma unroll
        for (int kk = 0; kk < 8; ++kk) { const bf16x8 kf = *(LAS bf16x8*)(kl + voff_b(r32, 2 * kk + hi)); s = MFMA32(kf, qf[kk], s); }
        const bool tneg = (m0 - 128 + 32 * kt) < 0;
#pragma unroll
        for (int r = 0; r < 16; ++r) { const int C = 128 - 32 * kt - ((r & 3) + 8 * (r >> 2));
            float v = fmaf(s[r], sc2, bl) - sl2 * (float)C;
            if (kt == 0) v = (C + Ld > 128) ? -INFINITY : v;
            if (kt == 4) v = (C + Ld < 0) ? -INFINITY : v;
            if (kt < 4) v = tneg ? -INFINITY : v;
            s[r] = v; mx = fmaxf(mx, v); }
        S[kt] = s;
        __builtin_amdgcn_sched_barrier(0);
    }
#undef ATT_KLOAD
    v4u vst[2][8];
#define ATT_VLOAD(buf, kt_) do { _Pragma("unroll") for (int it = 0; it < 8; ++it) { int vidx_ = m0 - 128 + 32 * (kt_) + it * 4 + (lane >> 4); vidx_ = vidx_ < 0 ? 0 : vidx_; \
        vst[buf][it] = *(const v4u*)((const char*)base + (unsigned)(((unsigned)vidx_ << dl) * (unsigned)(LDQ * 2) + (unsigned)(4 * HQ) + (unsigned)((lane & 15) * 16))); } } while (0)
    ATT_VLOAD(0, 0); ATT_VLOAD(1, 1);
    __builtin_amdgcn_sched_barrier(0);
    mx = fmaxf(mx, __shfl_xor(mx, 32));
    float l = 0.f;
    v4u Pp[5][2];
#pragma unroll
    for (int kt = 0; kt < 5; ++kt) {
#pragma unroll
        for (int r = 0; r < 16; ++r) { const float p = __builtin_amdgcn_exp2f(S[kt][r] - mx); S[kt][r] = p; l += p; }
#pragma unroll
        for (int s = 0; s < 2; ++s) { Pp[kt][s].x = pk2(S[kt][8 * s + 0], S[kt][8 * s + 1]); Pp[kt][s].y = pk2(S[kt][8 * s + 2], S[kt][8 * s + 3]); Pp[kt][s].z = pk2(S[kt][8 * s + 4], S[kt][8 * s + 5]); Pp[kt][s].w = pk2(S[kt][8 * s + 6], S[kt][8 * s + 7]); }
    }
    l += __shfl_xor(l, 32);
    f32x16 O[4];
#pragma unroll
    for (int dv = 0; dv < 4; ++dv) O[dv] = (f32x16){};
    const int q4 = (lane & 15) >> 2, p4 = lane & 3, blk = (lane >> 4) & 1;
#pragma unroll
    for (int kt = 0; kt < 5; ++kt) {
#pragma unroll
        for (int it = 0; it < 8; ++it) { const int row = it * 4 + (lane >> 4); *(LAS v4u*)(vl + voff_b(row, lane & 15)) = vst[kt & 1][it]; }
        if (kt < 3) ATT_VLOAD(kt & 1, kt + 2);
        __builtin_amdgcn_sched_barrier(0);
#pragma unroll
        for (int s = 0; s < 2; ++s) {
            const bf16x8 pf = __builtin_bit_cast(bf16x8, Pp[kt][s]);
#pragma unroll
            for (int dv = 0; dv < 4; ++dv) {
                const int c = 4 * dv + 2 * blk + (p4 >> 1);
                const v4i16_t lo = trrd(vl + voff_b(16 * s + 4 * hi + q4, c) + 8 * (p4 & 1));
                const v4i16_t hh = trrd(vl + voff_b(16 * s + 8 + 4 * hi + q4, c) + 8 * (p4 & 1));
                const bf16x8 vf = __builtin_shufflevector(lo, hh, 0, 1, 2, 3, 4, 5, 6, 7);
                O[dv] = MFMA32(vf, pf, O[dv]);
            }
        }
        __builtin_amdgcn_sched_barrier(0);
    }
#undef ATT_VLOAD
    const float inv = 1.0f / l;
    const size_t tok = (size_t)b * SEQ + ((size_t)(m0 + r32) << dl) + res;
#pragma unroll
    for (int dv = 0; dv < 4; ++dv)
#pragma unroll
        for (int gq = 0; gq < 4; ++gq) { v2u o; o.x = pk2(O[dv][4 * gq] * inv, O[dv][4 * gq + 1] * inv); o.y = pk2(O[dv][4 * gq + 2] * inv, O[dv][4 * gq + 3] * inv);
            *(LAS v2u*)(vl + voff_b(r32, 4 * dv + gq) + 8 * hi) = o; }
#pragma unroll
    for (int it = 0; it < 8; ++it) { const int row = it * 4 + (lane >> 4); const v4u v = *(LAS v4u*)(vl + voff_b(row, lane & 15));
        const size_t tk = (size_t)b * SEQ + ((size_t)(m0 + row) << dl) + res;
        *(v4u*)(opart + (tk * NH + h) * HD + (lane & 15) * 8) = v; }
    if (hi == 0) lse[tok * NH + h] = mx + __log2f(l);
}

__device__ __forceinline__ void ssm_estate_unit(const bf16* ubuf, const bf16* WTt, float* E, LAS unsigned char* el, int g, int b, int nt, int lane) {
    const int r32 = lane & 31, hi = lane >> 5, chunk = 32 * nt + r32;
    const bf16* up = ubuf + ((((size_t)(b * NG + g)) * 16 + nt) * 16 * 32 + r32) * NC + 8 * hi;
    const bf16* wp = WTt + ((size_t)g * 4 * 16 * 64 + lane) * 8;
    f32x16 acc[4];
#pragma unroll
    for (int mt = 0; mt < 4; ++mt) acc[mt] = (f32x16){};
#pragma unroll 8
    for (int j = 0; j < CL; ++j) {
        const bf16x8 bf = *(const bf16x8*)(up + j * 512);
#pragma unroll
        for (int mt = 0; mt < 4; ++mt) { const bf16x8 af = *(const bf16x8*)(wp + (mt * 16 + j) * 512); acc[mt] = MFMA32(af, bf, acc[mt]); }
    }
#pragma unroll
    for (int mt = 0; mt < 4; ++mt)
#pragma unroll
        for (int gq = 0; gq < 4; ++gq) *(LAS f32x4*)(el + r32 * 512 + (((8 * mt + 2 * gq + hi) ^ r32) * 16)) = (f32x4){acc[mt][4 * gq], acc[mt][4 * gq + 1], acc[mt][4 * gq + 2], acc[mt][4 * gq + 3]};
    float* ep = E + (((size_t)(b * NG + g)) * NCHUNK + 32 * nt) * 128;
#pragma unroll
    for (int it = 0; it < 16; ++it) { const int id = it * 64 + lane, n = id >> 5, pc = id & 31; const f32x4 v = *(LAS f32x4*)(el + id * 16); *(f32x4*)(ep + n * 128 + ((pc ^ n) * 4)) = v; }
}
template <int mg> __device__ __forceinline__ void ssm_out_unit(const bf16* ubuf, const bf16* A3, const bf16* HB, LAS unsigned char* yt, int wave, int g, int b, int nt, int lane) {
    const int r32 = lane & 31, hi = lane >> 5, chunk = 32 * nt + r32;
    const bf16* up = ubuf + ((((size_t)(b * NG + g)) * 16 + nt) * 16 * 32 + r32) * NC + 8 * hi;
    const bf16* hp = HB + ((((size_t)(b * NG + g)) * 16 + nt) * 8 * 32 + r32) * 16 + 8 * hi;
    const bf16* ap = A3 + (((size_t)(g * 8 + 4 * mg)) * 24 * 64 + lane) * 8;
    f32x16 acc[4];
#pragma unroll
    for (int mt = 0; mt < 4; ++mt) acc[mt] = (f32x16){};
    constexpr int jmax = 8 * mg + 8;
#pragma unroll 8
    for (int j = 0; j < jmax; ++j) {
        const bf16x8 bf = *(const bf16x8*)(up + j * 512);
#pragma unroll
        for (int mt = 0; mt < 4; ++mt) { const bf16x8 af = *(const bf16x8*)(ap + (mt * 24 + j) * 512); acc[mt] = MFMA32(af, bf, acc[mt]); }
    }
#pragma unroll 8
    for (int ks = 0; ks < 8; ++ks) {
        const bf16x8 bf = *(const bf16x8*)(hp + ks * 512);
#pragma unroll
        for (int mt = 0; mt < 4; ++mt) { const bf16x8 af = *(const bf16x8*)(ap + (mt * 24 + 16 + ks) * 512); acc[mt] = MFMA32(af, bf, acc[mt]); }
    }
#pragma unroll
    for (int mt = 0; mt < 4; ++mt)
#pragma unroll
        for (int gq = 0; gq < 4; ++gq) {
            const int il = 2 * mt + (gq >> 1), ch = (wave * 2 + (gq & 1)) ^ (r32 & 15);
            v2u o; o.x = pk2(gelu_tanh(acc[mt][4 * gq]), gelu_tanh(acc[mt][4 * gq + 1])); o.y = pk2(gelu_tanh(acc[mt][4 * gq + 2]), gelu_tanh(acc[mt][4 * gq + 3]));
            *(LAS v2u*)(yt + (r32 * 8 + il) * 256 + ch * 16 + 8 * hi) = o;
        }
}

template <int NR> __device__ __forceinline__ void norm1_rows(const float* x, const bf16* o, const float* gpost, const float* gpre, float* x1, bf16* h2, int m, int mstep, int lane) {
    f32x4 v[NR][8], xv[NR][8]; float s[NR], s1[NR];
#pragma unroll
    for (int r = 0; r < NR; ++r) { const size_t row = (size_t)(m + r * mstep);
#pragma unroll
        for (int j = 0; j < 4; ++j) { const v4u w = __builtin_nontemporal_load((const v4u*)(o + row * LDH + 8 * (lane + 64 * j)));
            v[r][2 * j] = (f32x4){bflo(w.x), bfhi(w.x), bflo(w.y), bfhi(w.y)}; v[r][2 * j + 1] = (f32x4){bflo(w.z), bfhi(w.z), bflo(w.w), bfhi(w.w)}; }
#pragma unroll
        for (int j = 0; j < 8; ++j) xv[r][j] = __builtin_nontemporal_load((const f32x4*)(x + row * DM + 8 * (lane + 64 * (j >> 1)) + 4 * (j & 1))); }
#pragma unroll
    for (int r = 0; r < NR; ++r) { s[r] = 0.f;
#pragma unroll
        for (int j = 0; j < 8; ++j) s[r] += (v[r][j].x * v[r][j].x + v[r][j].y * v[r][j].y) + (v[r][j].z * v[r][j].z + v[r][j].w * v[r][j].w); }
#pragma unroll
    for (int r = 0; r < NR; ++r) { const size_t row = (size_t)(m + r * mstep); const float rstd = rsqrtf(wave_sum(s[r]) * (1.f / DM) + EPS); s1[r] = 0.f;
#pragma unroll
        for (int j = 0; j < 8; ++j) { const int e0 = 8 * (lane + 64 * (j >> 1)) + 4 * (j & 1); const f32x4 gv = *(const f32x4*)(gpost + e0);
            v[r][j] = xv[r][j] + v[r][j] * rstd * gv; s1[r] += (v[r][j].x * v[r][j].x + v[r][j].y * v[r][j].y) + (v[r][j].z * v[r][j].z + v[r][j].w * v[r][j].w); *(f32x4*)(x1 + row * DM + e0) = v[r][j]; } }
#pragma unroll
    for (int r = 0; r < NR; ++r) { const size_t row = (size_t)(m + r * mstep); const float rstd1 = rsqrtf(wave_sum(s1[r]) * (1.f / DM) + EPS);
#pragma unroll
        for (int j = 0; j < 4; ++j) { const int e0 = 8 * (lane + 64 * j); const f32x4 g0 = *(const f32x4*)(gpre + e0), g1 = *(const f32x4*)(gpre + e0 + 4);
            const f32x4 a = v[r][2 * j] * rstd1 * g0, c = v[r][2 * j + 1] * rstd1 * g1; v4u ov; ov.x = pk2(a.x, a.y); ov.y = pk2(a.z, a.w); ov.z = pk2(c.x, c.y); ov.w = pk2(c.z, c.w);
            *(v4u*)(h2 + row * LDH + e0) = ov; } }
}
template <int NR> __device__ __forceinline__ void norm2_rows(const bf16* f, const float* gpost, float* out, int m, int mstep, int lane) {
    f32x4 v[NR][8], xv[NR][8]; float s[NR];
#pragma unroll
    for (int r = 0; r < NR; ++r) { const size_t row = (size_t)(m + r * mstep);
#pragma unroll
        for (int j = 0; j < 4; ++j) { const v4u w = __builtin_nontemporal_load((const v4u*)(f + row * LDH + 8 * (lane + 64 * j)));
            v[r][2 * j] = (f32x4){bflo(w.x), bfhi(w.x), bflo(w.y), bfhi(w.y)}; v[r][2 * j + 1] = (f32x4){bflo(w.z), bfhi(w.z), bflo(w.w), bfhi(w.w)}; }
#pragma unroll
        for (int j = 0; j < 8; ++j) xv[r][j] = *(const f32x4*)(out + row * DM + 8 * (lane + 64 * (j >> 1)) + 4 * (j & 1)); }
#pragma unroll
    for (int r = 0; r < NR; ++r) { s[r] = 0.f;
#pragma unroll
        for (int j = 0; j < 8; ++j) s[r] += (v[r][j].x * v[r][j].x + v[r][j].y * v[r][j].y) + (v[r][j].z * v[r][j].z + v[r][j].w * v[r][j].w); }
#pragma unroll
    for (int r = 0; r < NR; ++r) { const size_t row = (size_t)(m + r * mstep); const float rstd = rsqrtf(wave_sum(s[r]) * (1.f / DM) + EPS);
#pragma unroll
        for (int j = 0; j < 8; ++j) { const int e0 = 8 * (lane + 64 * (j >> 1)) + 4 * (j & 1); const f32x4 gv = *(const f32x4*)(gpost + e0);
            __builtin_nontemporal_store(xv[r][j] + v[r][j] * rstd * gv, (f32x4*)(out + row * DM + e0)); } }
}

#define XB_TMO      128
#define XB_XCNT(j)  (256  + 64 * (j))
#define XB_XSUB(j)  (1280 + 64 * (j))
#define XB_XGEN(j)  (2304 + 64 * (j))
#define XB_TOP      3328
#define XB_TOPGEN   3392
#define XCD_BAR_WORDS 3456
#define XB_SPIN_CAP (1u << 18)

__device__ __forceinline__ unsigned xb_ld(unsigned* p)              { return __hip_atomic_load(p, __ATOMIC_RELAXED, __HIP_MEMORY_SCOPE_AGENT); }
__device__ __forceinline__ unsigned xb_add(unsigned* p, unsigned v) { return __hip_atomic_fetch_add(p, v, __ATOMIC_RELAXED, __HIP_MEMORY_SCOPE_AGENT); }
__device__ __forceinline__ unsigned xb_xcc_id() { return (unsigned)__builtin_amdgcn_s_getreg((3 << 11) | 20) & 0xFu; }
#define XB_SPIN(cond, bar) do { unsigned _sp = 0; while (cond) { __builtin_amdgcn_s_sleep(1); \
    if ((++_sp & 255u) == 0u) { if (xb_ld(&(bar)[XB_TMO])) break; if (_sp > XB_SPIN_CAP) { atomicAdd(&(bar)[XB_TMO], 1u); break; } } } } while (0)

struct XcdBarrier {
    unsigned* bar; unsigned x;
    volatile LAS unsigned* st;
};

__device__ __forceinline__ XcdBarrier xcd_barrier_post(unsigned* bar, volatile LAS unsigned* st) {
    XcdBarrier b; b.bar = bar; b.x = xb_xcc_id(); b.st = st;
    if (threadIdx.x == 0) (void)xb_add(&bar[XB_XCNT(b.x)], 1u);
    return b;
}
__device__ __forceinline__ void xcd_barrier_complete(unsigned* bar, unsigned x, unsigned& nloc, unsigned& nx) {
    const unsigned G = gridDim.x * gridDim.y * gridDim.z;
    unsigned sum, cnt, mine, sp = 0u;
    for (;;) {
        sum = 0u; cnt = 0u; mine = 0u;
#pragma unroll
        for (unsigned j = 0; j < 16; ++j) { const unsigned c = xb_ld(&bar[XB_XCNT(j)]); sum += c; cnt += (c > 0u) ? 1u : 0u; mine = (j == x) ? c : mine; }
        if (sum == G) break;
        __builtin_amdgcn_s_sleep(1);
        if ((++sp & 255u) == 0u) { if (xb_ld(&bar[XB_TMO])) break; if (sp > XB_SPIN_CAP) { atomicAdd(&bar[XB_TMO], 1u); break; } }
    }
    nloc = mine > 0u ? mine : 1u; nx = cnt > 0u ? cnt : 1u;
}

__device__ __forceinline__ void xcd_barrier(const XcdBarrier& b) {
    asm volatile("s_waitcnt vmcnt(0)" ::: "memory");
    __syncthreads();
    if (threadIdx.x == 0) {
        unsigned* bar = b.bar;
        __builtin_amdgcn_s_waitcnt(0);
        unsigned nloc = b.st[0], nx = b.st[1];
        if (nloc == 0u) { xcd_barrier_complete(bar, b.x, nloc, nx); b.st[0] = nloc; b.st[1] = nx; }
        const unsigned old = xb_add(&bar[XB_XSUB(b.x)], 1u);
        const unsigned gen = old / nloc;
        if (old + 1u == (gen + 1u) * nloc) {
            __builtin_amdgcn_fence(__ATOMIC_RELEASE, "agent");
            asm volatile("s_waitcnt vmcnt(0)" ::: "memory");
            const unsigned og = xb_add(&bar[XB_TOP], 1u);
            const unsigned tg = og / nx;
            if (og + 1u == (tg + 1u) * nx) xb_add(&bar[XB_TOPGEN], 1u);
            else XB_SPIN(xb_ld(&bar[XB_TOPGEN]) == tg, bar);
            __builtin_amdgcn_fence(__ATOMIC_ACQUIRE, "agent");
            xb_add(&bar[XB_XGEN(b.x)], 1u);
            asm volatile("s_waitcnt vmcnt(0)" ::: "memory");
        } else {
            XB_SPIN(xb_ld(&bar[XB_XGEN(b.x)]) == gen, bar);
            __builtin_amdgcn_fence(__ATOMIC_ACQUIRE, "agent");
            asm volatile("s_waitcnt vmcnt(0)" ::: "memory");
        }
    }
    __syncthreads();
}

#ifndef PH_SKIP
#define PH_SKIP 0
#endif
#define PH_ON(k) (((PH_SKIP) >> (k)) & 1) == 0
#ifndef PH_DUP
#define PH_DUP 0
#endif
#define PH_REP(k) for (int rep_ = 0; rep_ < 1 + (((PH_DUP) >> (k)) & 1); ++rep_)

__global__ void __launch_bounds__(NTHR, 2) mega_fwd(Args a) {
    extern __shared__ __attribute__((aligned(16))) unsigned char lds_raw[];
    cg::grid_group grid = cg::this_grid();
    LAS unsigned char* lds = (LAS unsigned char*)lds_raw;
    const int G = gridDim.x, bx = blockIdx.x, NGW = G * NWAVES;
#define PH_IDS int tid = threadIdx.x; asm volatile("" : "+v"(tid)); const int lane = tid & 63; const int wave = __builtin_amdgcn_readfirstlane(tid >> 6); const int gw = bx * NWAVES + wave; (void)lane; (void)gw; (void)wave;
    unsigned char* ws = a.ws;
    {
        for (int u = threadIdx.x; u < (LDS_BYTES - RING_BYTES) / 4; u += NTHR) ((LAS unsigned*)(lds + RING_BYTES))[u] = 0u;
        __syncthreads();
    }
    const XcdBarrier xbar = xcd_barrier_post((unsigned*)(ws + WS_BAR), (volatile LAS unsigned*)(lds + RING_BYTES + 320 + 32));
#define SEAM() xcd_barrier(xbar)
    bf16* Win_t = (bf16*)(ws + WS_WIN); bf16* Wup_t = (bf16*)(ws + WS_WUP); bf16* Wglu_t = (bf16*)(ws + WS_WGLU); bf16* Wout_t = (bf16*)(ws + WS_WOUT);
    bf16* Wffn_t = (bf16*)(ws + WS_WFFN); bf16* Wdown_t = (bf16*)(ws + WS_WDOWN);
    bf16* qkvu = (bf16*)(ws + WS_RA); bf16* ubuf = (bf16*)(ws + WS_UB); bf16* obuf = (bf16*)(ws + WS_RA); bf16* act = (bf16*)(ws + WS_RA);
    bf16* hbuf = (bf16*)(ws + WS_RH); bf16* attn = (bf16*)(ws + WS_ATTN); bf16* ybuf = (bf16*)(ws + WS_Y); bf16* h2 = (bf16*)(ws + WS_RH);
    bf16* opart = (bf16*)(ws + WS_OPART); float* lse = (float*)(ws + WS_LSE); float* Ebuf = (float*)(ws + WS_E); bf16* HB = (bf16*)(ws + WS_HB);
    bf16* msbuf = (bf16*)(ws + WS_RF); bf16* fbuf = (bf16*)(ws + WS_RF);
    bf16* gates = (bf16*)a.out;

    if (PH_ON(0)) PH_REP(0) {
        PH_IDS
        for (int i = bx * NTHR + tid; i < T; i += G * NTHR) { ((float*)(ws + WS_ROWSS))[i] = 0.f; ((float*)(ws + WS_ROWSS1))[i] = 0.f; ((float*)(ws + WS_ROWSS2))[i] = 0.f;
            if (i < 64 * 64) { ((unsigned*)(ws + WS_PCNT))[i] = 0u; ((unsigned*)(ws + WS_PCNT1))[i] = 0u; ((unsigned*)(ws + WS_PCNT2))[i] = 0u; } }
        LAS float* scr = (LAS float*)(lds + wave * 16384);
        constexpr int I_IN = (DM / 64) * (INW / 32), I_UP = (AOW / 64) * (DM / 32), I_GLU = (SSMW / 64) * (DM / 32), I_OUT = (DM / 64) * (DM / 32), I_FFN = (DM / 64) * (DFF / 32), I_DN = (DFF / 64) * (DM / 32);
        constexpr int NITEMS = I_IN;
#define P0_ITEM(t, it_) do { t = tr_make(a.w_in, DM, INW, Win_t, 0, (it_)); } while (0)
        for (int it = gw; it < NITEMS; it += 2 * NGW) {
            TrItem t0, t1; float w0[32], w1[32];
            const bool two = it + NGW < NITEMS;
            P0_ITEM(t0, it); tr_load(t0, w0, lane);
            if (two) { P0_ITEM(t1, it + NGW); tr_load(t1, w1, lane); }
            tr_finish(t0, w0, scr, lane);
            if (two) tr_finish(t1, w1, scr, lane);
        }
#undef P0_ITEM
        for (int m = gw; m < T; m += 2 * NGW) rms_row2_to_bf16(a.x + (size_t)m * DM, a.x + (size_t)(m + NGW) * DM, a.norm_mix_pre, hbuf + (size_t)m * LDH, hbuf + (size_t)(m + NGW) * LDH, lane);
    }
    grid.sync();

    if (PH_ON(1)) {
        pg8::Gemm g{hbuf, Win_t, T, INW, DM, LDH, LDH}; pg8::StaticOrder S; S.init(T, INW, G, bx, 1 + (((PH_DUP) >> 1) & 1));
        pg8::EpiIn E{qkvu, ubuf, gates};
        pg8::gemm_phase<pg8::EpiIn, pg8::StaticOrder, PG8_ALIGN, PG8_SP2>(lds, g, S, E);
        if (bx >= G / 2) {
            PH_IDS
            LAS float* scr = (LAS float*)(lds + wave * 16384);
            constexpr int I_FFN = (DM / 64) * (DFF / 32);
            constexpr int I_DN2 = (DFF / 64) * (DM / 32), I_UP2 = (AOW / 64) * (DM / 32), I_GLU2 = (SSMW / 64) * (DM / 32), I_OUT2 = (DM / 64) * (DM / 32);
            for (int it = (bx - G / 2) * NWAVES + wave; it < 2 * I_FFN + I_DN2 + I_UP2 + 2 * I_GLU2 + I_OUT2; it += (G - G / 2) * NWAVES) {
                int r = it;
                if (r < I_UP2) { p0_transpose(a.w_attn_up, AOW, DM, Wup_t, 0, r, scr, lane); continue; } r -= I_UP2;
                if (r < I_GLU2) { p0_transpose(a.w_glu_v, SSMW, DM, Wglu_t, 1, r, scr, lane); continue; } r -= I_GLU2;
                if (r < I_GLU2) { p0_transpose(a.w_glu_g, SSMW, DM, Wglu_t, 2, r, scr, lane); continue; } r -= I_GLU2;
                if (r < I_OUT2) { p0_transpose(a.w_out, DM, DM, Wout_t, 0, r, scr, lane); continue; } r -= I_OUT2;
                if (r < I_FFN) { p0_transpose(a.w_ffn_gate, DM, DFF, Wffn_t, 1, r, scr, lane, a.norm_ffn_pre); continue; } r -= I_FFN;
                if (r < I_FFN) { p0_transpose(a.w_ffn_up, DM, DFF, Wffn_t, 2, r, scr, lane, a.norm_ffn_pre); continue; } r -= I_FFN;
                p0_transpose(a.w_ffn_down, DFF, DM, Wdown_t, 0, r, scr, lane);
            }
            __syncthreads();
            if (bx >= G - NG) ssm_tables(a, bx - (G - NG), lds, tid);
        }
    }
    SEAM();

    if (PH_ON(2)) PH_REP(2) {
        PH_IDS
        LAS unsigned char* vl = lds + wave * 16384;
        PH_REP(12) for (int w = gw; w < BATCH * NH * (SEQ / 32); w += NGW) {
            const int bh = w / (SEQ / 32), tile = w % (SEQ / 32);
            attn_wave_tile(qkvu, opart, lse, bh / NH, bh % NH, tile, vl, lane);
        }
        PH_REP(13) for (int w = gw; w < NG * BATCH * (NCHUNK / 32); w += NGW) {
            const int g = w / (BATCH * (NCHUNK / 32)), r = w % (BATCH * (NCHUNK / 32));
            ssm_estate_unit(ubuf, (const bf16*)(ws + WS_WT), Ebuf, vl, g, r / (NCHUNK / 32), r % (NCHUNK / 32), lane);
        }
    }
    SEAM();

    if (PH_ON(3)) PH_REP(3) {
        PH_IDS
        for (int u = bx; u < BATCH * NG * 2; u += G) {
            const int b = u >> 7, g = (u >> 1) & 63, p = (u & 1) * 32 + (tid & 31), seg = tid >> 5;
            const float lr = ((const float*)(ws + WS_LAML))[(g * NP + p) * 2], li = ((const float*)(ws + WS_LAML))[(g * NP + p) * 2 + 1];
            const size_t base = (((size_t)(b * NG + g)) * NCHUNK + 32 * seg) * 128 + p;
            const size_t hbase = (((((size_t)(b * NG + g)) * 16 + seg) * 8 + (p >> 4)) * 32) * 16 + (p & 15);
            float er[32], ei[32];
#pragma unroll
            for (int k = 0; k < 32; ++k) { er[k] = Ebuf[base + (size_t)k * 128]; ei[k] = Ebuf[base + (size_t)k * 128 + 64]; }
            float hr = 0.f, hi_ = 0.f;
#pragma unroll
            for (int k = 0; k < 32; ++k) { const float nr = lr * hr - li * hi_ + er[k], ni = lr * hi_ + li * hr + ei[k]; hr = nr; hi_ = ni; }
            LAS float* se = (LAS float*)lds;
            se[(seg * 32 + (tid & 31)) * 2] = hr; se[(seg * 32 + (tid & 31)) * 2 + 1] = hi_;
            float pr = lr, pi = li;
#pragma unroll
            for (int q = 0; q < 5; ++q) { const float nr = pr * pr - pi * pi, ni = 2.f * pr * pi; pr = nr; pi = ni; }
            __syncthreads();
            hr = 0.f; hi_ = 0.f;
            for (int s2 = 0; s2 < seg; ++s2) { const float sr = se[(s2 * 32 + (tid & 31)) * 2], si = se[(s2 * 32 + (tid & 31)) * 2 + 1]; const float nr = pr * hr - pi * hi_ + sr, ni = pr * hi_ + pi * hr + si; hr = nr; hi_ = ni; }
#pragma unroll
            for (int k = 0; k < 32; ++k) {
                HB[hbase + k * 16] = (bf16)(pk2(hr, 0.f) & 0xffffu); HB[hbase + 4 * 512 + k * 16] = (bf16)(pk2(hi_, 0.f) & 0xffffu);
                const float nr = lr * hr - li * hi_ + er[k], ni = lr * hi_ + li * hr + ei[k]; hr = nr; hi_ = ni;
            }
            __syncthreads();
        }
        for (size_t idx = (size_t)bx * NTHR + tid; idx < (size_t)T * 64; idx += (size_t)G * NTHR) {
            const size_t tok = idx >> 6; const int j = (int)(idx >> 4) & 3, ch = (int)idx & 15;
            const float l0 = lse[tok * NH + j], l1 = lse[tok * NH + 4 + j], l2 = lse[tok * NH + 8 + j];
            const float m = fmaxf(l0, fmaxf(l1, l2));
            float w0 = __builtin_amdgcn_exp2f(l0 - m), w1 = __builtin_amdgcn_exp2f(l1 - m), w2 = __builtin_amdgcn_exp2f(l2 - m);
            const float inv = 1.0f / (w0 + w1 + w2); w0 *= inv; w1 *= inv; w2 *= inv;
            const v4u o0 = *(const v4u*)(opart + (tok * NH + j) * HD + ch * 8), o1 = *(const v4u*)(opart + (tok * NH + 4 + j) * HD + ch * 8), o2 = *(const v4u*)(opart + (tok * NH + 8 + j) * HD + ch * 8);
            v4u r;
            r.x = pk2(w0 * bflo(o0.x) + w1 * bflo(o1.x) + w2 * bflo(o2.x), w0 * bfhi(o0.x) + w1 * bfhi(o1.x) + w2 * bfhi(o2.x));
            r.y = pk2(w0 * bflo(o0.y) + w1 * bflo(o1.y) + w2 * bflo(o2.y), w0 * bfhi(o0.y) + w1 * bfhi(o1.y) + w2 * bfhi(o2.y));
            r.z = pk2(w0 * bflo(o0.z) + w1 * bflo(o1.z) + w2 * bflo(o2.z), w0 * bfhi(o0.z) + w1 * bfhi(o1.z) + w2 * bfhi(o2.z));
            r.w = pk2(w0 * bflo(o0.w) + w1 * bflo(o1.w) + w2 * bflo(o2.w), w0 * bfhi(o0.w) + w1 * bfhi(o1.w) + w2 * bfhi(o2.w));
            *(v4u*)(attn + tok * LDATT + j * HD + ch * 8) = r;
        }
    }
    SEAM();

    if (PH_ON(4)) PH_REP(4) {
        PH_IDS
        for (int bu = bx; bu < BATCH * (NCHUNK / 32) * 2 * (NG / 8); bu += G) {
            const int go = bu & 7, mg = (bu >> 3) & 1, nt = (bu >> 4) & 15, b = bu >> 8, g = go * 8 + wave;
            if (mg) ssm_out_unit<1>(ubuf, (const bf16*)(ws + WS_A3), HB, lds, wave, g, b, nt, lane);
            else ssm_out_unit<0>(ubuf, (const bf16*)(ws + WS_A3), HB, lds, wave, g, b, nt, lane);
            __syncthreads();
#pragma unroll
            for (int it = 0; it < 8; ++it) { const int id = it * NTHR + tid, row = id >> 4, ch = id & 15, n = row >> 3, il = row & 7;
                const v4u v = *(LAS v4u*)(lds + row * 256 + ((ch ^ (n & 15)) * 16));
                *(v4u*)(ybuf + (size_t)(b * SEQ + (32 * nt + n) * CL + 8 * mg + il) * LDY + go * 128 + ch * 8) = v; }
            __syncthreads();
        }
    }
    SEAM();

    if (PH_ON(5)) {
        pg8::Gemm g{ybuf, Wglu_t, T, 2 * DM, SSMW, LDY, LDY}; pg8::StaticOrder S; S.init(T, 2 * DM, G, bx, 1 + (((PH_DUP) >> 5) & 1));
        pg8::EpiGlu E{gates, msbuf};
        pg8::gemm_phase<pg8::EpiGlu, pg8::StaticOrder, PG8_ALIGN, PG8_SP2>(lds, g, S, E);
    }
    SEAM();

    if (PH_ON(6)) {
        pg8::Gemm g{attn, Wup_t, T, DM, AOW, LDATT, LDATT}; pg8::StaticOrder S; S.init(T, DM, G, bx);
        pg8::EpiMerge E{gates, msbuf};
        pg8::gemm_phase<pg8::EpiMerge, pg8::StaticOrder, PG8_ALIGN, PG8_SP2>(lds, g, S, E);
    }
    SEAM();

    if (PH_ON(7)) {
        pg8::Gemm g{msbuf, Wout_t, T, DM, DM, LDH, LDH}; pg8::PanelOrder S; S.init(G, bx);
        pg8::EpiNormMid E{a.x, (bf16*)(ws + WS_X1B), a.norm_mix_post, (float*)(ws + WS_ROWSS1), (unsigned*)(ws + WS_PCNT1), (float*)(ws + WS_ROWSS2)};
        pg8::gemm_phase<pg8::EpiNormMid, pg8::PanelOrder, PG8_ALIGN, PG8_SP2>(lds, g, S, E);
    }
    SEAM();

    if (PH_ON(9)) {
        pg8::Gemm g{(const bf16*)(ws + WS_X1B), Wffn_t, T, 2 * DFF, DM, DM, LDH}; pg8::StaticOrder S; S.init(T, 2 * DFF, G, bx, 1 + (((PH_DUP) >> 9) & 1));
        pg8::EpiFfn E{act, (const float*)(ws + WS_ROWSS2)};
        pg8::gemm_phase<pg8::EpiFfn, pg8::StaticOrder, PG8_ALIGN, PG8_SP2>(lds, g, S, E);
    }
    SEAM();

    if (PH_ON(10)) {
        pg8::Gemm g{act, Wdown_t, T, DM, DFF, LDACT, LDACT}; pg8::PanelOrder S; S.init(G, bx);
        pg8::EpiNormOut E{a.out, (const bf16*)(ws + WS_X1B), a.norm_ffn_post, (float*)(ws + WS_ROWSS), (unsigned*)(ws + WS_PCNT)};
        pg8::gemm_phase<pg8::EpiNormOut, pg8::PanelOrder, PG8_ALIGN, PG8_SP2>(lds, g, S, E);
    }
}

extern "C" void kernel_launch(void* const* d_in, const int* in_sizes, int n_in, void* d_out, int out_size, void* d_ws, size_t ws_size, hipStream_t stream) {
    static int grid = 0;
    if (grid == 0) {
        if (n_in != 21 || in_sizes[0] != T * DM || out_size != T * DM || ws_size < WS_END) { fprintf(stderr, "kernel_launch: unexpected shapes (n_in %d, in0 %d, out %d, ws %zu < %zu); nothing launched\n", n_in, n_in > 0 ? in_sizes[0] : -1, out_size, ws_size, (size_t)WS_END); grid = -1; return; }
        int dev = 0, cus = 0, per_cu = 0;
        if (hipGetDevice(&dev) != hipSuccess || hipDeviceGetAttribute(&cus, hipDeviceAttributeMultiprocessorCount, dev) != hipSuccess) { grid = -1; return; }
        if (hipFuncSetAttribute((const void*)mega_fwd, hipFuncAttributeMaxDynamicSharedMemorySize, LDS_BYTES) != hipSuccess) { fprintf(stderr, "kernel_launch: hipFuncSetAttribute failed\n"); grid = -1; return; }
        if (hipOccupancyMaxActiveBlocksPerMultiprocessor(&per_cu, (const void*)mega_fwd, NTHR, LDS_BYTES) != hipSuccess || per_cu < 1) { fprintf(stderr, "kernel_launch: occupancy query reports %d blocks per CU; nothing launched\n", per_cu); (void)hipGetLastError(); grid = -1; return; }
        grid = cus;
    }
    if (grid < 0) return;
    Args a{};
    a.x = (const float*)d_in[0]; a.norm_mix_pre = (const float*)d_in[1]; a.w_in = (const float*)d_in[2]; a.w_attn_up = (const float*)d_in[3];
    a.a_re = (const float*)d_in[4]; a.a_im = (const float*)d_in[5]; a.log_dt = (const float*)d_in[6]; a.b_re = (const float*)d_in[7]; a.b_im = (const float*)d_in[8];
    a.c_re = (const float*)d_in[9]; a.c_im = (const float*)d_in[10]; a.ssm_d = (const float*)d_in[11];
    a.w_glu_v = (const float*)d_in[12]; a.w_glu_g = (const float*)d_in[13]; a.w_out = (const float*)d_in[14]; a.norm_mix_post = (const float*)d_in[15]; a.norm_ffn_pre = (const float*)d_in[16];
    a.w_ffn_gate = (const float*)d_in[17]; a.w_ffn_up = (const float*)d_in[18]; a.w_ffn_down = (const float*)d_in[19]; a.norm_ffn_post = (const float*)d_in[20];
    a.out = (float*)d_out; a.ws = (unsigned char*)d_ws;
    if (hipMemsetAsync((char*)d_ws + WS_BAR, 0, WS_BAR_BYTES, stream) != hipSuccess) { fprintf(stderr, "kernel_launch: hipMemsetAsync failed\n"); return; }
    void* args[] = {&a};
    const hipError_t e = hipLaunchCooperativeKernel((const void*)mega_fwd, dim3(grid), dim3(NTHR), args, LDS_BYTES, stream);
    if (e != hipSuccess) fprintf(stderr, "kernel_launch: cooperative launch failed: %s (grid %d)\n", hipGetErrorString(e), grid);
}
```

```cpp
#include <hip/hip_runtime.h>
#include <hip/hip_cooperative_groups.h>
#include <cstdio>
#include <cstdint>
namespace cg = cooperative_groups;
namespace pg8 {
#define PG8_LAS __attribute__((address_space(3)))
typedef unsigned short bf16_t;
typedef short bf16x8 __attribute__((ext_vector_type(8)));
typedef float f32x4 __attribute__((ext_vector_type(4)));
typedef unsigned u32x4 __attribute__((ext_vector_type(4)));
constexpr int BM = 256, BK = 64, HALF = 128, HTB = HALF * BK * 2  , STAGE_BYTES = 8 * HTB, NXCD = 8, WGM = 8;

__host__ __device__ __forceinline__ int lds_byte(int r, int c) { const int st = (r >> 4) * 2 + (c >> 5), rr = r & 15, cc = c & 31, ob = rr * 64 + cc * 2; return st * 1024 + (ob ^ (((ob >> 9) & 1) << 5)); }
__host__ __device__ __forceinline__ void stage_rc(int b, int& R, int& C) { const int st = b / 1024, sb = b % 1024, swz = sb ^ (((sb >> 9) & 1) << 5); R = (st >> 1) * 16 + swz / 64; C = (st & 1) * 32 + (swz % 64) / 2; }
__host__ __device__ __forceinline__ int perm32(int rho) { const int n = rho >> 4, i = rho & 15; return 8 * (i >> 2) + 4 * n + (i & 3); }

struct Unit { int pm, pn; };
struct Gemm { const bf16_t* A; const bf16_t* Bt; int M, N, K, lda, ldb; };

struct StaticOrder {
    int nM, nN, nwg, G, c, rep;
    __host__ __device__ void init(int M, int N, int G_, int c_, int rep_ = 1) { nM = M / BM; nN = N / BM; nwg = nM * nN; G = G_; c = c_; rep = rep_; }
    __host__ __device__ bool next(int i, Unit& u) const {
        const long L = (long)i * G + c; if (L >= (long)nwg * rep) return false;
        int wgid = (int)(L % nwg); { const int q = nwg / NXCD, r = nwg % NXCD, xcd = wgid % NXCD, off = wgid / NXCD; wgid = (xcd < r ? xcd * (q + 1) : r * (q + 1) + (xcd - r) * q) + off; }
        const int nig = WGM * nN, gid = wgid / nig, fm = gid * WGM, gsz = (nM - fm) < WGM ? (nM - fm) : WGM;
        u.pm = fm + ((wgid % nig) % gsz); u.pn = (wgid % nig) / gsz; return true;
    }
    __device__ __forceinline__ void a_ready(const Unit&) const {}
    __device__ __forceinline__ void done(const Unit&) const {}
};

__device__ __forceinline__ unsigned cvt_pk_bf16(float lo, float hi) { unsigned r; asm volatile("v_cvt_pk_bf16_f32 %0, %1, %2" : "=v"(r) : "v"(lo), "v"(hi)); return r; }
typedef float f32x2 __attribute__((ext_vector_type(2)));
template <class Epi, class Sched, bool ALIGN_EPI = false, bool SP2 = false>
__device__ __forceinline__ void gemm_phase(PG8_LAS unsigned char* lds, const Gemm g, const Sched& S, const Epi& E) {
    int tid_ = threadIdx.x; asm volatile("" : "+v"(tid_));
    const int tid = tid_, wid = __builtin_amdgcn_readfirstlane(tid >> 6), lane = tid & 63, wr = wid >> 2, wc = wid & 3, fr = lane & 15, fq = lane >> 4;
    const int K = g.K, nt = K / BK;
    unsigned voffA[2], voffB[2];
#pragma unroll
    for (int i = 0; i < 2; ++i) { int R, C; stage_rc(tid * 16 + i * 8192, R, C); const int Rb = Epi::PERM ? ((R & ~31) + perm32(R & 31)) : R;
        voffA[i] = (unsigned)(R * g.lda + C) * 2u; voffB[i] = (unsigned)(Rb * g.ldb + C) * 2u; }
    const size_t kstep = (size_t)(BK * 2);
    const size_t hstepA = (size_t)HALF * g.lda * 2, hstepB = (size_t)HALF * g.ldb * 2;
    const size_t tstepA = 2 * hstepA, tstepB = 2 * hstepB;
    const unsigned ldsw = (unsigned)wid * 1024u;
    const int aoff = lds_byte(wr * 64 + fr, fq * 8), boff = lds_byte(wc * 32 + fr, fq * 8);
#define PG8_SA(b, h) (((b) * 2 + (h)) * HTB)
#define PG8_SB(b, h) ((4 + (b) * 2 + (h)) * HTB)
#define PG8_STAGE(bufoff, gbase, voff) do { _Pragma("unroll") for (int _i = 0; _i < 2; ++_i) \
        __builtin_amdgcn_global_load_lds((const unsigned*)((const char*)(gbase) + (voff)[_i]), (PG8_LAS unsigned*)(lds + (bufoff) + ldsw + _i * 8192), 16, 0, 0); } while (0)
#define PG8_LDA(dst, b, h) do { _Pragma("unroll") for (int m = 0; m < 4; ++m) _Pragma("unroll") for (int k = 0; k < 2; ++k) dst[m][k] = *(const PG8_LAS bf16x8*)(lds + PG8_SA(b, h) + aoff + m * 2048 + k * 1024); } while (0)
#define PG8_LDB(dst, b, h) do { _Pragma("unroll") for (int n = 0; n < 2; ++n) _Pragma("unroll") for (int k = 0; k < 2; ++k) dst[n][k] = *(const PG8_LAS bf16x8*)(lds + PG8_SB(b, h) + boff + n * 2048 + k * 1024); } while (0)
#define PG8_MMA(ai, bj, At, Bt) do { __builtin_amdgcn_s_setprio(1); _Pragma("unroll") for (int m = 0; m < 4; ++m) _Pragma("unroll") for (int n = 0; n < 2; ++n) _Pragma("unroll") for (int k = 0; k < 2; ++k) \
        acc[ai][bj][m][n] = __builtin_amdgcn_mfma_f32_16x16x32_bf16(Bt[n][k], At[m][k], acc[ai][bj][m][n], 0, 0, 0); __builtin_amdgcn_s_setprio(0); } while (0)
#define PG8_WAIT_V(n) asm volatile("s_waitcnt vmcnt(" #n ")" ::: "memory")
#define PG8_WAIT_L(n) asm volatile("s_waitcnt lgkmcnt(" #n ")" ::: "memory")
#define PG8_BAR __builtin_amdgcn_s_barrier()
#define PG8_SCHED __builtin_amdgcn_sched_barrier(0)
    Unit cur, nxt; int ui = 0;
    if (!S.next(0, cur)) return;
    f32x4 acc[2][2][4][2];
#pragma unroll
    for (int a = 0; a < 2; ++a)
#pragma unroll
        for (int b = 0; b < 2; ++b)
#pragma unroll
            for (int m = 0; m < 4; ++m)
#pragma unroll
                for (int n = 0; n < 2; ++n) acc[a][b][m][n] = (f32x4){0.f, 0.f, 0.f, 0.f};
    bf16x8 At[4][2], B0[2][2], B1[2][2];
    const char* cA = (const char*)g.A + (size_t)cur.pm * tstepA; const char* cB = (const char*)g.Bt + (size_t)cur.pn * tstepB;
    S.a_ready(cur);
    if constexpr (SP2) {
        PG8_STAGE(PG8_SB(0, 0), cB, voffB); PG8_STAGE(PG8_SB(0, 1), cB + hstepB, voffB); PG8_STAGE(PG8_SA(0, 0), cA, voffA); PG8_STAGE(PG8_SA(0, 1), cA + hstepA, voffA);
        if (wr == 1) PG8_BAR;
        PG8_WAIT_V(2); PG8_BAR;
        PG8_STAGE(PG8_SB(1, 0), cB + kstep, voffB); PG8_STAGE(PG8_SA(1, 0), cA + kstep, voffA); PG8_STAGE(PG8_SB(1, 1), cB + hstepB + kstep, voffB);
        PG8_WAIT_V(6); PG8_BAR;
    } else {
        PG8_STAGE(PG8_SB(0, 0), cB, voffB); PG8_STAGE(PG8_SA(0, 0), cA, voffA); PG8_STAGE(PG8_SB(0, 1), cB + hstepB, voffB); PG8_STAGE(PG8_SA(0, 1), cA + hstepA, voffA);
        if (wr == 1) PG8_BAR;
        PG8_WAIT_V(4); PG8_BAR;
        PG8_STAGE(PG8_SB(1, 0), cB + kstep, voffB); PG8_STAGE(PG8_SA(1, 0), cA + kstep, voffA); PG8_STAGE(PG8_SB(1, 1), cB + hstepB + kstep, voffB);
        PG8_WAIT_V(6); PG8_BAR;
    }
    for (;;) {
        const bool has_next = S.next(ui + 1, nxt);
        const char* nA = has_next ? (const char*)g.A + (size_t)nxt.pm * tstepA : cA; const char* nB = has_next ? (const char*)g.Bt + (size_t)nxt.pn * tstepB : cB;
        for (int t = 0; t < nt; t += 2) {
            const bool last = (t == nt - 2);
            const char* a1 = cA + (size_t)(t + 1) * kstep;
            const char* a2 = last ? nA : cA + (size_t)(t + 2) * kstep; const char* b2 = last ? nB : cB + (size_t)(t + 2) * kstep;
            const char* a3 = a2 + kstep; const char* b3 = b2 + kstep;
            if (last && has_next) S.a_ready(nxt);
            if constexpr (SP2) {
            PG8_LDB(B0, 0, 0); PG8_LDB(B1, 0, 1); PG8_SCHED; PG8_LDA(At, 0, 0); PG8_STAGE(PG8_SA(1, 1), a1 + hstepA, voffA);
            PG8_WAIT_V(8); PG8_WAIT_L(0); PG8_BAR; PG8_MMA(0, 0, At, B0); PG8_MMA(0, 1, At, B1); PG8_BAR; PG8_SCHED;
            PG8_LDA(At, 0, 1); PG8_STAGE(PG8_SB(0, 0), b2, voffB); PG8_STAGE(PG8_SB(0, 1), b2 + hstepB, voffB); PG8_STAGE(PG8_SA(0, 0), a2, voffA);
            PG8_WAIT_V(8); PG8_WAIT_L(0); PG8_BAR; PG8_MMA(1, 0, At, B0); PG8_MMA(1, 1, At, B1); PG8_BAR; PG8_SCHED;
            PG8_LDB(B0, 1, 0); PG8_LDB(B1, 1, 1); PG8_SCHED; PG8_LDA(At, 1, 0); PG8_STAGE(PG8_SA(0, 1), a2 + hstepA, voffA);
            PG8_WAIT_V(8); PG8_WAIT_L(0); PG8_BAR; PG8_MMA(0, 0, At, B0); PG8_MMA(0, 1, At, B1); PG8_BAR; PG8_SCHED;
            PG8_LDA(At, 1, 1); PG8_STAGE(PG8_SB(1, 0), b3, voffB); PG8_STAGE(PG8_SB(1, 1), b3 + hstepB, voffB); PG8_STAGE(PG8_SA(1, 0), a3, voffA);
            PG8_WAIT_V(8); PG8_WAIT_L(0); PG8_BAR; PG8_MMA(1, 0, At, B0); PG8_MMA(1, 1, At, B1); PG8_BAR; PG8_SCHED;
            } else {
            PG8_LDB(B0, 0, 0); PG8_SCHED; PG8_LDA(At, 0, 0); PG8_STAGE(PG8_SA(1, 1), a1 + hstepA, voffA);
            PG8_WAIT_L(8); PG8_BAR; PG8_WAIT_L(0); PG8_MMA(0, 0, At, B0); PG8_BAR; PG8_SCHED;
            PG8_LDB(B1, 0, 1); PG8_STAGE(PG8_SB(0, 0), b2, voffB);
            PG8_BAR; PG8_WAIT_L(0); PG8_MMA(0, 1, At, B1); PG8_BAR;
            PG8_LDA(At, 0, 1); PG8_STAGE(PG8_SA(0, 0), a2, voffA);
            PG8_BAR; PG8_WAIT_L(0); PG8_MMA(1, 0, At, B0); PG8_BAR; PG8_SCHED;
            PG8_STAGE(PG8_SB(0, 1), b2 + hstepB, voffB);
            PG8_WAIT_V(6); PG8_BAR; PG8_MMA(1, 1, At, B1); PG8_BAR;
            PG8_LDB(B0, 1, 0); PG8_SCHED; PG8_LDA(At, 1, 0); PG8_STAGE(PG8_SA(0, 1), a2 + hstepA, voffA);
            PG8_WAIT_L(8); PG8_BAR; PG8_WAIT_L(0); PG8_MMA(0, 0, At, B0); PG8_BAR; PG8_SCHED;
            PG8_LDB(B1, 1, 1); PG8_STAGE(PG8_SB(1, 0), b3, voffB);
            PG8_BAR; PG8_WAIT_L(0); PG8_MMA(0, 1, At, B1); PG8_BAR;
            PG8_LDA(At, 1, 1); PG8_STAGE(PG8_SA(1, 0), a3, voffA);
            PG8_BAR; PG8_WAIT_L(0); PG8_MMA(1, 0, At, B0); PG8_BAR; PG8_SCHED;
            PG8_STAGE(PG8_SB(1, 1), b3 + hstepB, voffB);
            PG8_WAIT_V(6); PG8_BAR; PG8_MMA(1, 1, At, B1); PG8_BAR;
            }
        }
        if constexpr (ALIGN_EPI) { if (wr == 0) PG8_BAR; }
        if constexpr (!Epi::AFTER_DRAIN) { E(acc, cur, wr, wc, fr, fq); S.done(cur); }
        if (!has_next) break;
#pragma unroll
        for (int a = 0; a < 2; ++a)
#pragma unroll
            for (int b = 0; b < 2; ++b)
#pragma unroll
                for (int m = 0; m < 4; ++m)
#pragma unroll
                    for (int n = 0; n < 2; ++n) acc[a][b][m][n] = (f32x4){0.f, 0.f, 0.f, 0.f};
        cur = nxt; cA = nA; cB = nB; ++ui;
        if constexpr (ALIGN_EPI) { if (wr == 1) PG8_BAR; }
    }
    PG8_WAIT_V(0);
    if constexpr (!ALIGN_EPI) { if (wr == 0) PG8_BAR; }
    PG8_BAR;
    if constexpr (Epi::AFTER_DRAIN) { E.fused(acc, cur, wr, wc, fr, fq, lds, wid, lane); S.done(cur); }
#undef PG8_SA
#undef PG8_SB
#undef PG8_STAGE
#undef PG8_LDA
#undef PG8_LDB
#undef PG8_MMA
#undef PG8_WAIT_V
#undef PG8_WAIT_L
#undef PG8_BAR
#undef PG8_SCHED
}
}
#ifndef PG8_SP2
#define PG8_SP2 true
#endif
#ifndef PG8_ALIGN
#define PG8_ALIGN true
#endif

constexpr int BATCH = 2, SEQ = 8192, DM = 2048, T = BATCH * SEQ;
constexpr int HD = 128, NH = 12, HQ = 1536, SSMW = 1024, NG = 64, NP = 64, NC = 16;
constexpr int DFF = 5632, INW = 9728, QKVU = 5632, NGATE = INW - QKVU, AOW = 512;
constexpr int CL = 16, NCHUNK = SEQ / CL;
constexpr int A3W = CL * NC + 2 * NP;
constexpr float EPS = 1e-6f, LOG2E = 1.4426950408889634f;
constexpr int NWAVES = 8, NTHR = 512;
constexpr int PADE = 64;
constexpr int LDH = DM + PADE, LDQ = 3 * HQ + PADE, LDACT = DFF + PADE, LDATT = AOW + PADE, LDY = SSMW + PADE;

constexpr size_t WS_ROWSS1 = 196608, WS_ROWSS2 = 262144, WS_PCNT1 = 327680, WS_PCNT2 = 344064;
constexpr size_t WS_ROWSS = 65536, WS_PCNT = 131072;
constexpr size_t WS_BAR = 4096, WS_BAR_BYTES = 16384;
constexpr size_t WS_WFFN = 1u << 20;
constexpr size_t WS_WDOWN = WS_WFFN + (size_t)2 * DFF * LDH * 2;
constexpr size_t WS_WOUT = WS_WDOWN + (size_t)DM * LDACT * 2;
constexpr size_t WS_WIN = WS_WOUT + (size_t)DM * LDH * 2;
constexpr size_t WS_WUP = WS_WIN + (size_t)INW * LDH * 2;
constexpr size_t WS_WGLU = WS_WUP + (size_t)DM * LDATT * 2;
constexpr size_t WS_A3 = WS_WGLU + (size_t)2 * DM * LDY * 2;
constexpr size_t WS_WT = WS_A3 + (size_t)NG * 256 * A3W * 2;
constexpr size_t WS_LAML = WS_WT + (size_t)NG * 128 * 256 * 2;
constexpr size_t WS_X1B = WS_WIN;
static_assert(WS_X1B + (size_t)T * DM * 2 <= WS_LAML, "x1 overlay fits in the dead weight/table region");
constexpr size_t WS_RA = WS_LAML + 65536;
constexpr size_t WS_UB = WS_RA + (size_t)T * LDQ * 2;
constexpr size_t WS_RH = WS_RA + (size_t)T * LDACT * 2;
static_assert(WS_UB + (size_t)T * SSMW * 2 <= WS_RH, "u buffer fits behind qkv");
constexpr size_t WS_ATTN = WS_RH, WS_Y = WS_RH + (size_t)T * LDATT * 2;
static_assert(WS_Y + (size_t)T * LDY * 2 <= WS_RH + (size_t)T * LDH * 2, "attn + y fit in the h region");
constexpr size_t WS_RF = WS_RH + (size_t)T * LDH * 2;
constexpr size_t WS_OPART = WS_RF, WS_LSE = WS_OPART + (size_t)T * NH * HD * 2, WS_E = WS_LSE + (size_t)T * NH * 4;
constexpr size_t WS_HB = WS_E + (size_t)BATCH * NCHUNK * NG * 128 * 4, WS_END = WS_HB + (size_t)BATCH * NCHUNK * NG * 128 * 2;
static_assert(WS_END <= 536870912ull, "d_ws map exceeds 512 MiB");
static_assert(WS_RF + (size_t)T * LDH * 2 <= WS_END, "ms/f fit in the partials region");

constexpr int RING_BYTES = 131072, LDS_BYTES = 147456;

#define GAS __attribute__((address_space(1)))
#define LAS __attribute__((address_space(3)))
typedef unsigned short bf16;
typedef unsigned v4u __attribute__((ext_vector_type(4)));
typedef unsigned v2u __attribute__((ext_vector_type(2)));
typedef float f32x4 __attribute__((ext_vector_type(4)));
typedef float f32x16 __attribute__((ext_vector_type(16)));
typedef short bf16x8 __attribute__((ext_vector_type(8)));
typedef short v4i16_t __attribute__((ext_vector_type(4)));
typedef float f32x2_t __attribute__((ext_vector_type(2)));
typedef __bf16 bf16x2_t __attribute__((ext_vector_type(2)));

__device__ __forceinline__ unsigned pk2(float lo, float hi) { f32x2_t v = {lo, hi}; bf16x2_t b = __builtin_convertvector(v, bf16x2_t); return __builtin_bit_cast(unsigned, b); }
__device__ __forceinline__ float bflo(unsigned w) { return __uint_as_float(w << 16); }
__device__ __forceinline__ float bfhi(unsigned w) { return __uint_as_float(w & 0xffff0000u); }
__device__ __forceinline__ float sigmoidf_(float x) { return __builtin_amdgcn_rcpf(1.0f + __expf(-x)); }
__device__ __forceinline__ float gelu_tanh(float x) { const float z = 0.7978845608028654f * (x + 0.044715f * x * x * x); const float e = __expf(2.0f * z); return 0.5f * x * (2.0f - 2.0f * __builtin_amdgcn_rcpf(1.0f + e)); }
__device__ __forceinline__ float wave_sum(float v) {
#pragma unroll
    for (int o = 1; o < 64; o <<= 1) v += __shfl_xor(v, o);
    return v;
}
__device__ __forceinline__ int crow(int reg, int h) { return (reg & 3) + 8 * (reg >> 2) + 4 * h; }
#define MFMA32(a, b, c) __builtin_amdgcn_mfma_f32_32x32x16_bf16((a), (b), (c), 0, 0, 0)

namespace pg8 {
__device__ __forceinline__ u32x4 pack8(const f32x4 v0, const f32x4 v1) { u32x4 w; w.x = pk2(v0[0], v0[1]); w.y = pk2(v0[2], v0[3]); w.z = pk2(v1[0], v1[1]); w.w = pk2(v1[2], v1[3]); return w; }
__device__ __forceinline__ void unpack8(const u32x4 w, f32x4& v0, f32x4& v1) { v0 = (f32x4){bflo(w.x), bfhi(w.x), bflo(w.y), bfhi(w.y)}; v1 = (f32x4){bflo(w.z), bfhi(w.z), bflo(w.w), bfhi(w.w)}; }
__device__ __forceinline__ size_t gaddr(size_t row, int col) { return ((row >> 4) * (size_t)(NGATE / 8) + (size_t)(col >> 3)) * 128 + (row & 15) * 8; }
__device__ __forceinline__ f32x4 sig4(const f32x4 v) { return (f32x4){sigmoidf_(v[0]), sigmoidf_(v[1]), sigmoidf_(v[2]), sigmoidf_(v[3])}; }

struct EpiPlain {
    static constexpr bool PERM = true, AFTER_DRAIN = false;
    bf16_t* O; int ldc;
    __device__ __forceinline__ void operator()(const f32x4 (&acc)[2][2][4][2], const Unit& u, int wr, int wc, int fr, int fq) const {
        const int row0 = u.pm * BM + wr * 64 + fr, col0 = u.pn * BM + wc * 32 + 8 * fq;
#pragma unroll
        for (int ai = 0; ai < 2; ++ai)
#pragma unroll
            for (int m = 0; m < 4; ++m) { bf16_t* rowp = O + (size_t)(row0 + ai * HALF + m * 16) * ldc + col0;
#pragma unroll
                for (int bj = 0; bj < 2; ++bj) __builtin_nontemporal_store(pack8(acc[ai][bj][m][0], acc[ai][bj][m][1]), (u32x4*)(rowp + bj * HALF)); }
    }
};
struct EpiIn {
    static constexpr bool PERM = true, AFTER_DRAIN = false;
    bf16_t* qkv; bf16_t* ubuf; bf16_t* gates;
    __device__ __forceinline__ void operator()(const f32x4 (&acc)[2][2][4][2], const Unit& u, int wr, int wc, int fr, int fq) const {
        const int row0 = u.pm * BM + wr * 64 + fr; const int colt = u.pn * BM;
        if (colt < 3 * HQ) {
            const int col0 = colt + wc * 32 + 8 * fq;
#pragma unroll
            for (int ai = 0; ai < 2; ++ai)
#pragma unroll
                for (int m = 0; m < 4; ++m) { bf16_t* rowp = qkv + (size_t)(row0 + ai * HALF + m * 16) * LDQ + col0;
#pragma unroll
                    for (int bj = 0; bj < 2; ++bj) __builtin_nontemporal_store(pack8(acc[ai][bj][m][0], acc[ai][bj][m][1]), (u32x4*)(rowp + bj * HALF)); }
        } else if (colt < QKVU) {
            const int uc0 = colt - 3 * HQ + wc * 32 + 8 * fq;
#pragma unroll
            for (int ai = 0; ai < 2; ++ai)
#pragma unroll
                for (int m = 0; m < 4; ++m) { const int row = row0 + ai * HALF + m * 16, b = row / SEQ, t = row % SEQ;
#pragma unroll
                    for (int bj = 0; bj < 2; ++bj) { const int uc = uc0 + bj * HALF;
                        __builtin_nontemporal_store(pack8(acc[ai][bj][m][0], acc[ai][bj][m][1]), (u32x4*)(ubuf + (((((size_t)(b * NG + (uc >> 4))) * 16 + (t >> 9)) * 16 + (t & 15)) * 32 + ((t >> 4) & 31)) * NC + (uc & 15))); } }
        } else {
            const int col0 = colt - QKVU + wc * 32 + 8 * fq;
#pragma unroll
            for (int ai = 0; ai < 2; ++ai)
#pragma unroll
                for (int m = 0; m < 4; ++m) { const size_t row = (size_t)(row0 + ai * HALF + m * 16);
#pragma unroll
                    for (int bj = 0; bj < 2; ++bj) __builtin_nontemporal_store(pack8(sig4(acc[ai][bj][m][0]), sig4(acc[ai][bj][m][1])), (u32x4*)(gates + gaddr(row, col0 + bj * HALF))); }
        }
    }
};
struct EpiGlu {
    static constexpr bool PERM = true, AFTER_DRAIN = false;
    const bf16_t* gates; bf16_t* ms;
    __device__ __forceinline__ void operator()(const f32x4 (&acc)[2][2][4][2], const Unit& u, int wr, int wc, int fr, int fq) const {
        const int row0 = u.pm * BM + wr * 64 + fr, col0 = u.pn * HALF + wc * 32 + 8 * fq;
#pragma unroll
        for (int ai = 0; ai < 2; ++ai)
#pragma unroll
            for (int m = 0; m < 4; ++m) { const size_t row = (size_t)(row0 + ai * HALF + m * 16);
                f32x4 g0, g1; unpack8(*(const u32x4*)(gates + gaddr(row, DM + col0)), g0, g1);
                const f32x4 v0 = acc[ai][0][m][0] * sig4(acc[ai][1][m][0]) * g0, v1 = acc[ai][0][m][1] * sig4(acc[ai][1][m][1]) * g1;
                __builtin_nontemporal_store(pack8(v0, v1), (u32x4*)(ms + row * LDH + col0)); }
    }
};
struct EpiMerge {
    static constexpr bool PERM = true, AFTER_DRAIN = false;
    const bf16_t* gates; bf16_t* ms;
    __device__ __forceinline__ void operator()(const f32x4 (&acc)[2][2][4][2], const Unit& u, int wr, int wc, int fr, int fq) const {
        const int row0 = u.pm * BM + wr * 64 + fr, col0 = u.pn * BM + wc * 32 + 8 * fq;
#pragma unroll
        for (int ai = 0; ai < 2; ++ai)
#pragma unroll
            for (int m = 0; m < 4; ++m) { const size_t row = (size_t)(row0 + ai * HALF + m * 16);
#pragma unroll
                for (int bj = 0; bj < 2; ++bj) { const int col = col0 + bj * HALF;
                    f32x4 g0, g1, s0, s1; unpack8(*(const u32x4*)(gates + gaddr(row, col)), g0, g1); unpack8(*(const u32x4*)(ms + row * LDH + col), s0, s1);
                    __builtin_nontemporal_store(pack8(g0 * acc[ai][bj][m][0] + s0, g1 * acc[ai][bj][m][1] + s1), (u32x4*)(ms + row * LDH + col)); } }
    }
};
struct EpiFfn {
    static constexpr bool PERM = true, AFTER_DRAIN = false, REMAP = false;
    bf16_t* act; const float* rowss; const PG8_LAS float* rs; int rbase;
    __device__ __forceinline__ void operator()(const f32x4 (&acc)[2][2][4][2], const Unit& u, int wr, int wc, int fr, int fq) const {
        const int row0 = u.pm * BM + wr * 64 + fr, col0 = u.pn * HALF + wc * 32 + 8 * fq;
#pragma unroll
        for (int ai = 0; ai < 2; ++ai)
#pragma unroll
            for (int m = 0; m < 4; ++m) { const size_t row = (size_t)(row0 + ai * HALF + m * 16);
                const int ri = (int)row - rbase; const float r = ((unsigned)ri < 2048u) ? rs[ri] : rsqrtf(rowss[row] * (1.f / DM) + EPS);
                const f32x4 a0 = acc[ai][0][m][0] * r, a1 = acc[ai][0][m][1] * r;
                __builtin_nontemporal_store(pack8(a0 * sig4(a0) * (acc[ai][1][m][0] * r), a1 * sig4(a1) * (acc[ai][1][m][1] * r)), (u32x4*)(act + row * LDACT + col0)); }
    }
};
struct PanelOrder {
    int G, vcu;
    __device__ void init(int G_, int bx) { G = G_; vcu = (G_ % 8 == 0) ? (bx % 8) * (G_ / 8) + bx / 8 : bx; }
    __device__ bool next(int i, Unit& u) const { const int L = i * G + vcu; if (L >= (T / BM) * (DM / BM)) return false; u.pm = L >> 3; u.pn = L & 7; return true; }
    __device__ __forceinline__ void a_ready(const Unit&) const {}
    __device__ __forceinline__ void done(const Unit&) const {}
};
struct EpiNormOut {
    static constexpr bool PERM = true, AFTER_DRAIN = false, REMAP = false;
    float* out; const bf16_t* x1b; const float* gain; float* rowss; unsigned* pcnt;
    __device__ __forceinline__ void operator()(const f32x4 (&acc)[2][2][4][2], const Unit& u, int wr, int wc, int fr, int fq) const {
        const int row0 = u.pm * BM + wr * 64 + fr;
#pragma unroll
        for (int ai = 0; ai < 2; ++ai)
#pragma unroll
            for (int m = 0; m < 4; ++m) { float q = 0.f;
#pragma unroll
                for (int bj = 0; bj < 2; ++bj)
#pragma unroll
                    for (int n = 0; n < 2; ++n) { const f32x4 v = acc[ai][bj][m][n]; q += (v[0] * v[0] + v[1] * v[1]) + (v[2] * v[2] + v[3] * v[3]); }
                q += __shfl_xor(q, 16); q += __shfl_xor(q, 32);
                if (fq == 0) { const float old = __hip_atomic_fetch_add(rowss + row0 + ai * HALF + m * 16, q, __ATOMIC_RELAXED, __HIP_MEMORY_SCOPE_AGENT); asm volatile("" :: "v"(old)); } }
        asm volatile("s_waitcnt vmcnt(0)" ::: "memory");
        unsigned* cw = pcnt + 64 * u.pm;
        if ((threadIdx.x & 63) == 0) (void)__hip_atomic_fetch_add(cw, 1u, __ATOMIC_RELAXED, __HIP_MEMORY_SCOPE_AGENT);
        { unsigned sp = 0; while ((unsigned)__builtin_amdgcn_readfirstlane(__hip_atomic_load(cw, __ATOMIC_RELAXED, __HIP_MEMORY_SCOPE_AGENT)) < 64u) { __builtin_amdgcn_s_sleep(2); if (++sp > (1u << 20)) break; } }
        asm volatile("" ::: "memory");
        const int col0 = u.pn * BM + wc * 32 + 8 * fq;
#pragma unroll
        for (int ai = 0; ai < 2; ++ai)
#pragma unroll
            for (int m = 0; m < 4; ++m) { const int row = row0 + ai * HALF + m * 16;
                const float rstd = rsqrtf(__hip_atomic_load(rowss + row, __ATOMIC_RELAXED, __HIP_MEMORY_SCOPE_AGENT) * (1.f / DM) + EPS);
#pragma unroll
                for (int bj = 0; bj < 2; ++bj) { float* op = out + (size_t)row * DM + col0 + bj * HALF; const float* gp = gain + col0 + bj * HALF;
                    f32x4 x0, x1; unpack8(*(const u32x4*)(x1b + (size_t)row * DM + col0 + bj * HALF), x0, x1); const f32x4 g0 = *(const f32x4*)gp, g1 = *(const f32x4*)(gp + 4);
                    __builtin_nontemporal_store(x0 + acc[ai][bj][m][0] * rstd * g0, (f32x4*)op); __builtin_nontemporal_store(x1 + acc[ai][bj][m][1] * rstd * g1, (f32x4*)(op + 4)); } }
    }
};
struct EpiNormMid {
    static constexpr bool PERM = true, AFTER_DRAIN = false, REMAP = false;
    const float* x; bf16_t* x1o; const float* gpost; float* rowss1; unsigned* pcnt1; float* rowss2;
    __device__ __forceinline__ static void arrive_wait(unsigned* cw) {
        asm volatile("s_waitcnt vmcnt(0)" ::: "memory");
        if ((threadIdx.x & 63) == 0) (void)__hip_atomic_fetch_add(cw, 1u, __ATOMIC_RELAXED, __HIP_MEMORY_SCOPE_AGENT);
        unsigned sp = 0; while ((unsigned)__builtin_amdgcn_readfirstlane(__hip_atomic_load(cw, __ATOMIC_RELAXED, __HIP_MEMORY_SCOPE_AGENT)) < 64u) { __builtin_amdgcn_s_sleep(2); if (++sp > (1u << 20)) break; }
        asm volatile("" ::: "memory");
    }
    __device__ __forceinline__ void operator()(const f32x4 (&acc_)[2][2][4][2], const Unit& u, int wr, int wc, int fr, int fq) const {
        f32x4 (&acc)[2][2][4][2] = const_cast<f32x4 (&)[2][2][4][2]>(acc_);
        const int row0 = u.pm * BM + wr * 64 + fr, col0 = u.pn * BM + wc * 32 + 8 * fq;
#pragma unroll
        for (int ai = 0; ai < 2; ++ai)
#pragma unroll
            for (int m = 0; m < 4; ++m) { float q = 0.f;
#pragma unroll
                for (int bj = 0; bj < 2; ++bj)
#pragma unroll
                    for (int n = 0; n < 2; ++n) { const f32x4 v = acc[ai][bj][m][n]; q += (v[0] * v[0] + v[1] * v[1]) + (v[2] * v[2] + v[3] * v[3]); }
                q += __shfl_xor(q, 16); q += __shfl_xor(q, 32);
                if (fq == 0) { const float old = __hip_atomic_fetch_add(rowss1 + row0 + ai * HALF + m * 16, q, __ATOMIC_RELAXED, __HIP_MEMORY_SCOPE_AGENT); asm volatile("" :: "v"(old)); } }
        arrive_wait(pcnt1 + 64 * u.pm);
#pragma unroll
        for (int ai = 0; ai < 2; ++ai)
#pragma unroll
            for (int m = 0; m < 4; ++m) { const int row = row0 + ai * HALF + m * 16; float q = 0.f;
                const float rstd = rsqrtf(__hip_atomic_load(rowss1 + row, __ATOMIC_RELAXED, __HIP_MEMORY_SCOPE_AGENT) * (1.f / DM) + EPS);
#pragma unroll
                for (int bj = 0; bj < 2; ++bj) { const size_t off = (size_t)row * DM + col0 + bj * HALF; const float* gp = gpost + col0 + bj * HALF;
                    const f32x4 x0 = __builtin_nontemporal_load((const f32x4*)(x + off)), x1 = __builtin_nontemporal_load((const f32x4*)(x + off + 4)), g0 = *(const f32x4*)gp, g1 = *(const f32x4*)(gp + 4);
                    const f32x4 v0 = x0 + acc[ai][bj][m][0] * rstd * g0, v1 = x1 + acc[ai][bj][m][1] * rstd * g1;
                    acc[ai][bj][m][0] = v0; acc[ai][bj][m][1] = v1;
                    *(u32x4*)(x1o + off) = pack8(v0, v1);
                    q += (v0[0] * v0[0] + v0[1] * v0[1]) + (v0[2] * v0[2] + v0[3] * v0[3]) + (v1[0] * v1[0] + v1[1] * v1[1]) + (v1[2] * v1[2] + v1[3] * v1[3]); }
                q += __shfl_xor(q, 16); q += __shfl_xor(q, 32);
                if (fq == 0) { const float old = __hip_atomic_fetch_add(rowss2 + row, q, __ATOMIC_RELAXED, __HIP_MEMORY_SCOPE_AGENT); asm volatile("" :: "v"(old)); } }
    }
};
}

struct Args {
    const float* x; const float* norm_mix_pre; const float* w_in; const float* w_attn_up;
    const float* a_re; const float* a_im; const float* log_dt; const float* b_re; const float* b_im; const float* c_re; const float* c_im; const float* ssm_d;
    const float* w_glu_v; const float* w_glu_g; const float* w_out; const float* norm_mix_post; const float* norm_ffn_pre;
    const float* w_ffn_gate; const float* w_ffn_up; const float* w_ffn_down; const float* norm_ffn_post;
    float* out; unsigned char* ws;
};

struct TrItem { const float* W; bf16* WT; const float* kg; int K, N, k0, n0, drow0; };
__device__ __forceinline__ void tr_load(const TrItem& t, float (&wv)[32], int lane) {
#pragma unroll
    for (int i = 0; i < 32; ++i) { const int kk = 2 * i + (lane >> 5); wv[i] = __builtin_nontemporal_load(t.W + (size_t)(t.k0 + kk) * t.N + t.n0 + (lane & 31)); }
    if (t.kg) {
#pragma unroll
        for (int i = 0; i < 32; ++i) wv[i] *= t.kg[t.k0 + 2 * i + (lane >> 5)]; }
}
__device__ __forceinline__ void tr_finish(const TrItem& t, const float (&wv)[32], LAS float* scr, int lane) {
    const int ldb = t.K + PADE;
#pragma unroll
    for (int i = 0; i < 32; ++i) { const int kk = 2 * i + (lane >> 5); scr[kk * 33 + (lane & 31)] = wv[i]; }
    asm volatile("s_waitcnt lgkmcnt(0)" ::: "memory");
    const int c = lane & 7;
#pragma unroll
    for (int j = 0; j < 4; ++j) { const int n = (lane >> 3) + 8 * j; const LAS float* s = scr + (8 * c) * 33 + n;
        v4u o; o.x = pk2(s[0 * 33], s[1 * 33]); o.y = pk2(s[2 * 33], s[3 * 33]); o.z = pk2(s[4 * 33], s[5 * 33]); o.w = pk2(s[6 * 33], s[7 * 33]);
        *(v4u*)(t.WT + (size_t)(t.drow0 + n) * ldb + t.k0 + 8 * c) = o; }
    asm volatile("s_waitcnt lgkmcnt(0)" ::: "memory");
}
__device__ __forceinline__ TrItem tr_make(const float* W, int K, int N, bf16* WT, int mode, int item, const float* kg = nullptr) {
    const int nblk = N / 32, kb = item / nblk, nb = item % nblk, n0 = 32 * nb;
    TrItem t; t.W = W; t.WT = WT; t.kg = kg; t.K = K; t.N = N; t.k0 = 64 * kb; t.n0 = n0; t.drow0 = (mode == 0) ? n0 : ((n0 >> 7) * 256 + (mode - 1) * 128 + (n0 & 127));
    return t;
}
__device__ __forceinline__ void p0_transpose(const float* W, int K, int N, bf16* WT, int mode, int item, LAS float* scr, int lane, const float* kg = nullptr) {
    const TrItem t = tr_make(W, K, N, WT, mode, item, kg); float wv[32]; tr_load(t, wv, lane); tr_finish(t, wv, scr, lane);
}
__device__ __forceinline__ void rms_row_to_bf16(const float* xrow, const float* gain, bf16* orow, int lane) {
    f32x4 v[8]; float s = 0.f;
#pragma unroll
    for (int j = 0; j < 8; ++j) { v[j] = *(const f32x4*)(xrow + 4 * (lane + 64 * j)); s += (v[j].x * v[j].x + v[j].y * v[j].y) + (v[j].z * v[j].z + v[j].w * v[j].w); }
    const float rstd = rsqrtf(wave_sum(s) * (1.f / DM) + EPS);
#pragma unroll
    for (int j = 0; j < 8; ++j) { const f32x4 g = *(const f32x4*)(gain + 4 * (lane + 64 * j)); v2u o; o.x = pk2(v[j].x * rstd * g.x, v[j].y * rstd * g.y); o.y = pk2(v[j].z * rstd * g.z, v[j].w * rstd * g.w);
        *(v2u*)(orow + 4 * (lane + 64 * j)) = o; }
}

__device__ __forceinline__ void rms_row2_to_bf16(const float* x0, const float* x1, const float* gain, bf16* o0, bf16* o1, int lane) {
    f32x4 v[8], w[8]; float s = 0.f, q = 0.f;
#pragma unroll
    for (int j = 0; j < 8; ++j) { v[j] = __builtin_nontemporal_load((const f32x4*)(x0 + 4 * (lane + 64 * j))); w[j] = __builtin_nontemporal_load((const f32x4*)(x1 + 4 * (lane + 64 * j))); }
#pragma unroll
    for (int j = 0; j < 8; ++j) { s += (v[j].x * v[j].x + v[j].y * v[j].y) + (v[j].z * v[j].z + v[j].w * v[j].w); q += (w[j].x * w[j].x + w[j].y * w[j].y) + (w[j].z * w[j].z + w[j].w * w[j].w); }
    const float rs = rsqrtf(wave_sum(s) * (1.f / DM) + EPS), rq = rsqrtf(wave_sum(q) * (1.f / DM) + EPS);
#pragma unroll
    for (int j = 0; j < 8; ++j) { const f32x4 g = *(const f32x4*)(gain + 4 * (lane + 64 * j));
        v2u a; a.x = pk2(v[j].x * rs * g.x, v[j].y * rs * g.y); a.y = pk2(v[j].z * rs * g.z, v[j].w * rs * g.w); *(v2u*)(o0 + 4 * (lane + 64 * j)) = a;
        v2u b; b.x = pk2(w[j].x * rq * g.x, w[j].y * rq * g.y); b.y = pk2(w[j].z * rq * g.z, w[j].w * rq * g.w); *(v2u*)(o1 + 4 * (lane + 64 * j)) = b; }
}
__device__ __forceinline__ void ssm_tables(const Args& a, int g, LAS unsigned char* lds, int tid) {
    LAS float* pw = (LAS float*)lds;
    LAS float* beta = pw + 64 * 17 * 2;
    LAS float* gam = beta + 64 * 16 * 2;
    LAS float* kt = gam + 16 * 64 * 2;
    unsigned char* ws = a.ws;
    if (tid < 64) {
        const int p = tid;
        const double dt = exp((double)a.log_dt[g]);
        const double are = (double)a.a_re[g * NP + p], aim = (double)a.a_im[g * NP + p];
        const double mag = exp(are * dt), ang = aim * dt;
        const double lr = mag * cos(ang), li = mag * sin(ang);
        const double den = are * are + aim * aim;
        const double cr = ((lr - 1.0) * are + li * aim) / den, ci = (li * are - (lr - 1.0) * aim) / den;
        double pr = 1.0, pi = 0.0;
        for (int d = 0; d <= CL; ++d) { pw[(p * 17 + d) * 2] = (float)pr; pw[(p * 17 + d) * 2 + 1] = (float)pi; const double nr = pr * lr - pi * li, ni = pr * li + pi * lr; pr = nr; pi = ni; }
        for (int c = 0; c < NC; ++c) { const double br = (double)a.b_re[(g * NP + p) * NC + c], bi = (double)a.b_im[(g * NP + p) * NC + c];
            beta[(p * 16 + c) * 2] = (float)(cr * br - ci * bi); beta[(p * 16 + c) * 2 + 1] = (float)(cr * bi + ci * br); }
        float* lamL = (float*)(ws + WS_LAML) + (g * NP + p) * 2;
        lamL[0] = pw[(p * 17 + CL) * 2]; lamL[1] = pw[(p * 17 + CL) * 2 + 1];
    }
    for (int idx = tid; idx < NC * NP; idx += NTHR) { gam[idx * 2] = a.c_re[g * NC * NP + idx]; gam[idx * 2 + 1] = a.c_im[g * NC * NP + idx]; }
    __syncthreads();
    for (int e = tid; e < CL * 256; e += NTHR) {
        const int d = e >> 8, c = (e >> 4) & 15, c2 = e & 15; float s = 0.f;
        for (int p = 0; p < NP; ++p) { const float gr = gam[(c * 64 + p) * 2], gi = gam[(c * 64 + p) * 2 + 1], wr_ = pw[(p * 17 + d) * 2], wi_ = pw[(p * 17 + d) * 2 + 1], br = beta[(p * 16 + c2) * 2], bi = beta[(p * 16 + c2) * 2 + 1];
            const float zr = gr * wr_ - gi * wi_, zi = gr * wi_ + gi * wr_; s += zr * br - zi * bi; }
        if (d == 0 && c == c2) s += a.ssm_d[g * NC + c];
        kt[e] = s;
    }
    __syncthreads();
    bf16* A3 = (bf16*)(ws + WS_A3) + (size_t)g * 256 * A3W;
    for (int cidx = tid; cidx < 256 * (A3W / 8); cidx += NTHR) {
        const int row = cidx / (A3W / 8), cc = cidx % (A3W / 8), i = row >> 4, c = row & 15; float v[8];
        if (cc < 32) { const int j = cc >> 1, c0 = (cc & 1) * 8;
#pragma unroll
            for (int e = 0; e < 8; ++e) v[e] = (j <= i) ? kt[((i - j) * 16 + c) * 16 + c0 + e] : 0.f;
        } else { const int pidx0 = (cc - 32) * 8, part = pidx0 >> 6, p0 = pidx0 & 63;
#pragma unroll
            for (int e = 0; e < 8; ++e) { const int p = p0 + e; const float gr = gam[(c * 64 + p) * 2], gi = gam[(c * 64 + p) * 2 + 1], wr_ = pw[(p * 17 + i + 1) * 2], wi_ = pw[(p * 17 + i + 1) * 2 + 1];
                v[e] = part ? -(gr * wi_ + gi * wr_) : (gr * wr_ - gi * wi_); }
        }
        v4u o; o.x = pk2(v[0], v[1]); o.y = pk2(v[2], v[3]); o.z = pk2(v[4], v[5]); o.w = pk2(v[6], v[7]);
        *(v4u*)(A3 + ((((size_t)(row >> 5)) * 24 + (cc >> 1)) * 64 + ((cc & 1) * 32 + (row & 31))) * 8) = o;
    }
    bf16* WTt = (bf16*)(ws + WS_WT) + (size_t)g * 128 * 256;
    for (int cidx = tid; cidx < 128 * 32; cidx += NTHR) {
        const int row = cidx >> 5, cc = cidx & 31, part = row >> 6, p = row & 63, j = cc >> 1, c0 = (cc & 1) * 8; float v[8];
        const float wr_ = pw[(p * 17 + (CL - 1 - j)) * 2], wi_ = pw[(p * 17 + (CL - 1 - j)) * 2 + 1];
#pragma unroll
        for (int e = 0; e < 8; ++e) { const float br = beta[(p * 16 + c0 + e) * 2], bi = beta[(p * 16 + c0 + e) * 2 + 1]; v[e] = part ? (wr_ * bi + wi_ * br) : (wr_ * br - wi_ * bi); }
        v4u o; o.x = pk2(v[0], v[1]); o.y = pk2(v[2], v[3]); o.z = pk2(v[4], v[5]); o.w = pk2(v[6], v[7]);
        *(v4u*)(WTt + ((((size_t)(row >> 5)) * 16 + (cc >> 1)) * 64 + ((cc & 1) * 32 + (row & 31))) * 8) = o;
    }
    __syncthreads();
}

__device__ __forceinline__ unsigned voff_b(int row, int ch) { return 256u * row + 16u * (ch ^ (((row & 3) << 2) | ((row >> 2) & 3))); }
__device__ __forceinline__ v4i16_t trrd(LAS unsigned char* p) { return __builtin_amdgcn_ds_read_tr16_b64_v4i16((LAS v4i16_t*)p); }
__device__ __forceinline__ void attn_wave_tile(const bf16* qkvu, bf16* opart, float* lse, int b, int h, int tile, LAS unsigned char* vl, int lane) {
    asm volatile("" : "+v"(lane));
    const int g = h >> 2, dl = 2 * g;
    const int tps = (SEQ >> dl) >> 5, res = tile / tps, m0 = (tile % tps) * 32;
    const int r32 = lane & 31, hi = lane >> 5;
    const float sl2 = exp2f(-8.0f * (float)(h + 1) / 12.0f) * LOG2E * (float)(1 << dl);
    const float sc2 = LOG2E * 0.08838834764831845f;
    const bf16* base = qkvu + (size_t)(b * SEQ + res) * LDQ + h * HD;
    const bf16* qrow = base + ((size_t)(m0 + r32) << dl) * LDQ;
    LAS unsigned char* kl = vl + 8192;
    const int lrow = lane >> 4, lch = lane & 15;
    v4u kst[8];
#pragma unroll
    for (int it = 0; it < 8; ++it) kst[it] = *(const v4u*)(base + ((size_t)(m0 + it * 4 + lrow) << dl) * LDQ + lch * 8);
#pragma unroll
    for (int it = 0; it < 8; ++it) *(LAS v4u*)(kl + voff_b(it * 4 + lrow, lch)) = kst[it];
    bf16x8 qf[8];
#pragma unroll
    for (int kk = 0; kk < 8; ++kk) qf[kk] = *(LAS bf16x8*)(kl + voff_b(r32, 2 * kk + hi));
    int Ld = r32 - 4 * hi; asm volatile("" : "+v"(Ld));
    const float bl = -sl2 * (float)Ld;
#define ATT_KLOAD(kt_) do { _Pragma("unroll") for (int it = 0; it < 8; ++it) { int kidx_ = m0 - 128 + 32 * (kt_) + it * 4 + lrow; kidx_ = kidx_ < 0 ? 0 : kidx_; \
        kst[it] = *(const v4u*)((const char*)base + (unsigned)(((unsigned)kidx_ << dl) * (unsigned)(LDQ * 2) + (unsigned)(2 * HQ) + (unsigned)(lch * 16))); } } while (0)
    ATT_KLOAD(0);
    f32x16 S[5];
    float mx = -INFINITY;
#pragma unroll
    for (int kt = 0; kt < 5; ++kt) {
#pragma unroll
        for (int it = 0; it < 8; ++it) *(LAS v4u*)(kl + voff_b(it * 4 + lrow, lch)) = kst[it];
        if (kt < 4) ATT_KLOAD(kt + 1);
        __builtin_amdgcn_sched_barrier(0);
        f32x16 s = {};
#pragma unroll
        for (int kk = 0; kk < 8; ++kk) { const bf16x8 kf = *(LAS bf16x8*)(kl + voff_b(r32, 2 * kk + hi)); s = MFMA32(kf, qf[kk], s); }
        const bool tneg = (m0 - 128 + 32 * kt) < 0;
#pragma unroll
        for (int r = 0; r < 16; ++r) { const int C = 128 - 32 * kt - ((r & 3) + 8 * (r >> 2));
            float v = fmaf(s[r], sc2, bl) - sl2 * (float)C;
            if (kt == 0) v = (C + Ld > 128) ? -INFINITY : v;
            if (kt == 4) v = (C + Ld < 0) ? -INFINITY : v;
            if (kt < 4) v = tneg ? -INFINITY : v;
            s[r] = v; mx = fmaxf(mx, v); }
        S[kt] = s;
        __builtin_amdgcn_sched_barrier(0);
    }
#undef ATT_KLOAD
    v4u vst[2][8];
#define ATT_VLOAD(buf, kt_) do { _Pragma("unroll") for (int it = 0; it < 8; ++it) { int vidx_ = m0 - 128 + 32 * (kt_) + it * 4 + (lane >> 4); vidx_ = vidx_ < 0 ? 0 : vidx_; \
        vst[buf][it] = *(const v4u*)((const char*)base + (unsigned)(((unsigned)vidx_ << dl) * (unsigned)(LDQ * 2) + (unsigned)(4 * HQ) + (unsigned)((lane & 15) * 16))); } } while (0)
    ATT_VLOAD(0, 0); ATT_VLOAD(1, 1);
    __builtin_amdgcn_sched_barrier(0);
    mx = fmaxf(mx, __shfl_xor(mx, 32));
    float l = 0.f;
    v4u Pp[5][2];
#pragma unroll
    for (int kt = 0; kt < 5; ++kt) {
#pragma unroll
        for (int r = 0; r < 16; ++r) { const float p = __builtin_amdgcn_exp2f(S[kt][r] - mx); S[kt][r] = p; l += p; }
#pragma unroll
        for (int s = 0; s < 2; ++s) { Pp[kt][s].x = pk2(S[kt][8 * s + 0], S[kt][8 * s + 1]); Pp[kt][s].y = pk2(S[kt][8 * s + 2], S[kt][8 * s + 3]); Pp[kt][s].z = pk2(S[kt][8 * s + 4], S[kt][8 * s + 5]); Pp[kt][s].w = pk2(S[kt][8 * s + 6], S[kt][8 * s + 7]); }
    }
    l += __shfl_xor(l, 32);
    f32x16 O[4];
#pragma unroll
    for (int dv = 0; dv < 4; ++dv) O[dv] = (f32x16){};
    const int q4 = (lane & 15) >> 2, p4 = lane & 3, blk = (lane >> 4) & 1;
#pragma unroll
    for (int kt = 0; kt < 5; ++kt) {
#pragma unroll
        for (int it = 0; it < 8; ++it) { const int row = it * 4 + (lane >> 4); *(LAS v4u*)(vl + voff_b(row, lane & 15)) = vst[kt & 1][it]; }
        if (kt < 3) ATT_VLOAD(kt & 1, kt + 2);
        __builtin_amdgcn_sched_barrier(0);
#pragma unroll
        for (int s = 0; s < 2; ++s) {
            const bf16x8 pf = __builtin_bit_cast(bf16x8, Pp[kt][s]);
#pragma unroll
            for (int dv = 0; dv < 4; ++dv) {
                const int c = 4 * dv + 2 * blk + (p4 >> 1);
                const v4i16_t lo = trrd(vl + voff_b(16 * s + 4 * hi + q4, c) + 8 * (p4 & 1));
                const v4i16_t hh = trrd(vl + voff_b(16 * s + 8 + 4 * hi + q4, c) + 8 * (p4 & 1));
                const bf16x8 vf = __builtin_shufflevector(lo, hh, 0, 1, 2, 3, 4, 5, 6, 7);
                O[dv] = MFMA32(vf, pf, O[dv]);
            }
        }
        __builtin_amdgcn_sched_barrier(0);
    }
#undef ATT_VLOAD
    const float inv = 1.0f / l;
    const size_t tok = (size_t)b * SEQ + ((size_t)(m0 + r32) << dl) + res;
#pragma unroll
    for (int dv = 0; dv < 4; ++dv)
#pragma unroll
        for (int gq = 0; gq < 4; ++gq) { v2u o; o.x = pk2(O[dv][4 * gq] * inv, O[dv][4 * gq + 1] * inv); o.y = pk2(O[dv][4 * gq + 2] * inv, O[dv][4 * gq + 3] * inv);
            *(LAS v2u*)(vl + voff_b(r32, 4 * dv + gq) + 8 * hi) = o; }
#pragma unroll
    for (int it = 0; it < 8; ++it) { const int row = it * 4 + (lane >> 4); const v4u v = *(LAS v4u*)(vl + voff_b(row, lane & 15));
        const size_t tk = (size_t)b * SEQ + ((size_t)(m0 + row) << dl) + res;
        *(v4u*)(opart + (tk * NH + h) * HD + (lane & 15) * 8) = v; }
    if (hi == 0) lse[tok * NH + h] = mx + __log2f(l);
}

__device__ __forceinline__ void ssm_estate_unit(const bf16* ubuf, const bf16* WTt, float* E, LAS unsigned char* el, int g, int b, int nt, int lane) {
    const int r32 = lane & 31, hi = lane >> 5, chunk = 32 * nt + r32;
    const bf16* up = ubuf + ((((size_t)(b * NG + g)) * 16 + nt) * 16 * 32 + r32) * NC + 8 * hi;
    const bf16* wp = WTt + ((size_t)g * 4 * 16 * 64 + lane) * 8;
    f32x16 acc[4];
#pragma unroll
    for (int mt = 0; mt < 4; ++mt) acc[mt] = (f32x16){};
#pragma unroll 8
    for (int j = 0; j < CL; ++j) {
        const bf16x8 bf = *(const bf16x8*)(up + j * 512);
#pragma unroll
        for (int mt = 0; mt < 4; ++mt) { const bf16x8 af = *(const bf16x8*)(wp + (mt * 16 + j) * 512); acc[mt] = MFMA32(af, bf, acc[mt]); }
    }
#pragma unroll
    for (int mt = 0; mt < 4; ++mt)
#pragma unroll
        for (int gq = 0; gq < 4; ++gq) *(LAS f32x4*)(el + r32 * 512 + (((8 * mt + 2 * gq + hi) ^ r32) * 16)) = (f32x4){acc[mt][4 * gq], acc[mt][4 * gq + 1], acc[mt][4 * gq + 2], acc[mt][4 * gq + 3]};
    float* ep = E + (((size_t)(b * NG + g)) * NCHUNK + 32 * nt) * 128;
#pragma unroll
    for (int it = 0; it < 16; ++it) { const int id = it * 64 + lane, n = id >> 5, pc = id & 31; const f32x4 v = *(LAS f32x4*)(el + id * 16); *(f32x4*)(ep + n * 128 + ((pc ^ n) * 4)) = v; }
}
template <int mg> __device__ __forceinline__ void ssm_out_unit(const bf16* ubuf, const bf16* A3, const bf16* HB, LAS unsigned char* yt, int wave, int g, int b, int nt, int lane) {
    const int r32 = lane & 31, hi = lane >> 5, chunk = 32 * nt + r32;
    const bf16* up = ubuf + ((((size_t)(b * NG + g)) * 16 + nt) * 16 * 32 + r32) * NC + 8 * hi;
    const bf16* hp = HB + ((((size_t)(b * NG + g)) * 16 + nt) * 8 * 32 + r32) * 16 + 8 * hi;
    const bf16* ap = A3 + (((size_t)(g * 8 + 4 * mg)) * 24 * 64 + lane) * 8;
    f32x16 acc[4];
#pragma unroll
    for (int mt = 0; mt < 4; ++mt) acc[mt] = (f32x16){};
    constexpr int jmax = 8 * mg + 8;
#pragma unroll 8
    for (int j = 0; j < jmax; ++j) {
        const bf16x8 bf = *(const bf16x8*)(up + j * 512);
#pragma unroll
        for (int mt = 0; mt < 4; ++mt) { const bf16x8 af = *(const bf16x8*)(ap + (mt * 24 + j) * 512); acc[mt] = MFMA32(af, bf, acc[mt]); }
    }
#pragma unroll 8
    for (int ks = 0; ks < 8; ++ks) {
        const bf16x8 bf = *(const bf16x8*)(hp + ks * 512);
#pragma unroll
        for (int mt = 0; mt < 4; ++mt) { const bf16x8 af = *(const bf16x8*)(ap + (mt * 24 + 16 + ks) * 512); acc[mt] = MFMA32(af, bf, acc[mt]); }
    }
#pragma unroll
    for (int mt = 0; mt < 4; ++mt)
#pragma unroll
        for (int gq = 0; gq < 4; ++gq) {
            const int il = 2 * mt + (gq >> 1), ch = (wave * 2 + (gq & 1)) ^ (r32 & 15);
            v2u o; o.x = pk2(gelu_tanh(acc[mt][4 * gq]), gelu_tanh(acc[mt][4 * gq + 1])); o.y = pk2(gelu_tanh(acc[mt][4 * gq + 2]), gelu_tanh(acc[mt][4 * gq + 3]));
            *(LAS v2u*)(yt + (r32 * 8 + il) * 256 + ch * 16 + 8 * hi) = o;
        }
}

template <int NR> __device__ __forceinline__ void norm1_rows(const float* x, const bf16* o, const float* gpost, const float* gpre, float* x1, bf16* h2, int m, int mstep, int lane) {
    f32x4 v[NR][8], xv[NR][8]; float s[NR], s1[NR];
#pragma unroll
    for (int r = 0; r < NR; ++r) { const size_t row = (size_t)(m + r * mstep);
#pragma unroll
        for (int j = 0; j < 4; ++j) { const v4u w = __builtin_nontemporal_load((const v4u*)(o + row * LDH + 8 * (lane + 64 * j)));
            v[r][2 * j] = (f32x4){bflo(w.x), bfhi(w.x), bflo(w.y), bfhi(w.y)}; v[r][2 * j + 1] = (f32x4){bflo(w.z), bfhi(w.z), bflo(w.w), bfhi(w.w)}; }
#pragma unroll
        for (int j = 0; j < 8; ++j) xv[r][j] = __builtin_nontemporal_load((const f32x4*)(x + row * DM + 8 * (lane + 64 * (j >> 1)) + 4 * (j & 1))); }
#pragma unroll
    for (int r = 0; r < NR; ++r) { s[r] = 0.f;
#pragma unroll
        for (int j = 0; j < 8; ++j) s[r] += (v[r][j].x * v[r][j].x + v[r][j].y * v[r][j].y) + (v[r][j].z * v[r][j].z + v[r][j].w * v[r][j].w); }
#pragma unroll
    for (int r = 0; r < NR; ++r) { const size_t row = (size_t)(m + r * mstep); const float rstd = rsqrtf(wave_sum(s[r]) * (1.f / DM) + EPS); s1[r] = 0.f;
#pragma unroll
        for (int j = 0; j < 8; ++j) { const int e0 = 8 * (lane + 64 * (j >> 1)) + 4 * (j & 1); const f32x4 gv = *(const f32x4*)(gpost + e0);
            v[r][j] = xv[r][j] + v[r][j] * rstd * gv; s1[r] += (v[r][j].x * v[r][j].x + v[r][j].y * v[r][j].y) + (v[r][j].z * v[r][j].z + v[r][j].w * v[r][j].w); *(f32x4*)(x1 + row * DM + e0) = v[r][j]; } }
#pragma unroll
    for (int r = 0; r < NR; ++r) { const size_t row = (size_t)(m + r * mstep); const float rstd1 = rsqrtf(wave_sum(s1[r]) * (1.f / DM) + EPS);
#pragma unroll
        for (int j = 0; j < 4; ++j) { const int e0 = 8 * (lane + 64 * j); const f32x4 g0 = *(const f32x4*)(gpre + e0), g1 = *(const f32x4*)(gpre + e0 + 4);
            const f32x4 a = v[r][2 * j] * rstd1 * g0, c = v[r][2 * j + 1] * rstd1 * g1; v4u ov; ov.x = pk2(a.x, a.y); ov.y = pk2(a.z, a.w); ov.z = pk2(c.x, c.y); ov.w = pk2(c.z, c.w);
            *(v4u*)(h2 + row * LDH + e0) = ov; } }
}
template <int NR> __device__ __forceinline__ void norm2_rows(const bf16* f, const float* gpost, float* out, int m, int mstep, int lane) {
    f32x4 v[NR][8], xv[NR][8]; float s[NR];
#pragma unroll
    for (int r = 0; r < NR; ++r) { const size_t row = (size_t)(m + r * mstep);
#pragma unroll
        for (int j = 0; j < 4; ++j) { const v4u w = __builtin_nontemporal_load((const v4u*)(f + row * LDH + 8 * (lane + 64 * j)));
            v[r][2 * j] = (f32x4){bflo(w.x), bfhi(w.x), bflo(w.y), bfhi(w.y)}; v[r][2 * j + 1] = (f32x4){bflo(w.z), bfhi(w.z), bflo(w.w), bfhi(w.w)}; }
#pragma unroll
        for (int j = 0; j < 8; ++j) xv[r][j] = *(const f32x4*)(out + row * DM + 8 * (lane + 64 * (j >> 1)) + 4 * (j & 1)); }
#pragma unroll
    for (int r = 0; r < NR; ++r) { s[r] = 0.f;
#pragma unroll
        for (int j = 0; j < 8; ++j) s[r] += (v[r][j].x * v[r][j].x + v[r][j].y * v[r][j].y) + (v[r][j].z * v[r][j].z + v[r][j].w * v[r][j].w); }
#pragma unroll
    for (int r = 0; r < NR; ++r) { const size_t row = (size_t)(m + r * mstep); const float rstd = rsqrtf(wave_sum(s[r]) * (1.f / DM) + EPS);
#pragma unroll
        for (int j = 0; j < 8; ++j) { const int e0 = 8 * (lane + 64 * (j >> 1)) + 4 * (j & 1); const f32x4 gv = *(const f32x4*)(gpost + e0);
            __builtin_nontemporal_store(xv[r][j] + v[r][j] * rstd * gv, (f32x4*)(out + row * DM + e0)); } }
}

#define XB_TMO      128
#define XB_XCNT(j)  (256  + 64 * (j))
#define XB_XSUB(j)  (1280 + 64 * (j))
#define XB_XGEN(j)  (2304 + 64 * (j))
#define XB_TOP      3328
#define XB_TOPGEN   3392
#define XCD_BAR_WORDS 3456
#define XB_SPIN_CAP (1u << 18)

__device__ __forceinline__ unsigned xb_ld(unsigned* p)              { return __hip_atomic_load(p, __ATOMIC_RELAXED, __HIP_MEMORY_SCOPE_AGENT); }
__device__ __forceinline__ unsigned xb_add(unsigned* p, unsigned v) { return __hip_atomic_fetch_add(p, v, __ATOMIC_RELAXED, __HIP_MEMORY_SCOPE_AGENT); }
__device__ __forceinline__ unsigned xb_xcc_id() { return (unsigned)__builtin_amdgcn_s_getreg((3 << 11) | 20) & 0xFu; }
#define XB_SPIN(cond, bar) do { unsigned _sp = 0; while (cond) { __builtin_amdgcn_s_sleep(1); \
    if ((++_sp & 255u) == 0u) { if (xb_ld(&(bar)[XB_TMO])) break; if (_sp > XB_SPIN_CAP) { atomicAdd(&(bar)[XB_TMO], 1u); break; } } } } while (0)

struct XcdBarrier {
    unsigned* bar; unsigned x;
    volatile LAS unsigned* st;
};

__device__ __forceinline__ XcdBarrier xcd_barrier_post(unsigned* bar, volatile LAS unsigned* st) {
    XcdBarrier b; b.bar = bar; b.x = xb_xcc_id(); b.st = st;
    if (threadIdx.x == 0) (void)xb_add(&bar[XB_XCNT(b.x)], 1u);
    return b;
}
__device__ __forceinline__ void xcd_barrier_complete(unsigned* bar, unsigned x, unsigned& nloc, unsigned& nx) {
    const unsigned G = gridDim.x * gridDim.y * gridDim.z;
    unsigned sum, cnt, mine, sp = 0u;
    for (;;) {
        sum = 0u; cnt = 0u; mine = 0u;
#pragma unroll
        for (unsigned j = 0; j < 16; ++j) { const unsigned c = xb_ld(&bar[XB_XCNT(j)]); sum += c; cnt += (c > 0u) ? 1u : 0u; mine = (j == x) ? c : mine; }
        if (sum == G) break;
        __builtin_amdgcn_s_sleep(1);
        if ((++sp & 255u) == 0u) { if (xb_ld(&bar[XB_TMO])) break; if (sp > XB_SPIN_CAP) { atomicAdd(&bar[XB_TMO], 1u); break; } }
    }
    nloc = mine > 0u ? mine : 1u; nx = cnt > 0u ? cnt : 1u;
}

__device__ __forceinline__ void xcd_barrier(const XcdBarrier& b) {
    asm volatile("s_waitcnt vmcnt(0)" ::: "memory");
    __syncthreads();
    if (threadIdx.x == 0) {
        unsigned* bar = b.bar;
        __builtin_amdgcn_s_waitcnt(0);
        unsigned nloc = b.st[0], nx = b.st[1];
        if (nloc == 0u) { xcd_barrier_complete(bar, b.x, nloc, nx); b.st[0] = nloc; b.st[1] = nx; }
        const unsigned old = xb_add(&bar[XB_XSUB(b.x)], 1u);
        const unsigned gen = old / nloc;
        if (old + 1u == (gen + 1u) * nloc) {
            __builtin_amdgcn_fence(__ATOMIC_RELEASE, "agent");
            asm volatile("s_waitcnt vmcnt(0)" ::: "memory");
            const unsigned og = xb_add(&bar[XB_TOP], 1u);
            const unsigned tg = og / nx;
            if (og + 1u == (tg + 1u) * nx) xb_add(&bar[XB_TOPGEN], 1u);
            else XB_SPIN(xb_ld(&bar[XB_TOPGEN]) == tg, bar);
            __builtin_amdgcn_fence(__ATOMIC_ACQUIRE, "agent");
            xb_add(&bar[XB_XGEN(b.x)], 1u);
            asm volatile("s_waitcnt vmcnt(0)" ::: "memory");
        } else {
            XB_SPIN(xb_ld(&bar[XB_XGEN(b.x)]) == gen, bar);
            __builtin_amdgcn_fence(__ATOMIC_ACQUIRE, "agent");
            asm volatile("s_waitcnt vmcnt(0)" ::: "memory");
        }
    }
    __syncthreads();
}

#ifndef PH_SKIP
#define PH_SKIP 0
#endif
#define PH_ON(k) (((PH_SKIP) >> (k)) & 1) == 0
#ifndef PH_DUP
#define PH_DUP 0
#endif
#define PH_REP(k) for (int rep_ = 0; rep_ < 1 + (((PH_DUP) >> (k)) & 1); ++rep_)

__global__ void __launch_bounds__(NTHR, 2) mega_fwd(Args a) {
    extern __shared__ __attribute__((aligned(16))) unsigned char lds_raw[];
    cg::grid_group grid = cg::this_grid();
    LAS unsigned char* lds = (LAS unsigned char*)lds_raw;
    const int G = gridDim.x, bx = blockIdx.x, NGW = G * NWAVES;
#define PH_IDS int tid = threadIdx.x; asm volatile("" : "+v"(tid)); const int lane = tid & 63; const int wave = __builtin_amdgcn_readfirstlane(tid >> 6); const int gw = bx * NWAVES + wave; (void)lane; (void)gw; (void)wave;
    unsigned char* ws = a.ws;
    {
        for (int u = threadIdx.x; u < (LDS_BYTES - RING_BYTES) / 4; u += NTHR) ((LAS unsigned*)(lds + RING_BYTES))[u] = 0u;
        __syncthreads();
    }
    const XcdBarrier xbar = xcd_barrier_post((unsigned*)(ws + WS_BAR), (volatile LAS unsigned*)(lds + RING_BYTES + 320 + 32));
#define SEAM() xcd_barrier(xbar)
    bf16* Win_t = (bf16*)(ws + WS_WIN); bf16* Wup_t = (bf16*)(ws + WS_WUP); bf16* Wglu_t = (bf16*)(ws + WS_WGLU); bf16* Wout_t = (bf16*)(ws + WS_WOUT);
    bf16* Wffn_t = (bf16*)(ws + WS_WFFN); bf16* Wdown_t = (bf16*)(ws + WS_WDOWN);
    bf16* qkvu = (bf16*)(ws + WS_RA); bf16* ubuf = (bf16*)(ws + WS_UB); bf16* obuf = (bf16*)(ws + WS_RA); bf16* act = (bf16*)(ws + WS_RA);
    bf16* hbuf = (bf16*)(ws + WS_RH); bf16* attn = (bf16*)(ws + WS_ATTN); bf16* ybuf = (bf16*)(ws + WS_Y); bf16* h2 = (bf16*)(ws + WS_RH);
    bf16* opart = (bf16*)(ws + WS_OPART); float* lse = (float*)(ws + WS_LSE); float* Ebuf = (float*)(ws + WS_E); bf16* HB = (bf16*)(ws + WS_HB);
    bf16* msbuf = (bf16*)(ws + WS_RF); bf16* fbuf = (bf16*)(ws + WS_RF);
    bf16* gates = (bf16*)a.out;

    if (PH_ON(0)) PH_REP(0) {
        PH_IDS
        for (int i = bx * NTHR + tid; i < T; i += G * NTHR) { ((float*)(ws + WS_ROWSS))[i] = 0.f; ((float*)(ws + WS_ROWSS1))[i] = 0.f; ((float*)(ws + WS_ROWSS2))[i] = 0.f;
            if (i < 64 * 64) { ((unsigned*)(ws + WS_PCNT))[i] = 0u; ((unsigned*)(ws + WS_PCNT1))[i] = 0u; ((unsigned*)(ws + WS_PCNT2))[i] = 0u; } }
        LAS float* scr = (LAS float*)(lds + wave * 16384);
        constexpr int I_IN = (DM / 64) * (INW / 32), I_UP = (AOW / 64) * (DM / 32), I_GLU = (SSMW / 64) * (DM / 32), I_OUT = (DM / 64) * (DM / 32), I_FFN = (DM / 64) * (DFF / 32), I_DN = (DFF / 64) * (DM / 32);
        constexpr int NITEMS = I_IN;
#define P0_ITEM(t, it_) do { t = tr_make(a.w_in, DM, INW, Win_t, 0, (it_)); } while (0)
        for (int it = gw; it < NITEMS; it += 2 * NGW) {
            TrItem t0, t1; float w0[32], w1[32];
            const bool two = it + NGW < NITEMS;
            P0_ITEM(t0, it); tr_load(t0, w0, lane);
            if (two) { P0_ITEM(t1, it + NGW); tr_load(t1, w1, lane); }
            tr_finish(t0, w0, scr, lane);
            if (two) tr_finish(t1, w1, scr, lane);
        }
#undef P0_ITEM
        for (int m = gw; m < T; m += 2 * NGW) rms_row2_to_bf16(a.x + (size_t)m * DM, a.x + (size_t)(m + NGW) * DM, a.norm_mix_pre, hbuf + (size_t)m * LDH, hbuf + (size_t)(m + NGW) * LDH, lane);
    }
    grid.sync();

    if (PH_ON(1)) {
        pg8::Gemm g{hbuf, Win_t, T, INW, DM, LDH, LDH}; pg8::StaticOrder S; S.init(T, INW, G, bx, 1 + (((PH_DUP) >> 1) & 1));
        pg8::EpiIn E{qkvu, ubuf, gates};
        pg8::gemm_phase<pg8::EpiIn, pg8::StaticOrder, PG8_ALIGN, PG8_SP2>(lds, g, S, E);
        if (bx >= G / 2) {
            PH_IDS
            LAS float* scr = (LAS float*)(lds + wave * 16384);
            constexpr int I_FFN = (DM / 64) * (DFF / 32);
            constexpr int I_DN2 = (DFF / 64) * (DM / 32), I_UP2 = (AOW / 64) * (DM / 32), I_GLU2 = (SSMW / 64) * (DM / 32), I_OUT2 = (DM / 64) * (DM / 32);
            for (int it = (bx - G / 2) * NWAVES + wave; it < 2 * I_FFN + I_DN2 + I_UP2 + 2 * I_GLU2 + I_OUT2; it += (G - G / 2) * NWAVES) {
                int r = it;
                if (r < I_UP2) { p0_transpose(a.w_attn_up, AOW, DM, Wup_t, 0, r, scr, lane); continue; } r -= I_UP2;
                if (r < I_GLU2) { p0_transpose(a.w_glu_v, SSMW, DM, Wglu_t, 1, r, scr, lane); continue; } r -= I_GLU2;
                if (r < I_GLU2) { p0_transpose(a.w_glu_g, SSMW, DM, Wglu_t, 2, r, scr, lane); continue; } r -= I_GLU2;
                if (r < I_OUT2) { p0_transpose(a.w_out, DM, DM, Wout_t, 0, r, scr, lane); continue; } r -= I_OUT2;
                if (r < I_FFN) { p0_transpose(a.w_ffn_gate, DM, DFF, Wffn_t, 1, r, scr, lane, a.norm_ffn_pre); continue; } r -= I_FFN;
                if (r < I_FFN) { p0_transpose(a.w_ffn_up, DM, DFF, Wffn_t, 2, r, scr, lane, a.norm_ffn_pre); continue; } r -= I_FFN;
                p0_transpose(a.w_ffn_down, DFF, DM, Wdown_t, 0, r, scr, lane);
            }
            __syncthreads();
            if (bx >= G - NG) ssm_tables(a, bx - (G - NG), lds, tid);
        }
    }
    SEAM();

    if (PH_ON(2)) PH_REP(2) {
        PH_IDS
        LAS unsigned char* vl = lds + wave * 16384;
        PH_REP(12) for (int w = gw; w < BATCH * NH * (SEQ / 32); w += NGW) {
            const int bh = w / (SEQ / 32), tile = w % (SEQ / 32);
            attn_wave_tile(qkvu, opart, lse, bh / NH, bh % NH, tile, vl, lane);
        }
        PH_REP(13) for (int w = gw; w < NG * BATCH * (NCHUNK / 32); w += NGW) {
            const int g = w / (BATCH * (NCHUNK / 32)), r = w % (BATCH * (NCHUNK / 32));
            ssm_estate_unit(ubuf, (const bf16*)(ws + WS_WT), Ebuf, vl, g, r / (NCHUNK / 32), r % (NCHUNK / 32), lane);
        }
    }
    SEAM();

    if (PH_ON(3)) PH_REP(3) {
        PH_IDS
        for (int u = bx; u < BATCH * NG * 2; u += G) {
            const int b = u >> 7, g = (u >> 1) & 63, p = (u & 1) * 32 + (tid & 31), seg = tid >> 5;
            const float lr = ((const float*)(ws + WS_LAML))[(g * NP + p) * 2], li = ((const float*)(ws + WS_LAML))[(g * NP + p) * 2 + 1];
            const size_t base = (((size_t)(b * NG + g)) * NCHUNK + 32 * seg) * 128 + p;
            const size_t hbase = (((((size_t)(b * NG + g)) * 16 + seg) * 8 + (p >> 4)) * 32) * 16 + (p & 15);
            float er[32], ei[32];
#pragma unroll
            for (int k = 0; k < 32; ++k) { er[k] = Ebuf[base + (size_t)k * 128]; ei[k] = Ebuf[base + (size_t)k * 128 + 64]; }
            float hr = 0.f, hi_ = 0.f;
#pragma unroll
            for (int k = 0; k < 32; ++k) { const float nr = lr * hr - li * hi_ + er[k], ni = lr * hi_ + li * hr + ei[k]; hr = nr; hi_ = ni; }
            LAS float* se = (LAS float*)lds;
            se[(seg * 32 + (tid & 31)) * 2] = hr; se[(seg * 32 + (tid & 31)) * 2 + 1] = hi_;
            float pr = lr, pi = li;
#pragma unroll
            for (int q = 0; q < 5; ++q) { const float nr = pr * pr - pi * pi, ni = 2.f * pr * pi; pr = nr; pi = ni; }
            __syncthreads();
            hr = 0.f; hi_ = 0.f;
            for (int s2 = 0; s2 < seg; ++s2) { const float sr = se[(s2 * 32 + (tid & 31)) * 2], si = se[(s2 * 32 + (tid & 31)) * 2 + 1]; const float nr = pr * hr - pi * hi_ + sr, ni = pr * hi_ + pi * hr + si; hr = nr; hi_ = ni; }
#pragma unroll
            for (int k = 0; k < 32; ++k) {
                HB[hbase + k * 16] = (bf16)(pk2(hr, 0.f) & 0xffffu); HB[hbase + 4 * 512 + k * 16] = (bf16)(pk2(hi_, 0.f) & 0xffffu);
                const float nr = lr * hr - li * hi_ + er[k], ni = lr * hi_ + li * hr + ei[k]; hr = nr; hi_ = ni;
            }
            __syncthreads();
        }
        for (size_t idx = (size_t)bx * NTHR + tid; idx < (size_t)T * 64; idx += (size_t)G * NTHR) {
            const size_t tok = idx >> 6; const int j = (int)(idx >> 4) & 3, ch = (int)idx & 15;
            const float l0 = lse[tok * NH + j], l1 = lse[tok * NH + 4 + j], l2 = lse[tok * NH + 8 + j];
            const float m = fmaxf(l0, fmaxf(l1, l2));
            float w0 = __builtin_amdgcn_exp2f(l0 - m), w1 = __builtin_amdgcn_exp2f(l1 - m), w2 = __builtin_amdgcn_exp2f(l2 - m);
            const float inv = 1.0f / (w0 + w1 + w2); w0 *= inv; w1 *= inv; w2 *= inv;
            const v4u o0 = *(const v4u*)(opart + (tok * NH + j) * HD + ch * 8), o1 = *(const v4u*)(opart + (tok * NH + 4 + j) * HD + ch * 8), o2 = *(const v4u*)(opart + (tok * NH + 8 + j) * HD + ch * 8);
            v4u r;
            r.x = pk2(w0 * bflo(o0.x) + w1 * bflo(o1.x) + w2 * bflo(o2.x), w0 * bfhi(o0.x) + w1 * bfhi(o1.x) + w2 * bfhi(o2.x));
            r.y = pk2(w0 * bflo(o0.y) + w1 * bflo(o1.y) + w2 * bflo(o2.y), w0 * bfhi(o0.y) + w1 * bfhi(o1.y) + w2 * bfhi(o2.y));
            r.z = pk2(w0 * bflo(o0.z) + w1 * bflo(o1.z) + w2 * bflo(o2.z), w0 * bfhi(o0.z) + w1 * bfhi(o1.z) + w2 * bfhi(o2.z));
            r.w = pk2(w0 * bflo(o0.w) + w1 * bflo(o1.w) + w2 * bflo(o2.w), w0 * bfhi(o0.w) + w1 * bfhi(o1.w) + w2 * bfhi(o2.w));
            *(v4u*)(attn + tok * LDATT + j * HD + ch * 8) = r;
        }
    }
    SEAM();

    if (PH_ON(4)) PH_REP(4) {
        PH_IDS
        for (int bu = bx; bu < BATCH * (NCHUNK / 32) * 2 * (NG / 8); bu += G) {
            const int go = bu & 7, mg = (bu >> 3) & 1, nt = (bu >> 4) & 15, b = bu >> 8, g = go * 8 + wave;
            if (mg) ssm_out_unit<1>(ubuf, (const bf16*)(ws + WS_A3), HB, lds, wave, g, b, nt, lane);
            else ssm_out_unit<0>(ubuf, (const bf16*)(ws + WS_A3), HB, lds, wave, g, b, nt, lane);
            __syncthreads();
#pragma unroll
            for (int it = 0; it < 8; ++it) { const int id = it * NTHR + tid, row = id >> 4, ch = id & 15, n = row >> 3, il = row & 7;
                const v4u v = *(LAS v4u*)(lds + row * 256 + ((ch ^ (n & 15)) * 16));
                *(v4u*)(ybuf + (size_t)(b * SEQ + (32 * nt + n) * CL + 8 * mg + il) * LDY + go * 128 + ch * 8) = v; }
            __syncthreads();
        }
    }
    SEAM();

    if (PH_ON(5)) {
        pg8::Gemm g{ybuf, Wglu_t, T, 2 * DM, SSMW, LDY, LDY}; pg8::StaticOrder S; S.init(T, 2 * DM, G, bx, 1 + (((PH_DUP) >> 5) & 1));
        pg8::EpiGlu E{gates, msbuf};
        pg8::gemm_phase<pg8::EpiGlu, pg8::StaticOrder, PG8_ALIGN, PG8_SP2>(lds, g, S, E);
    }
    SEAM();

    if (PH_ON(6)) {
        pg8::Gemm g{attn, Wup_t, T, DM, AOW, LDATT, LDATT}; pg8::StaticOrder S; S.init(T, DM, G, bx);
        pg8::EpiMerge E{gates, msbuf};
        pg8::gemm_phase<pg8::EpiMerge, pg8::StaticOrder, PG8_ALIGN, PG8_SP2>(lds, g, S, E);
    }
    SEAM();

    if (PH_ON(7)) {
        pg8::Gemm g{msbuf, Wout_t, T, DM, DM, LDH, LDH}; pg8::PanelOrder S; S.init(G, bx);
        pg8::EpiNormMid E{a.x, (bf16*)(ws + WS_X1B), a.norm_mix_post, (float*)(ws + WS_ROWSS1), (unsigned*)(ws + WS_PCNT1), (float*)(ws + WS_ROWSS2)};
        pg8::gemm_phase<pg8::EpiNormMid, pg8::PanelOrder, PG8_ALIGN, PG8_SP2>(lds, g, S, E);
    }
    SEAM();

    if (PH_ON(9)) {
        pg8::Gemm g{(const bf16*)(ws + WS_X1B), Wffn_t, T, 2 * DFF, DM, DM, LDH}; pg8::StaticOrder S; S.init(T, 2 * DFF, G, bx, 1 + (((PH_DUP) >> 9) & 1));
        LAS float* rs = (LAS float*)(lds + RING_BYTES + 4096); const int rbase = (G == 256) ? (bx & 7) * 2048 : 0;
        for (int i = threadIdx.x; i < 2048; i += NTHR) rs[i] = rsqrtf(((const float*)(ws + WS_ROWSS2))[rbase + i] * (1.f / DM) + EPS);
        __syncthreads();
        pg8::EpiFfn E{act, (const float*)(ws + WS_ROWSS2), rs, rbase};
        pg8::gemm_phase<pg8::EpiFfn, pg8::StaticOrder, PG8_ALIGN, PG8_SP2>(lds, g, S, E);
    }
    SEAM();

    if (PH_ON(10)) {
        pg8::Gemm g{act, Wdown_t, T, DM, DFF, LDACT, LDACT}; pg8::PanelOrder S; S.init(G, bx);
        pg8::EpiNormOut E{a.out, (const bf16*)(ws + WS_X1B), a.norm_ffn_post, (float*)(ws + WS_ROWSS), (unsigned*)(ws + WS_PCNT)};
        pg8::gemm_phase<pg8::EpiNormOut, pg8::PanelOrder, PG8_ALIGN, PG8_SP2>(lds, g, S, E);
    }
}

extern "C" void kernel_launch(void* const* d_in, const int* in_sizes, int n_in, void* d_out, int out_size, void* d_ws, size_t ws_size, hipStream_t stream) {
    static int grid = 0;
    if (grid == 0) {
        if (n_in != 21 || in_sizes[0] != T * DM || out_size != T * DM || ws_size < WS_END) { fprintf(stderr, "kernel_launch: unexpected shapes (n_in %d, in0 %d, out %d, ws %zu < %zu); nothing launched\n", n_in, n_in > 0 ? in_sizes[0] : -1, out_size, ws_size, (size_t)WS_END); grid = -1; return; }
        int dev = 0, cus = 0, per_cu = 0;
        if (hipGetDevice(&dev) != hipSuccess || hipDeviceGetAttribute(&cus, hipDeviceAttributeMultiprocessorCount, dev) != hipSuccess) { grid = -1; return; }
        if (hipFuncSetAttribute((const void*)mega_fwd, hipFuncAttributeMaxDynamicSharedMemorySize, LDS_BYTES) != hipSuccess) { fprintf(stderr, "kernel_launch: hipFuncSetAttribute failed\n"); grid = -1; return; }
        if (hipOccupancyMaxActiveBlocksPerMultiprocessor(&per_cu, (const void*)mega_fwd, NTHR, LDS_BYTES) != hipSuccess || per_cu < 1) { fprintf(stderr, "kernel_launch: occupancy query reports %d blocks per CU; nothing launched\n", per_cu); (void)hipGetLastError(); grid = -1; return; }
        grid = cus;
    }
    if (grid < 0) return;
    Args a{};
    a.x = (const float*)d_in[0]; a.norm_mix_pre = (const float*)d_in[1]; a.w_in = (const float*)d_in[2]; a.w_attn_up = (const float*)d_in[3];
    a.a_re = (const float*)d_in[4]; a.a_im = (const float*)d_in[5]; a.log_dt = (const float*)d_in[6]; a.b_re = (const float*)d_in[7]; a.b_im = (const float*)d_in[8];
    a.c_re = (const float*)d_in[9]; a.c_im = (const float*)d_in[10]; a.ssm_d = (const float*)d_in[11];
    a.w_glu_v = (const float*)d_in[12]; a.w_glu_g = (const float*)d_in[13]; a.w_out = (const float*)d_in[14]; a.norm_mix_post = (const float*)d_in[15]; a.norm_ffn_pre = (const float*)d_in[16];
    a.w_ffn_gate = (const float*)d_in[17]; a.w_ffn_up = (const float*)d_in[18]; a.w_ffn_down = (const float*)d_in[19]; a.norm_ffn_post = (const float*)d_in[20];
    a.out = (float*)d_out; a.ws = (unsigned char*)d_ws;
    if (hipMemsetAsync((char*)d_ws + WS_BAR, 0, WS_BAR_BYTES, stream) != hipSuccess) { fprintf(stderr, "kernel_launch: hipMemsetAsync failed\n"); return; }
    void* args[] = {&a};
    const hipError_t e = hipLaunchCooperativeKernel((const void*)mega_fwd, dim3(grid), dim3(NTHR), args, LDS_BYTES, stream);
    if (e != hipSuccess) fprintf(stderr, "kernel_launch: cooperative launch failed: %s (grid %d)\n", hipGetErrorString(e), grid);
}
```

```cpp
#include <hip/hip_runtime.h>
#include <hip/hip_cooperative_groups.h>
#include <cstdio>
#include <cstdint>
namespace cg = cooperative_groups;
namespace pg8 {
#define PG8_LAS __attribute__((address_space(3)))
typedef unsigned short bf16_t;
typedef short bf16x8 __attribute__((ext_vector_type(8)));
typedef float f32x4 __attribute__((ext_vector_type(4)));
typedef unsigned u32x4 __attribute__((ext_vector_type(4)));
constexpr int BM = 256, BK = 64, HALF = 128, HTB = HALF * BK * 2  , STAGE_BYTES = 8 * HTB, NXCD = 8, WGM = 8;

__host__ __device__ __forceinline__ int lds_byte(int r, int c) { const int st = (r >> 4) * 2 + (c >> 5), rr = r & 15, cc = c & 31, ob = rr * 64 + cc * 2; return st * 1024 + (ob ^ (((ob >> 9) & 1) << 5)); }
__host__ __device__ __forceinline__ void stage_rc(int b, int& R, int& C) { const int st = b / 1024, sb = b % 1024, swz = sb ^ (((sb >> 9) & 1) << 5); R = (st >> 1) * 16 + swz / 64; C = (st & 1) * 32 + (swz % 64) / 2; }
__host__ __device__ __forceinline__ int perm32(int rho) { const int n = rho >> 4, i = rho & 15; return 8 * (i >> 2) + 4 * n + (i & 3); }

struct Unit { int pm, pn; };
struct Gemm { const bf16_t* A; const bf16_t* Bt; int M, N, K, lda, ldb; };

struct StaticOrder {
    int nM, nN, nwg, G, c, rep;
    __host__ __device__ void init(int M, int N, int G_, int c_, int rep_ = 1) { nM = M / BM; nN = N / BM; nwg = nM * nN; G = G_; c = c_; rep = rep_; }
    __host__ __device__ bool next(int i, Unit& u) const {
        const long L = (long)i * G + c; if (L >= (long)nwg * rep) return false;
        int wgid = (int)(L % nwg); { const int q = nwg / NXCD, r = nwg % NXCD, xcd = wgid % NXCD, off = wgid / NXCD; wgid = (xcd < r ? xcd * (q + 1) : r * (q + 1) + (xcd - r) * q) + off; }
        const int nig = WGM * nN, gid = wgid / nig, fm = gid * WGM, gsz = (nM - fm) < WGM ? (nM - fm) : WGM;
        u.pm = fm + ((wgid % nig) % gsz); u.pn = (wgid % nig) / gsz; return true;
    }
    __device__ __forceinline__ void a_ready(const Unit&) const {}
    __device__ __forceinline__ void done(const Unit&) const {}
};

__device__ __forceinline__ unsigned cvt_pk_bf16(float lo, float hi) { unsigned r; asm volatile("v_cvt_pk_bf16_f32 %0, %1, %2" : "=v"(r) : "v"(lo), "v"(hi)); return r; }
typedef float f32x2 __attribute__((ext_vector_type(2)));
template <class Epi, class Sched, bool ALIGN_EPI = false, bool SP2 = false>
__device__ __forceinline__ void gemm_phase(PG8_LAS unsigned char* lds, const Gemm g, const Sched& S, const Epi& E) {
    int tid_ = threadIdx.x; asm volatile("" : "+v"(tid_));
    const int tid = tid_, wid = __builtin_amdgcn_readfirstlane(tid >> 6), lane = tid & 63, wr = wid >> 2, wc = wid & 3, fr = lane & 15, fq = lane >> 4;
    const int K = g.K, nt = K / BK;
    unsigned voffA[2], voffB[2];
#pragma unroll
    for (int i = 0; i < 2; ++i) { int R, C; stage_rc(tid * 16 + i * 8192, R, C); const int Rb = Epi::PERM ? ((R & ~31) + perm32(R & 31)) : R;
        voffA[i] = (unsigned)(R * g.lda + C) * 2u; voffB[i] = (unsigned)(Rb * g.ldb + C) * 2u; }
    const size_t kstep = (size_t)(BK * 2);
    const size_t hstepA = (size_t)HALF * g.lda * 2, hstepB = (size_t)HALF * g.ldb * 2;
    const size_t tstepA = 2 * hstepA, tstepB = 2 * hstepB;
    const unsigned ldsw = (unsigned)wid * 1024u;
    const int aoff = lds_byte(wr * 64 + fr, fq * 8), boff = lds_byte(wc * 32 + fr, fq * 8);
#define PG8_SA(b, h) (((b) * 2 + (h)) * HTB)
#define PG8_SB(b, h) ((4 + (b) * 2 + (h)) * HTB)
#define PG8_STAGE(bufoff, gbase, voff) do { _Pragma("unroll") for (int _i = 0; _i < 2; ++_i) \
        __builtin_amdgcn_global_load_lds((const unsigned*)((const char*)(gbase) + (voff)[_i]), (PG8_LAS unsigned*)(lds + (bufoff) + ldsw + _i * 8192), 16, 0, 0); } while (0)
#define PG8_LDA(dst, b, h) do { _Pragma("unroll") for (int m = 0; m < 4; ++m) _Pragma("unroll") for (int k = 0; k < 2; ++k) dst[m][k] = *(const PG8_LAS bf16x8*)(lds + PG8_SA(b, h) + aoff + m * 2048 + k * 1024); } while (0)
#define PG8_LDB(dst, b, h) do { _Pragma("unroll") for (int n = 0; n < 2; ++n) _Pragma("unroll") for (int k = 0; k < 2; ++k) dst[n][k] = *(const PG8_LAS bf16x8*)(lds + PG8_SB(b, h) + boff + n * 2048 + k * 1024); } while (0)
#define PG8_MMA(ai, bj, At, Bt) do { __builtin_amdgcn_s_setprio(1); _Pragma("unroll") for (int m = 0; m < 4; ++m) _Pragma("unroll") for (int n = 0; n < 2; ++n) _Pragma("unroll") for (int k = 0; k < 2; ++k) \
        acc[ai][bj][m][n] = __builtin_amdgcn_mfma_f32_16x16x32_bf16(Bt[n][k], At[m][k], acc[ai][bj][m][n], 0, 0, 0); __builtin_amdgcn_s_setprio(0); } while (0)
#define PG8_WAIT_V(n) asm volatile("s_waitcnt vmcnt(" #n ")" ::: "memory")
#define PG8_WAIT_L(n) asm volatile("s_waitcnt lgkmcnt(" #n ")" ::: "memory")
#define PG8_BAR __builtin_amdgcn_s_barrier()
#define PG8_SCHED __builtin_amdgcn_sched_barrier(0)
    Unit cur, nxt; int ui = 0;
    if (!S.next(0, cur)) return;
    f32x4 acc[2][2][4][2];
#pragma unroll
    for (int a = 0; a < 2; ++a)
#pragma unroll
        for (int b = 0; b < 2; ++b)
#pragma unroll
            for (int m = 0; m < 4; ++m)
#pragma unroll
                for (int n = 0; n < 2; ++n) acc[a][b][m][n] = (f32x4){0.f, 0.f, 0.f, 0.f};
    bf16x8 At[4][2], B0[2][2], B1[2][2];
    const char* cA = (const char*)g.A + (size_t)cur.pm * tstepA; const char* cB = (const char*)g.Bt + (size_t)cur.pn * tstepB;
    S.a_ready(cur);
    if constexpr (SP2) {
        PG8_STAGE(PG8_SB(0, 0), cB, voffB); PG8_STAGE(PG8_SB(0, 1), cB + hstepB, voffB); PG8_STAGE(PG8_SA(0, 0), cA, voffA); PG8_STAGE(PG8_SA(0, 1), cA + hstepA, voffA);
        if (wr == 1) PG8_BAR;
        PG8_WAIT_V(2); PG8_BAR;
        PG8_STAGE(PG8_SB(1, 0), cB + kstep, voffB); PG8_STAGE(PG8_SA(1, 0), cA + kstep, voffA); PG8_STAGE(PG8_SB(1, 1), cB + hstepB + kstep, voffB);
        PG8_WAIT_V(6); PG8_BAR;
    } else {
        PG8_STAGE(PG8_SB(0, 0), cB, voffB); PG8_STAGE(PG8_SA(0, 0), cA, voffA); PG8_STAGE(PG8_SB(0, 1), cB + hstepB, voffB); PG8_STAGE(PG8_SA(0, 1), cA + hstepA, voffA);
        if (wr == 1) PG8_BAR;
        PG8_WAIT_V(4); PG8_BAR;
        PG8_STAGE(PG8_SB(1, 0), cB + kstep, voffB); PG8_STAGE(PG8_SA(1, 0), cA + kstep, voffA); PG8_STAGE(PG8_SB(1, 1), cB + hstepB + kstep, voffB);
        PG8_WAIT_V(6); PG8_BAR;
    }
    for (;;) {
        const bool has_next = S.next(ui + 1, nxt);
        const char* nA = has_next ? (const char*)g.A + (size_t)nxt.pm * tstepA : cA; const char* nB = has_next ? (const char*)g.Bt + (size_t)nxt.pn * tstepB : cB;
        for (int t = 0; t < nt; t += 2) {
            const bool last = (t == nt - 2);
            const char* a1 = cA + (size_t)(t + 1) * kstep;
            const char* a2 = last ? nA : cA + (size_t)(t + 2) * kstep; const char* b2 = last ? nB : cB + (size_t)(t + 2) * kstep;
            const char* a3 = a2 + kstep; const char* b3 = b2 + kstep;
            if (last && has_next) S.a_ready(nxt);
            if constexpr (SP2) {
            PG8_LDB(B0, 0, 0); PG8_LDB(B1, 0, 1); PG8_SCHED; PG8_LDA(At, 0, 0); PG8_STAGE(PG8_SA(1, 1), a1 + hstepA, voffA);
            PG8_WAIT_V(8); PG8_WAIT_L(0); PG8_BAR; PG8_MMA(0, 0, At, B0); PG8_MMA(0, 1, At, B1); PG8_BAR; PG8_SCHED;
            PG8_LDA(At, 0, 1); PG8_STAGE(PG8_SB(0, 0), b2, voffB); PG8_STAGE(PG8_SB(0, 1), b2 + hstepB, voffB); PG8_STAGE(PG8_SA(0, 0), a2, voffA);
            PG8_WAIT_V(8); PG8_WAIT_L(0); PG8_BAR; PG8_MMA(1, 0, At, B0); PG8_MMA(1, 1, At, B1); PG8_BAR; PG8_SCHED;
            PG8_LDB(B0, 1, 0); PG8_LDB(B1, 1, 1); PG8_SCHED; PG8_LDA(At, 1, 0); PG8_STAGE(PG8_SA(0, 1), a2 + hstepA, voffA);
            PG8_WAIT_V(8); PG8_WAIT_L(0); PG8_BAR; PG8_MMA(0, 0, At, B0); PG8_MMA(0, 1, At, B1); PG8_BAR; PG8_SCHED;
            PG8_LDA(At, 1, 1); PG8_STAGE(PG8_SB(1, 0), b3, voffB); PG8_STAGE(PG8_SB(1, 1), b3 + hstepB, voffB); PG8_STAGE(PG8_SA(1, 0), a3, voffA);
            PG8_WAIT_V(8); PG8_WAIT_L(0); PG8_BAR; PG8_MMA(1, 0, At, B0); PG8_MMA(1, 1, At, B1); PG8_BAR; PG8_SCHED;
            } else {
            PG8_LDB(B0, 0, 0); PG8_SCHED; PG8_LDA(At, 0, 0); PG8_STAGE(PG8_SA(1, 1), a1 + hstepA, voffA);
            PG8_WAIT_L(8); PG8_BAR; PG8_WAIT_L(0); PG8_MMA(0, 0, At, B0); PG8_BAR; PG8_SCHED;
            PG8_LDB(B1, 0, 1); PG8_STAGE(PG8_SB(0, 0), b2, voffB);
            PG8_BAR; PG8_WAIT_L(0); PG8_MMA(0, 1, At, B1); PG8_BAR;
            PG8_LDA(At, 0, 1); PG8_STAGE(PG8_SA(0, 0), a2, voffA);
            PG8_BAR; PG8_WAIT_L(0); PG8_MMA(1, 0, At, B0); PG8_BAR; PG8_SCHED;
            PG8_STAGE(PG8_SB(0, 1), b2 + hstepB, voffB);
            PG8_WAIT_V(6); PG8_BAR; PG8_MMA(1, 1, At, B1); PG8_BAR;
            PG8_LDB(B0, 1, 0); PG8_SCHED; PG8_LDA(At, 1, 0); PG8_STAGE(PG8_SA(0, 1), a2 + hstepA, voffA);
            PG8_WAIT_L(8); PG8_BAR; PG8_WAIT_L(0); PG8_MMA(0, 0, At, B0); PG8_BAR; PG8_SCHED;
            PG8_LDB(B1, 1, 1); PG8_STAGE(PG8_SB(1, 0), b3, voffB);
            PG8_BAR; PG8_WAIT_L(0); PG8_MMA(0, 1, At, B1); PG8_BAR;
            PG8_LDA(At, 1, 1); PG8_STAGE(PG8_SA(1, 0), a3, voffA);
            PG8_BAR; PG8_WAIT_L(0); PG8_MMA(1, 0, At, B0); PG8_BAR; PG8_SCHED;
            PG8_STAGE(PG8_SB(1, 1), b3 + hstepB, voffB);
            PG8_WAIT_V(6); PG8_BAR; PG8_MMA(1, 1, At, B1); PG8_BAR;
            }
        }
        if constexpr (ALIGN_EPI) { if (wr == 0) PG8_BAR; }
        if constexpr (!Epi::AFTER_DRAIN) { E(acc, cur, wr, wc, fr, fq); S.done(cur); }
        if (!has_next) break;
#pragma unroll
        for (int a = 0; a < 2; ++a)
#pragma unroll
            for (int b = 0; b < 2; ++b)
#pragma unroll
                for (int m = 0; m < 4; ++m)
#pragma unroll
                    for (int n = 0; n < 2; ++n) acc[a][b][m][n] = (f32x4){0.f, 0.f, 0.f, 0.f};
        cur = nxt; cA = nA; cB = nB; ++ui;
        if constexpr (ALIGN_EPI) { if (wr == 1) PG8_BAR; }
    }
    PG8_WAIT_V(0);
    if constexpr (!ALIGN_EPI) { if (wr == 0) PG8_BAR; }
    PG8_BAR;
    if constexpr (Epi::AFTER_DRAIN) { E.fused(acc, cur, wr, wc, fr, fq, lds, wid, lane); S.done(cur); }
#undef PG8_SA
#undef PG8_SB
#undef PG8_STAGE
#undef PG8_LDA
#undef PG8_LDB
#undef PG8_MMA
#undef PG8_WAIT_V
#undef PG8_WAIT_L
#undef PG8_BAR
#undef PG8_SCHED
}
}
#ifndef PG8_SP2
#define PG8_SP2 true
#endif
#ifndef PG8_ALIGN
#define PG8_ALIGN true
#endif

constexpr int BATCH = 2, SEQ = 8192, DM = 2048, T = BATCH * SEQ;
constexpr int HD = 128, NH = 12, HQ = 1536, SSMW = 1024, NG = 64, NP = 64, NC = 16;
constexpr int DFF = 5632, INW = 9728, QKVU = 5632, NGATE = INW - QKVU, AOW = 512;
constexpr int CL = 16, NCHUNK = SEQ / CL;
constexpr int A3W = CL * NC + 2 * NP;
constexpr float EPS = 1e-6f, LOG2E = 1.4426950408889634f;
constexpr int NWAVES = 8, NTHR = 512;
constexpr int PADE = 64;
constexpr int LDH = DM + PADE, LDQ = 3 * HQ + PADE, LDACT = DFF + PADE, LDATT = AOW + PADE, LDY = SSMW + PADE;

constexpr size_t WS_ROWSS1 = 196608, WS_ROWSS2 = 262144, WS_PCNT1 = 327680, WS_PCNT2 = 344064;
constexpr size_t WS_ROWSS = 65536, WS_PCNT = 131072;
constexpr size_t WS_BAR = 4096, WS_BAR_BYTES = 16384;
constexpr size_t WS_WFFN = 1u << 20;
constexpr size_t WS_WDOWN = WS_WFFN + (size_t)2 * DFF * LDH * 2;
constexpr size_t WS_WOUT = WS_WDOWN + (size_t)DM * LDACT * 2;
constexpr size_t WS_WIN = WS_WOUT + (size_t)DM * LDH * 2;
constexpr size_t WS_WUP = WS_WIN + (size_t)INW * LDH * 2;
constexpr size_t WS_WGLU = WS_WUP + (size_t)DM * LDATT * 2;
constexpr size_t WS_A3 = WS_WGLU + (size_t)2 * DM * LDY * 2;
constexpr size_t WS_WT = WS_A3 + (size_t)NG * 256 * A3W * 2;
constexpr size_t WS_LAML = WS_WT + (size_t)NG * 128 * 256 * 2;
constexpr size_t WS_X1B = WS_WIN;
static_assert(WS_X1B + (size_t)T * DM * 2 <= WS_LAML, "x1 overlay fits in the dead weight/table region");
constexpr size_t WS_RA = WS_LAML + 65536;
constexpr size_t WS_UB = WS_RA + (size_t)T * LDQ * 2;
constexpr size_t WS_RH = WS_RA + (size_t)T * LDACT * 2;
static_assert(WS_UB + (size_t)T * SSMW * 2 <= WS_RH, "u buffer fits behind qkv");
constexpr size_t WS_ATTN = WS_RH, WS_Y = WS_RH + (size_t)T * LDATT * 2;
static_assert(WS_Y + (size_t)T * LDY * 2 <= WS_RH + (size_t)T * LDH * 2, "attn + y fit in the h region");
constexpr size_t WS_RF = WS_RH + (size_t)T * LDH * 2;
constexpr size_t WS_OPART = WS_RF, WS_LSE = WS_OPART + (size_t)T * NH * HD * 2, WS_E = WS_LSE + (size_t)T * NH * 4;
constexpr size_t WS_HB = WS_E + (size_t)BATCH * NCHUNK * NG * 128 * 4, WS_END = WS_HB + (size_t)BATCH * NCHUNK * NG * 128 * 2;
static_assert(WS_END <= 536870912ull, "d_ws map exceeds 512 MiB");
static_assert(WS_RF + (size_t)T * LDH * 2 <= WS_END, "ms/f fit in the partials region");

constexpr int RING_BYTES = 131072, LDS_BYTES = 147456;

#define GAS __attribute__((address_space(1)))
#define LAS __attribute__((address_space(3)))
typedef unsigned short bf16;
typedef unsigned v4u __attribute__((ext_vector_type(4)));
typedef unsigned v2u __attribute__((ext_vector_type(2)));
typedef float f32x4 __attribute__((ext_vector_type(4)));
typedef float f32x16 __attribute__((ext_vector_type(16)));
typedef short bf16x8 __attribute__((ext_vector_type(8)));
typedef short v4i16_t __attribute__((ext_vector_type(4)));
typedef float f32x2_t __attribute__((ext_vector_type(2)));
typedef __bf16 bf16x2_t __attribute__((ext_vector_type(2)));

__device__ __forceinline__ unsigned pk2(float lo, float hi) { f32x2_t v = {lo, hi}; bf16x2_t b = __builtin_convertvector(v, bf16x2_t); return __builtin_bit_cast(unsigned, b); }
__device__ __forceinline__ float bflo(unsigned w) { return __uint_as_float(w << 16); }
__device__ __forceinline__ float bfhi(unsigned w) { return __uint_as_float(w & 0xffff0000u); }
__device__ __forceinline__ float sigmoidf_(float x) { return __builtin_amdgcn_rcpf(1.0f + __expf(-x)); }
__device__ __forceinline__ float gelu_tanh(float x) { const float z = 0.7978845608028654f * (x + 0.044715f * x * x * x); const float e = __expf(2.0f * z); return 0.5f * x * (2.0f - 2.0f * __builtin_amdgcn_rcpf(1.0f + e)); }
__device__ __forceinline__ float wave_sum(float v) {
#pragma unroll
    for (int o = 1; o < 64; o <<= 1) v += __shfl_xor(v, o);
    return v;
}
__device__ __forceinline__ int crow(int reg, int h) { return (reg & 3) + 8 * (reg >> 2) + 4 * h; }
#define MFMA32(a, b, c) __builtin_amdgcn_mfma_f32_32x32x16_bf16((a), (b), (c), 0, 0, 0)

namespace pg8 {
__device__ __forceinline__ u32x4 pack8(const f32x4 v0, const f32x4 v1) { u32x4 w; w.x = pk2(v0[0], v0[1]); w.y = pk2(v0[2], v0[3]); w.z = pk2(v1[0], v1[1]); w.w = pk2(v1[2], v1[3]); return w; }
__device__ __forceinline__ void unpack8(const u32x4 w, f32x4& v0, f32x4& v1) { v0 = (f32x4){bflo(w.x), bfhi(w.x), bflo(w.y), bfhi(w.y)}; v1 = (f32x4){bflo(w.z), bfhi(w.z), bflo(w.w), bfhi(w.w)}; }
__device__ __forceinline__ size_t gaddr(size_t row, int col) { return ((row >> 4) * (size_t)(NGATE / 8) + (size_t)(col >> 3)) * 128 + (row & 15) * 8; }
__device__ __forceinline__ f32x4 sig4(const f32x4 v) { return (f32x4){sigmoidf_(v[0]), sigmoidf_(v[1]), sigmoidf_(v[2]), sigmoidf_(v[3])}; }

struct EpiPlain {
    static constexpr bool PERM = true, AFTER_DRAIN = false;
    bf16_t* O; int ldc;
    __device__ __forceinline__ void operator()(const f32x4 (&acc)[2][2][4][2], const Unit& u, int wr, int wc, int fr, int fq) const {
        const int row0 = u.pm * BM + wr * 64 + fr, col0 = u.pn * BM + wc * 32 + 8 * fq;
#pragma unroll
        for (int ai = 0; ai < 2; ++ai)
#pragma unroll
            for (int m = 0; m < 4; ++m) { bf16_t* rowp = O + (size_t)(row0 + ai * HALF + m * 16) * ldc + col0;
#pragma unroll
                for (int bj = 0; bj < 2; ++bj) __builtin_nontemporal_store(pack8(acc[ai][bj][m][0], acc[ai][bj][m][1]), (u32x4*)(rowp + bj * HALF)); }
    }
};
struct EpiIn {
    static constexpr bool PERM = true, AFTER_DRAIN = false;
    bf16_t* qkv; bf16_t* ubuf; bf16_t* gates;
    __device__ __forceinline__ void operator()(const f32x4 (&acc)[2][2][4][2], const Unit& u, int wr, int wc, int fr, int fq) const {
        const int row0 = u.pm * BM + wr * 64 + fr; const int colt = u.pn * BM;
        if (colt < 3 * HQ) {
            const int col0 = colt + wc * 32 + 8 * fq;
#pragma unroll
            for (int ai = 0; ai < 2; ++ai)
#pragma unroll
                for (int m = 0; m < 4; ++m) { bf16_t* rowp = qkv + (size_t)(row0 + ai * HALF + m * 16) * LDQ + col0;
#pragma unroll
                    for (int bj = 0; bj < 2; ++bj) __builtin_nontemporal_store(pack8(acc[ai][bj][m][0], acc[ai][bj][m][1]), (u32x4*)(rowp + bj * HALF)); }
        } else if (colt < QKVU) {
            const int uc0 = colt - 3 * HQ + wc * 32 + 8 * fq;
#pragma unroll
            for (int ai = 0; ai < 2; ++ai)
#pragma unroll
                for (int m = 0; m < 4; ++m) { const int row = row0 + ai * HALF + m * 16, b = row / SEQ, t = row % SEQ;
#pragma unroll
                    for (int bj = 0; bj < 2; ++bj) { const int uc = uc0 + bj * HALF;
                        __builtin_nontemporal_store(pack8(acc[ai][bj][m][0], acc[ai][bj][m][1]), (u32x4*)(ubuf + (((((size_t)(b * NG + (uc >> 4))) * 16 + (t >> 9)) * 16 + (t & 15)) * 32 + ((t >> 4) & 31)) * NC + (uc & 15))); } }
        } else {
            const int col0 = colt - QKVU + wc * 32 + 8 * fq;
#pragma unroll
            for (int ai = 0; ai < 2; ++ai)
#pragma unroll
                for (int m = 0; m < 4; ++m) { const size_t row = (size_t)(row0 + ai * HALF + m * 16);
#pragma unroll
                    for (int bj = 0; bj < 2; ++bj) __builtin_nontemporal_store(pack8(sig4(acc[ai][bj][m][0]), sig4(acc[ai][bj][m][1])), (u32x4*)(gates + gaddr(row, col0 + bj * HALF))); }
        }
    }
};
struct EpiGlu {
    static constexpr bool PERM = true, AFTER_DRAIN = false;
    const bf16_t* gates; bf16_t* ms;
    __device__ __forceinline__ void operator()(const f32x4 (&acc)[2][2][4][2], const Unit& u, int wr, int wc, int fr, int fq) const {
        const int row0 = u.pm * BM + wr * 64 + fr, col0 = u.pn * HALF + wc * 32 + 8 * fq;
#pragma unroll
        for (int ai = 0; ai < 2; ++ai)
#pragma unroll
            for (int m = 0; m < 4; ++m) { const size_t row = (size_t)(row0 + ai * HALF + m * 16);
                const f32x4 v0 = acc[ai][0][m][0] * sig4(acc[ai][1][m][0]), v1 = acc[ai][0][m][1] * sig4(acc[ai][1][m][1]);
                __builtin_nontemporal_store(pack8(v0, v1), (u32x4*)(ms + row * LDH + col0)); }
    }
};
struct EpiMerge {
    static constexpr bool PERM = true, AFTER_DRAIN = false;
    const bf16_t* gates; bf16_t* ms;
    __device__ __forceinline__ void operator()(const f32x4 (&acc)[2][2][4][2], const Unit& u, int wr, int wc, int fr, int fq) const {
        const int row0 = u.pm * BM + wr * 64 + fr, col0 = u.pn * BM + wc * 32 + 8 * fq;
#pragma unroll
        for (int ai = 0; ai < 2; ++ai)
#pragma unroll
            for (int m = 0; m < 4; ++m) { const size_t row = (size_t)(row0 + ai * HALF + m * 16);
#pragma unroll
                for (int bj = 0; bj < 2; ++bj) { const int col = col0 + bj * HALF;
                    f32x4 g0, g1, h0, h1, s0, s1; unpack8(*(const u32x4*)(gates + gaddr(row, col)), g0, g1); unpack8(*(const u32x4*)(gates + gaddr(row, DM + col)), h0, h1); unpack8(*(const u32x4*)(ms + row * LDH + col), s0, s1);
                    __builtin_nontemporal_store(pack8(g0 * acc[ai][bj][m][0] + h0 * s0, g1 * acc[ai][bj][m][1] + h1 * s1), (u32x4*)(ms + row * LDH + col)); } }
    }
};
struct EpiFfn {
    static constexpr bool PERM = true, AFTER_DRAIN = false, REMAP = false;
    bf16_t* act; const float* rowss; const PG8_LAS float* rs; int rbase;
    __device__ __forceinline__ void operator()(const f32x4 (&acc)[2][2][4][2], const Unit& u, int wr, int wc, int fr, int fq) const {
        const int row0 = u.pm * BM + wr * 64 + fr, col0 = u.pn * HALF + wc * 32 + 8 * fq;
#pragma unroll
        for (int ai = 0; ai < 2; ++ai)
#pragma unroll
            for (int m = 0; m < 4; ++m) { const size_t row = (size_t)(row0 + ai * HALF + m * 16);
                const int ri = (int)row - rbase; const float r = ((unsigned)ri < 2048u) ? rs[ri] : rsqrtf(rowss[row] * (1.f / DM) + EPS);
                const f32x4 a0 = acc[ai][0][m][0] * r, a1 = acc[ai][0][m][1] * r;
                __builtin_nontemporal_store(pack8(a0 * sig4(a0) * (acc[ai][1][m][0] * r), a1 * sig4(a1) * (acc[ai][1][m][1] * r)), (u32x4*)(act + row * LDACT + col0)); }
    }
};
struct PanelOrder {
    int G, vcu;
    __device__ void init(int G_, int bx) { G = G_; vcu = (G_ % 8 == 0) ? (bx % 8) * (G_ / 8) + bx / 8 : bx; }
    __device__ bool next(int i, Unit& u) const { const int L = i * G + vcu; if (L >= (T / BM) * (DM / BM)) return false; u.pm = L >> 3; u.pn = L & 7; return true; }
    __device__ __forceinline__ void a_ready(const Unit&) const {}
    __device__ __forceinline__ void done(const Unit&) const {}
};
struct EpiNormOut {
    static constexpr bool PERM = true, AFTER_DRAIN = false, REMAP = false;
    float* out; const bf16_t* x1b; const float* gain; float* rowss; unsigned* pcnt;
    __device__ __forceinline__ void operator()(const f32x4 (&acc)[2][2][4][2], const Unit& u, int wr, int wc, int fr, int fq) const {
        const int row0 = u.pm * BM + wr * 64 + fr;
#pragma unroll
        for (int ai = 0; ai < 2; ++ai)
#pragma unroll
            for (int m = 0; m < 4; ++m) { float q = 0.f;
#pragma unroll
                for (int bj = 0; bj < 2; ++bj)
#pragma unroll
                    for (int n = 0; n < 2; ++n) { const f32x4 v = acc[ai][bj][m][n]; q += (v[0] * v[0] + v[1] * v[1]) + (v[2] * v[2] + v[3] * v[3]); }
                q += __shfl_xor(q, 16); q += __shfl_xor(q, 32);
                if (fq == 0) { const float old = __hip_atomic_fetch_add(rowss + row0 + ai * HALF + m * 16, q, __ATOMIC_RELAXED, __HIP_MEMORY_SCOPE_AGENT); asm volatile("" :: "v"(old)); } }
        asm volatile("s_waitcnt vmcnt(0)" ::: "memory");
        unsigned* cw = pcnt + 64 * u.pm;
        if ((threadIdx.x & 63) == 0) (void)__hip_atomic_fetch_add(cw, 1u, __ATOMIC_RELAXED, __HIP_MEMORY_SCOPE_AGENT);
        { unsigned sp = 0; while ((unsigned)__builtin_amdgcn_readfirstlane(__hip_atomic_load(cw, __ATOMIC_RELAXED, __HIP_MEMORY_SCOPE_AGENT)) < 64u) { __builtin_amdgcn_s_sleep(2); if (++sp > (1u << 20)) break; } }
        asm volatile("" ::: "memory");
        const int col0 = u.pn * BM + wc * 32 + 8 * fq;
#pragma unroll
        for (int ai = 0; ai < 2; ++ai)
#pragma unroll
            for (int m = 0; m < 4; ++m) { const int row = row0 + ai * HALF + m * 16;
                const float rstd = rsqrtf(__hip_atomic_load(rowss + row, __ATOMIC_RELAXED, __HIP_MEMORY_SCOPE_AGENT) * (1.f / DM) + EPS);
#pragma unroll
                for (int bj = 0; bj < 2; ++bj) { float* op = out + (size_t)row * DM + col0 + bj * HALF; const float* gp = gain + col0 + bj * HALF;
                    f32x4 x0, x1; unpack8(*(const u32x4*)(x1b + (size_t)row * DM + col0 + bj * HALF), x0, x1); const f32x4 g0 = *(const f32x4*)gp, g1 = *(const f32x4*)(gp + 4);
                    __builtin_nontemporal_store(x0 + acc[ai][bj][m][0] * rstd * g0, (f32x4*)op); __builtin_nontemporal_store(x1 + acc[ai][bj][m][1] * rstd * g1, (f32x4*)(op + 4)); } }
    }
};
struct EpiNormMid {
    static constexpr bool PERM = true, AFTER_DRAIN = false, REMAP = false;
    const float* x; bf16_t* x1o; const float* gpost; float* rowss1; unsigned* pcnt1; float* rowss2;
    __device__ __forceinline__ static void arrive_wait(unsigned* cw) {
        asm volatile("s_waitcnt vmcnt(0)" ::: "memory");
        if ((threadIdx.x & 63) == 0) (void)__hip_atomic_fetch_add(cw, 1u, __ATOMIC_RELAXED, __HIP_MEMORY_SCOPE_AGENT);
        unsigned sp = 0; while ((unsigned)__builtin_amdgcn_readfirstlane(__hip_atomic_load(cw, __ATOMIC_RELAXED, __HIP_MEMORY_SCOPE_AGENT)) < 64u) { __builtin_amdgcn_s_sleep(2); if (++sp > (1u << 20)) break; }
        asm volatile("" ::: "memory");
    }
    __device__ __forceinline__ void operator()(const f32x4 (&acc_)[2][2][4][2], const Unit& u, int wr, int wc, int fr, int fq) const {
        f32x4 (&acc)[2][2][4][2] = const_cast<f32x4 (&)[2][2][4][2]>(acc_);
        const int row0 = u.pm * BM + wr * 64 + fr, col0 = u.pn * BM + wc * 32 + 8 * fq;
#pragma unroll
        for (int ai = 0; ai < 2; ++ai)
#pragma unroll
            for (int m = 0; m < 4; ++m) { float q = 0.f;
#pragma unroll
                for (int bj = 0; bj < 2; ++bj)
#pragma unroll
                    for (int n = 0; n < 2; ++n) { const f32x4 v = acc[ai][bj][m][n]; q += (v[0] * v[0] + v[1] * v[1]) + (v[2] * v[2] + v[3] * v[3]); }
                q += __shfl_xor(q, 16); q += __shfl_xor(q, 32);
                if (fq == 0) { const float old = __hip_atomic_fetch_add(rowss1 + row0 + ai * HALF + m * 16, q, __ATOMIC_RELAXED, __HIP_MEMORY_SCOPE_AGENT); asm volatile("" :: "v"(old)); } }
        arrive_wait(pcnt1 + 64 * u.pm);
#pragma unroll
        for (int ai = 0; ai < 2; ++ai)
#pragma unroll
            for (int m = 0; m < 4; ++m) { const int row = row0 + ai * HALF + m * 16; float q = 0.f;
                const float rstd = rsqrtf(__hip_atomic_load(rowss1 + row, __ATOMIC_RELAXED, __HIP_MEMORY_SCOPE_AGENT) * (1.f / DM) + EPS);
#pragma unroll
                for (int bj = 0; bj < 2; ++bj) { const size_t off = (size_t)row * DM + col0 + bj * HALF; const float* gp = gpost + col0 + bj * HALF;
                    const f32x4 x0 = __builtin_nontemporal_load((const f32x4*)(x + off)), x1 = __builtin_nontemporal_load((const f32x4*)(x + off + 4)), g0 = *(const f32x4*)gp, g1 = *(const f32x4*)(gp + 4);
                    const f32x4 v0 = x0 + acc[ai][bj][m][0] * rstd * g0, v1 = x1 + acc[ai][bj][m][1] * rstd * g1;
                    acc[ai][bj][m][0] = v0; acc[ai][bj][m][1] = v1;
                    *(u32x4*)(x1o + off) = pack8(v0, v1);
                    q += (v0[0] * v0[0] + v0[1] * v0[1]) + (v0[2] * v0[2] + v0[3] * v0[3]) + (v1[0] * v1[0] + v1[1] * v1[1]) + (v1[2] * v1[2] + v1[3] * v1[3]); }
                q += __shfl_xor(q, 16); q += __shfl_xor(q, 32);
                if (fq == 0) { const float old = __hip_atomic_fetch_add(rowss2 + row, q, __ATOMIC_RELAXED, __HIP_MEMORY_SCOPE_AGENT); asm volatile("" :: "v"(old)); } }
    }
};
}

struct Args {
    const float* x; const float* norm_mix_pre; const float* w_in; const float* w_attn_up;
    const float* a_re; const float* a_im; const float* log_dt; const float* b_re; const float* b_im; const float* c_re; const float* c_im; const float* ssm_d;
    const float* w_glu_v; const float* w_glu_g; const float* w_out; const float* norm_mix_post; const float* norm_ffn_pre;
    const float* w_ffn_gate; const float* w_ffn_up; const float* w_ffn_down; const float* norm_ffn_post;
    float* out; unsigned char* ws;
};

struct TrItem { const float* W; bf16* WT; const float* kg; int K, N, k0, n0, drow0; };
__device__ __forceinline__ void tr_load(const TrItem& t, float (&wv)[32], int lane) {
#pragma unroll
    for (int i = 0; i < 32; ++i) { const int kk = 2 * i + (lane >> 5); wv[i] = __builtin_nontemporal_load(t.W + (size_t)(t.k0 + kk) * t.N + t.n0 + (lane & 31)); }
    if (t.kg) {
#pragma unroll
        for (int i = 0; i < 32; ++i) wv[i] *= t.kg[t.k0 + 2 * i + (lane >> 5)]; }
}
__device__ __forceinline__ void tr_finish(const TrItem& t, const float (&wv)[32], LAS float* scr, int lane) {
    const int ldb = t.K + PADE;
#pragma unroll
    for (int i = 0; i < 32; ++i) { const int kk = 2 * i + (lane >> 5); scr[kk * 33 + (lane & 31)] = wv[i]; }
    asm volatile("s_waitcnt lgkmcnt(0)" ::: "memory");
    const int c = lane & 7;
#pragma unroll
    for (int j = 0; j < 4; ++j) { const int n = (lane >> 3) + 8 * j; const LAS float* s = scr + (8 * c) * 33 + n;
        v4u o; o.x = pk2(s[0 * 33], s[1 * 33]); o.y = pk2(s[2 * 33], s[3 * 33]); o.z = pk2(s[4 * 33], s[5 * 33]); o.w = pk2(s[6 * 33], s[7 * 33]);
        *(v4u*)(t.WT + (size_t)(t.drow0 + n) * ldb + t.k0 + 8 * c) = o; }
    asm volatile("s_waitcnt lgkmcnt(0)" ::: "memory");
}
__device__ __forceinline__ TrItem tr_make(const float* W, int K, int N, bf16* WT, int mode, int item, const float* kg = nullptr) {
    const int nblk = N / 32, kb = item / nblk, nb = item % nblk, n0 = 32 * nb;
    TrItem t; t.W = W; t.WT = WT; t.kg = kg; t.K = K; t.N = N; t.k0 = 64 * kb; t.n0 = n0; t.drow0 = (mode == 0) ? n0 : ((n0 >> 7) * 256 + (mode - 1) * 128 + (n0 & 127));
    return t;
}
__device__ __forceinline__ void p0_transpose(const float* W, int K, int N, bf16* WT, int mode, int item, LAS float* scr, int lane, const float* kg = nullptr) {
    const TrItem t = tr_make(W, K, N, WT, mode, item, kg); float wv[32]; tr_load(t, wv, lane); tr_finish(t, wv, scr, lane);
}
__device__ __forceinline__ void rms_row_to_bf16(const float* xrow, const float* gain, bf16* orow, int lane) {
    f32x4 v[8]; float s = 0.f;
#pragma unroll
    for (int j = 0; j < 8; ++j) { v[j] = *(const f32x4*)(xrow + 4 * (lane + 64 * j)); s += (v[j].x * v[j].x + v[j].y * v[j].y) + (v[j].z * v[j].z + v[j].w * v[j].w); }
    const float rstd = rsqrtf(wave_sum(s) * (1.f / DM) + EPS);
#pragma unroll
    for (int j = 0; j < 8; ++j) { const f32x4 g = *(const f32x4*)(gain + 4 * (lane + 64 * j)); v2u o; o.x = pk2(v[j].x * rstd * g.x, v[j].y * rstd * g.y); o.y = pk2(v[j].z * rstd * g.z, v[j].w * rstd * g.w);
        *(v2u*)(orow + 4 * (lane + 64 * j)) = o; }
}

__device__ __forceinline__ void rms_row2_to_bf16(const float* x0, const float* x1, const float* gain, bf16* o0, bf16* o1, int lane) {
    f32x4 v[8], w[8]; float s = 0.f, q = 0.f;
#pragma unroll
    for (int j = 0; j < 8; ++j) { v[j] = __builtin_nontemporal_load((const f32x4*)(x0 + 4 * (lane + 64 * j))); w[j] = __builtin_nontemporal_load((const f32x4*)(x1 + 4 * (lane + 64 * j))); }
#pragma unroll
    for (int j = 0; j < 8; ++j) { s += (v[j].x * v[j].x + v[j].y * v[j].y) + (v[j].z * v[j].z + v[j].w * v[j].w); q += (w[j].x * w[j].x + w[j].y * w[j].y) + (w[j].z * w[j].z + w[j].w * w[j].w); }
    const float rs = rsqrtf(wave_sum(s) * (1.f / DM) + EPS), rq = rsqrtf(wave_sum(q) * (1.f / DM) + EPS);
#pragma unroll
    for (int j = 0; j < 8; ++j) { const f32x4 g = *(const f32x4*)(gain + 4 * (lane + 64 * j));
        v2u a; a.x = pk2(v[j].x * rs * g.x, v[j].y * rs * g.y); a.y = pk2(v[j].z * rs * g.z, v[j].w * rs * g.w); *(v2u*)(o0 + 4 * (lane + 64 * j)) = a;
        v2u b; b.x = pk2(w[j].x * rq * g.x, w[j].y * rq * g.y); b.y = pk2(w[j].z * rq * g.z, w[j].w * rq * g.w); *(v2u*)(o1 + 4 * (lane + 64 * j)) = b; }
}
__device__ __forceinline__ void ssm_tables(const Args& a, int g, LAS unsigned char* lds, int tid) {
    LAS float* pw = (LAS float*)lds;
    LAS float* beta = pw + 64 * 17 * 2;
    LAS float* gam = beta + 64 * 16 * 2;
    LAS float* kt = gam + 16 * 64 * 2;
    unsigned char* ws = a.ws;
    if (tid < 64) {
        const int p = tid;
        const double dt = exp((double)a.log_dt[g]);
        const double are = (double)a.a_re[g * NP + p], aim = (double)a.a_im[g * NP + p];
        const double mag = exp(are * dt), ang = aim * dt;
        const double lr = mag * cos(ang), li = mag * sin(ang);
        const double den = are * are + aim * aim;
        const double cr = ((lr - 1.0) * are + li * aim) / den, ci = (li * are - (lr - 1.0) * aim) / den;
        double pr = 1.0, pi = 0.0;
        for (int d = 0; d <= CL; ++d) { pw[(p * 17 + d) * 2] = (float)pr; pw[(p * 17 + d) * 2 + 1] = (float)pi; const double nr = pr * lr - pi * li, ni = pr * li + pi * lr; pr = nr; pi = ni; }
        for (int c = 0; c < NC; ++c) { const double br = (double)a.b_re[(g * NP + p) * NC + c], bi = (double)a.b_im[(g * NP + p) * NC + c];
            beta[(p * 16 + c) * 2] = (float)(cr * br - ci * bi); beta[(p * 16 + c) * 2 + 1] = (float)(cr * bi + ci * br); }
        float* lamL = (float*)(ws + WS_LAML) + (g * NP + p) * 2;
        lamL[0] = pw[(p * 17 + CL) * 2]; lamL[1] = pw[(p * 17 + CL) * 2 + 1];
    }
    for (int idx = tid; idx < NC * NP; idx += NTHR) { gam[idx * 2] = a.c_re[g * NC * NP + idx]; gam[idx * 2 + 1] = a.c_im[g * NC * NP + idx]; }
    __syncthreads();
    for (int e = tid; e < CL * 256; e += NTHR) {
        const int d = e >> 8, c = (e >> 4) & 15, c2 = e & 15; float s = 0.f;
        for (int p = 0; p < NP; ++p) { const float gr = gam[(c * 64 + p) * 2], gi = gam[(c * 64 + p) * 2 + 1], wr_ = pw[(p * 17 + d) * 2], wi_ = pw[(p * 17 + d) * 2 + 1], br = beta[(p * 16 + c2) * 2], bi = beta[(p * 16 + c2) * 2 + 1];
            const float zr = gr * wr_ - gi * wi_, zi = gr * wi_ + gi * wr_; s += zr * br - zi * bi; }
        if (d == 0 && c == c2) s += a.ssm_d[g * NC + c];
        kt[e] = s;
    }
    __syncthreads();
    bf16* A3 = (bf16*)(ws + WS_A3) + (size_t)g * 256 * A3W;
    for (int cidx = tid; cidx < 256 * (A3W / 8); cidx += NTHR) {
        const int row = cidx / (A3W / 8), cc = cidx % (A3W / 8), i = row >> 4, c = row & 15; float v[8];
        if (cc < 32) { const int j = cc >> 1, c0 = (cc & 1) * 8;
#pragma unroll
            for (int e = 0; e < 8; ++e) v[e] = (j <= i) ? kt[((i - j) * 16 + c) * 16 + c0 + e] : 0.f;
        } else { const int pidx0 = (cc - 32) * 8, part = pidx0 >> 6, p0 = pidx0 & 63;
#pragma unroll
            for (int e = 0; e < 8; ++e) { const int p = p0 + e; const float gr = gam[(c * 64 + p) * 2], gi = gam[(c * 64 + p) * 2 + 1], wr_ = pw[(p * 17 + i + 1) * 2], wi_ = pw[(p * 17 + i + 1) * 2 + 1];
                v[e] = part ? -(gr * wi_ + gi * wr_) : (gr * wr_ - gi * wi_); }
        }
        v4u o; o.x = pk2(v[0], v[1]); o.y = pk2(v[2], v[3]); o.z = pk2(v[4], v[5]); o.w = pk2(v[6], v[7]);
        *(v4u*)(A3 + ((((size_t)(row >> 5)) * 24 + (cc >> 1)) * 64 + ((cc & 1) * 32 + (row & 31))) * 8) = o;
    }
    bf16* WTt = (bf16*)(ws + WS_WT) + (size_t)g * 128 * 256;
    for (int cidx = tid; cidx < 128 * 32; cidx += NTHR) {
        const int row = cidx >> 5, cc = cidx & 31, part = row >> 6, p = row & 63, j = cc >> 1, c0 = (cc & 1) * 8; float v[8];
        const float wr_ = pw[(p * 17 + (CL - 1 - j)) * 2], wi_ = pw[(p * 17 + (CL - 1 - j)) * 2 + 1];
#pragma unroll
        for (int e = 0; e < 8; ++e) { const float br = beta[(p * 16 + c0 + e) * 2], bi = beta[(p * 16 + c0 + e) * 2 + 1]; v[e] = part ? (wr_ * bi + wi_ * br) : (wr_ * br - wi_ * bi); }
        v4u o; o.x = pk2(v[0], v[1]); o.y = pk2(v[2], v[3]); o.z = pk2(v[4], v[5]); o.w = pk2(v[6], v[7]);
        *(v4u*)(WTt + ((((size_t)(row >> 5)) * 16 + (cc >> 1)) * 64 + ((cc & 1) * 32 + (row & 31))) * 8) = o;
    }
    __syncthreads();
}

__device__ __forceinline__ unsigned voff_b(int row, int ch) { return 256u * row + 16u * (ch ^ (((row & 3) << 2) | ((row >> 2) & 3))); }
__device__ __forceinline__ v4i16_t trrd(LAS unsigned char* p) { return __builtin_amdgcn_ds_read_tr16_b64_v4i16((LAS v4i16_t*)p); }
__device__ __forceinline__ void attn_wave_tile(const bf16* qkvu, bf16* opart, float* lse, int b, int h, int tile, LAS unsigned char* vl, int lane) {
    asm volatile("" : "+v"(lane));
    const int g = h >> 2, dl = 2 * g;
    const int tps = (SEQ >> dl) >> 5, res = tile / tps, m0 = (tile % tps) * 32;
    const int r32 = lane & 31, hi = lane >> 5;
    const float sl2 = exp2f(-8.0f * (float)(h + 1) / 12.0f) * LOG2E * (float)(1 << dl);
    const float sc2 = LOG2E * 0.08838834764831845f;
    const bf16* base = qkvu + (size_t)(b * SEQ + res) * LDQ + h * HD;
    const bf16* qrow = base + ((size_t)(m0 + r32) << dl) * LDQ;
    LAS unsigned char* kl = vl + 8192;
    const int lrow = lane >> 4, lch = lane & 15;
    v4u kst[8];
#pragma unroll
    for (int it = 0; it < 8; ++it) kst[it] = *(const v4u*)(base + ((size_t)(m0 + it * 4 + lrow) << dl) * LDQ + lch * 8);
#pragma unroll
    for (int it = 0; it < 8; ++it) *(LAS v4u*)(kl + voff_b(it * 4 + lrow, lch)) = kst[it];
    bf16x8 qf[8];
#pragma unroll
    for (int kk = 0; kk < 8; ++kk) qf[kk] = *(LAS bf16x8*)(kl + voff_b(r32, 2 * kk + hi));
    int Ld = r32 - 4 * hi; asm volatile("" : "+v"(Ld));
    const float bl = -sl2 * (float)Ld;
#define ATT_KLOAD(kt_) do { _Pragma("unroll") for (int it = 0; it < 8; ++it) { int kidx_ = m0 - 128 + 32 * (kt_) + it * 4 + lrow; kidx_ = kidx_ < 0 ? 0 : kidx_; \
        kst[it] = *(const v4u*)((const char*)base + (unsigned)(((unsigned)kidx_ << dl) * (unsigned)(LDQ * 2) + (unsigned)(2 * HQ) + (unsigned)(lch * 16))); } } while (0)
    ATT_KLOAD(0);
    f32x16 S[5];
    float mx = -INFINITY;
#pragma unroll
    for (int kt = 0; kt < 5; ++kt) {
#pragma unroll
        for (int it = 0; it < 8; ++it) *(LAS v4u*)(kl + voff_b(it * 4 + lrow, lch)) = kst[it];
        if (kt < 4) ATT_KLOAD(kt + 1);
        __builtin_amdgcn_sched_barrier(0);
        f32x16 s = {};
#pragma unroll
        for (int kk = 0; kk < 8; ++kk) { const bf16x8 kf = *(LAS bf16x8*)(kl + voff_b(r32, 2 * kk + hi)); s = MFMA32(kf, qf[kk], s); }
        const bool tneg = (m0 - 128 + 32 * kt) < 0;
#pragma unroll
        for (int r = 0; r < 16; ++r) { const int C = 128 - 32 * kt - ((r & 3) + 8 * (r >> 2));
            float v = fmaf(s[r], sc2, bl) - sl2 * (float)C;
            if (kt == 0) v = (C + Ld > 128) ? -INFINITY : v;
            if (kt == 4) v = (C + Ld < 0) ? -INFINITY : v;
            if (kt < 4) v = tneg ? -INFINITY : v;
            s[r] = v; mx = fmaxf(mx, v); }
        S[kt] = s;
        __builtin_amdgcn_sched_barrier(0);
    }
#undef ATT_KLOAD
    v4u vst[2][8];
#define ATT_VLOAD(buf, kt_) do { _Pragma("unroll") for (int it = 0; it < 8; ++it) { int vidx_ = m0 - 128 + 32 * (kt_) + it * 4 + (lane >> 4); vidx_ = vidx_ < 0 ? 0 : vidx_; \
        vst[buf][it] = *(const v4u*)((const char*)base + (unsigned)(((unsigned)vidx_ << dl) * (unsigned)(LDQ * 2) + (unsigned)(4 * HQ) + (unsigned)((lane & 15) * 16))); } } while (0)
    ATT_VLOAD(0, 0); ATT_VLOAD(1, 1);
    __builtin_amdgcn_sched_barrier(0);
    mx = fmaxf(mx, __shfl_xor(mx, 32));
    float l = 0.f;
    v4u Pp[5][2];
#pragma unroll
    for (int kt = 0; kt < 5; ++kt) {
#pragma unroll
        for (int r = 0; r < 16; ++r) { const float p = __builtin_amdgcn_exp2f(S[kt][r] - mx); S[kt][r] = p; l += p; }
#pragma unroll
        for (int s = 0; s < 2; ++s) { Pp[kt][s].x = pk2(S[kt][8 * s + 0], S[kt][8 * s + 1]); Pp[kt][s].y = pk2(S[kt][8 * s + 2], S[kt][8 * s + 3]); Pp[kt][s].z = pk2(S[kt][8 * s + 4], S[kt][8 * s + 5]); Pp[kt][s].w = pk2(S[kt][8 * s + 6], S[kt][8 * s + 7]); }
    }
    l += __shfl_xor(l, 32);
    f32x16 O[4];
#pragma unroll
    for (int dv = 0; dv < 4; ++dv) O[dv] = (f32x16){};
    const int q4 = (lane & 15) >> 2, p4 = lane & 3, blk = (lane >> 4) & 1;
#pragma unroll
    for (int kt = 0; kt < 5; ++kt) {
#pragma unroll
        for (int it = 0; it < 8; ++it) { const int row = it * 4 + (lane >> 4); *(LAS v4u*)(vl + voff_b(row, lane & 15)) = vst[kt & 1][it]; }
        if (kt < 3) ATT_VLOAD(kt & 1, kt + 2);
        __builtin_amdgcn_sched_barrier(0);
#pragma unroll
        for (int s = 0; s < 2; ++s) {
            const bf16x8 pf = __builtin_bit_cast(bf16x8, Pp[kt][s]);
#pragma unroll
            for (int dv = 0; dv < 4; ++dv) {
                const int c = 4 * dv + 2 * blk + (p4 >> 1);
                const v4i16_t lo = trrd(vl + voff_b(16 * s + 4 * hi + q4, c) + 8 * (p4 & 1));
                const v4i16_t hh = trrd(vl + voff_b(16 * s + 8 + 4 * hi + q4, c) + 8 * (p4 & 1));
                const bf16x8 vf = __builtin_shufflevector(lo, hh, 0, 1, 2, 3, 4, 5, 6, 7);
                O[dv] = MFMA32(vf, pf, O[dv]);
            }
        }
        __builtin_amdgcn_sched_barrier(0);
    }
#undef ATT_VLOAD
    const float inv = 1.0f / l;
    const size_t tok = (size_t)b * SEQ + ((size_t)(m0 + r32) << dl) + res;
#pragma unroll
    for (int dv = 0; dv < 4; ++dv)
#pragma unroll
        for (int gq = 0; gq < 4; ++gq) { v2u o; o.x = pk2(O[dv][4 * gq] * inv, O[dv][4 * gq + 1] * inv); o.y = pk2(O[dv][4 * gq + 2] * inv, O[dv][4 * gq + 3] * inv);
            *(LAS v2u*)(vl + voff_b(r32, 4 * dv + gq) + 8 * hi) = o; }
#pragma unroll
    for (int it = 0; it < 8; ++it) { const int row = it * 4 + (lane >> 4); const v4u v = *(LAS v4u*)(vl + voff_b(row, lane & 15));
        const size_t tk = (size_t)b * SEQ + ((size_t)(m0 + row) << dl) + res;
        *(v4u*)(opart + (tk * NH + h) * HD + (lane & 15) * 8) = v; }
    if (hi == 0) lse[tok * NH + h] = mx + __log2f(l);
}

__device__ __forceinline__ void ssm_estate_unit(const bf16* ubuf, const bf16* WTt, float* E, LAS unsigned char* el, int g, int b, int nt, int lane) {
    const int r32 = lane & 31, hi = lane >> 5, chunk = 32 * nt + r32;
    const bf16* up = ubuf + ((((size_t)(b * NG + g)) * 16 + nt) * 16 * 32 + r32) * NC + 8 * hi;
    const bf16* wp = WTt + ((size_t)g * 4 * 16 * 64 + lane) * 8;
    f32x16 acc[4];
#pragma unroll
    for (int mt = 0; mt < 4; ++mt) acc[mt] = (f32x16){};
#pragma unroll 8
    for (int j = 0; j < CL; ++j) {
        const bf16x8 bf = *(const bf16x8*)(up + j * 512);
#pragma unroll
        for (int mt = 0; mt < 4; ++mt) { const bf16x8 af = *(const bf16x8*)(wp + (mt * 16 + j) * 512); acc[mt] = MFMA32(af, bf, acc[mt]); }
    }
#pragma unroll
    for (int mt = 0; mt < 4; ++mt)
#pragma unroll
        for (int gq = 0; gq < 4; ++gq) *(LAS f32x4*)(el + r32 * 512 + (((8 * mt + 2 * gq + hi) ^ r32) * 16)) = (f32x4){acc[mt][4 * gq], acc[mt][4 * gq + 1], acc[mt][4 * gq + 2], acc[mt][4 * gq + 3]};
    float* ep = E + (((size_t)(b * NG + g)) * NCHUNK + 32 * nt) * 128;
#pragma unroll
    for (int it = 0; it < 16; ++it) { const int id = it * 64 + lane, n = id >> 5, pc = id & 31; const f32x4 v = *(LAS f32x4*)(el + id * 16); *(f32x4*)(ep + n * 128 + ((pc ^ n) * 4)) = v; }
}
template <int mg> __device__ __forceinline__ void ssm_out_unit(const bf16* ubuf, const bf16* A3, const bf16* HB, LAS unsigned char* yt, int wave, int g, int b, int nt, int lane) {
    const int r32 = lane & 31, hi = lane >> 5, chunk = 32 * nt + r32;
    const bf16* up = ubuf + ((((size_t)(b * NG + g)) * 16 + nt) * 16 * 32 + r32) * NC + 8 * hi;
    const bf16* hp = HB + ((((size_t)(b * NG + g)) * 16 + nt) * 8 * 32 + r32) * 16 + 8 * hi;
    const bf16* ap = A3 + (((size_t)(g * 8 + 4 * mg)) * 24 * 64 + lane) * 8;
    f32x16 acc[4];
#pragma unroll
    for (int mt = 0; mt < 4; ++mt) acc[mt] = (f32x16){};
    constexpr int jmax = 8 * mg + 8;
#pragma unroll 8
    for (int j = 0; j < jmax; ++j) {
        const bf16x8 bf = *(const bf16x8*)(up + j * 512);
#pragma unroll
        for (int mt = 0; mt < 4; ++mt) { const bf16x8 af = *(const bf16x8*)(ap + (mt * 24 + j) * 512); acc[mt] = MFMA32(af, bf, acc[mt]); }
    }
#pragma unroll 8
    for (int ks = 0; ks < 8; ++ks) {
        const bf16x8 bf = *(const bf16x8*)(hp + ks * 512);
#pragma unroll
        for (int mt = 0; mt < 4; ++mt) { const bf16x8 af = *(const bf16x8*)(ap + (mt * 24 + 16 + ks) * 512); acc[mt] = MFMA32(af, bf, acc[mt]); }
    }
#pragma unroll
    for (int mt = 0; mt < 4; ++mt)
#pragma unroll
        for (int gq = 0; gq < 4; ++gq) {
            const int il = 2 * mt + (gq >> 1), ch = (wave * 2 + (gq & 1)) ^ (r32 & 15);
            v2u o; o.x = pk2(gelu_tanh(acc[mt][4 * gq]), gelu_tanh(acc[mt][4 * gq + 1])); o.y = pk2(gelu_tanh(acc[mt][4 * gq + 2]), gelu_tanh(acc[mt][4 * gq + 3]));
            *(LAS v2u*)(yt + (r32 * 8 + il) * 256 + ch * 16 + 8 * hi) = o;
        }
}

template <int NR> __device__ __forceinline__ void norm1_rows(const float* x, const bf16* o, const float* gpost, const float* gpre, float* x1, bf16* h2, int m, int mstep, int lane) {
    f32x4 v[NR][8], xv[NR][8]; float s[NR], s1[NR];
#pragma unroll
    for (int r = 0; r < NR; ++r) { const size_t row = (size_t)(m + r * mstep);
#pragma unroll
        for (int j = 0; j < 4; ++j) { const v4u w = __builtin_nontemporal_load((const v4u*)(o + row * LDH + 8 * (lane + 64 * j)));
            v[r][2 * j] = (f32x4){bflo(w.x), bfhi(w.x), bflo(w.y), bfhi(w.y)}; v[r][2 * j + 1] = (f32x4){bflo(w.z), bfhi(w.z), bflo(w.w), bfhi(w.w)}; }
#pragma unroll
        for (int j = 0; j < 8; ++j) xv[r][j] = __builtin_nontemporal_load((const f32x4*)(x + row * DM + 8 * (lane + 64 * (j >> 1)) + 4 * (j & 1))); }
#pragma unroll
    for (int r = 0; r < NR; ++r) { s[r] = 0.f;
#pragma unroll
        for (int j = 0; j < 8; ++j) s[r] += (v[r][j].x * v[r][j].x + v[r][j].y * v[r][j].y) + (v[r][j].z * v[r][j].z + v[r][j].w * v[r][j].w); }
#pragma unroll
    for (int r = 0; r < NR; ++r) { const size_t row = (size_t)(m + r * mstep); const float rstd = rsqrtf(wave_sum(s[r]) * (1.f / DM) + EPS); s1[r] = 0.f;
#pragma unroll
        for (int j = 0; j < 8; ++j) { const int e0 = 8 * (lane + 64 * (j >> 1)) + 4 * (j & 1); const f32x4 gv = *(const f32x4*)(gpost + e0);
            v[r][j] = xv[r][j] + v[r][j] * rstd * gv; s1[r] += (v[r][j].x * v[r][j].x + v[r][j].y * v[r][j].y) + (v[r][j].z * v[r][j].z + v[r][j].w * v[r][j].w); *(f32x4*)(x1 + row * DM + e0) = v[r][j]; } }
#pragma unroll
    for (int r = 0; r < NR; ++r) { const size_t row = (size_t)(m + r * mstep); const float rstd1 = rsqrtf(wave_sum(s1[r]) * (1.f / DM) + EPS);
#pragma unroll
        for (int j = 0; j < 4; ++j) { const int e0 = 8 * (lane + 64 * j); const f32x4 g0 = *(const f32x4*)(gpre + e0), g1 = *(const f32x4*)(gpre + e0 + 4);
            const f32x4 a = v[r][2 * j] * rstd1 * g0, c = v[r][2 * j + 1] * rstd1 * g1; v4u ov; ov.x = pk2(a.x, a.y); ov.y = pk2(a.z, a.w); ov.z = pk2(c.x, c.y); ov.w = pk2(c.z, c.w);
            *(v4u*)(h2 + row * LDH + e0) = ov; } }
}
template <int NR> __device__ __forceinline__ void norm2_rows(const bf16* f, const float* gpost, float* out, int m, int mstep, int lane) {
    f32x4 v[NR][8], xv[NR][8]; float s[NR];
#pragma unroll
    for (int r = 0; r < NR; ++r) { const size_t row = (size_t)(m + r * mstep);
#pragma unroll
        for (int j = 0; j < 4; ++j) { const v4u w = __builtin_nontemporal_load((const v4u*)(f + row * LDH + 8 * (lane + 64 * j)));
            v[r][2 * j] = (f32x4){bflo(w.x), bfhi(w.x), bflo(w.y), bfhi(w.y)}; v[r][2 * j + 1] = (f32x4){bflo(w.z), bfhi(w.z), bflo(w.w), bfhi(w.w)}; }
#pragma unroll
        for (int j = 0; j < 8; ++j) xv[r][j] = *(const f32x4*)(out + row * DM + 8 * (lane + 64 * (j >> 1)) + 4 * (j & 1)); }
#pragma unroll
    for (int r = 0; r < NR; ++r) { s[r] = 0.f;
#pragma unroll
        for (int j = 0; j < 8; ++j) s[r] += (v[r][j].x * v[r][j].x + v[r][j].y * v[r][j].y) + (v[r][j].z * v[r][j].z + v[r][j].w * v[r][j].w); }
#pragma unroll
    for (int r = 0; r < NR; ++r) { const size_t row = (size_t)(m + r * mstep); const float rstd = rsqrtf(wave_sum(s[r]) * (1.f / DM) + EPS);
#pragma unroll
        for (int j = 0; j < 8; ++j) { const int e0 = 8 * (lane + 64 * (j >> 1)) + 4 * (j & 1); const f32x4 gv = *(const f32x4*)(gpost + e0);
            __builtin_nontemporal_store(xv[r][j] + v[r][j] * rstd * gv, (f32x4*)(out + row * DM + e0)); } }
}

#define XB_TMO      128
#define XB_XCNT(j)  (256  + 64 * (j))
#define XB_XSUB(j)  (1280 + 64 * (j))
#define XB_XGEN(j)  (2304 + 64 * (j))
#define XB_TOP      3328
#define XB_TOPGEN   3392
#define XCD_BAR_WORDS 3456
#define XB_SPIN_CAP (1u << 18)

__device__ __forceinline__ unsigned xb_ld(unsigned* p)              { return __hip_atomic_load(p, __ATOMIC_RELAXED, __HIP_MEMORY_SCOPE_AGENT); }
__device__ __forceinline__ unsigned xb_add(unsigned* p, unsigned v) { return __hip_atomic_fetch_add(p, v, __ATOMIC_RELAXED, __HIP_MEMORY_SCOPE_AGENT); }
__device__ __forceinline__ unsigned xb_xcc_id() { return (unsigned)__builtin_amdgcn_s_getreg((3 << 11) | 20) & 0xFu; }
#define XB_SPIN(cond, bar) do { unsigned _sp = 0; while (cond) { __builtin_amdgcn_s_sleep(1); \
    if ((++_sp & 255u) == 0u) { if (xb_ld(&(bar)[XB_TMO])) break; if (_sp > XB_SPIN_CAP) { atomicAdd(&(bar)[XB_TMO], 1u); break; } } } } while (0)

struct XcdBarrier {
    unsigned* bar; unsigned x;
    volatile LAS unsigned* st;
};

__device__ __forceinline__ XcdBarrier xcd_barrier_post(unsigned* bar, volatile LAS unsigned* st) {
    XcdBarrier b; b.bar = bar; b.x = xb_xcc_id(); b.st = st;
    if (threadIdx.x == 0) (void)xb_add(&bar[XB_XCNT(b.x)], 1u);
    return b;
}
__device__ __forceinline__ void xcd_barrier_complete(unsigned* bar, unsigned x, unsigned& nloc, unsigned& nx) {
    const unsigned G = gridDim.x * gridDim.y * gridDim.z;
    unsigned sum, cnt, mine, sp = 0u;
    for (;;) {
        sum = 0u; cnt = 0u; mine = 0u;
#pragma unroll
        for (unsigned j = 0; j < 16; ++j) { const unsigned c = xb_ld(&bar[XB_XCNT(j)]); sum += c; cnt += (c > 0u) ? 1u : 0u; mine = (j == x) ? c : mine; }
        if (sum == G) break;
        __builtin_amdgcn_s_sleep(1);
        if ((++sp & 255u) == 0u) { if (xb_ld(&bar[XB_TMO])) break; if (sp > XB_SPIN_CAP) { atomicAdd(&bar[XB_TMO], 1u); break; } }
    }
    nloc = mine > 0u ? mine : 1u; nx = cnt > 0u ? cnt : 1u;
}

__device__ __forceinline__ void xcd_barrier(const XcdBarrier& b) {
    asm volatile("s_waitcnt vmcnt(0)" ::: "memory");
    __syncthreads();
    if (threadIdx.x == 0) {
        unsigned* bar = b.bar;
        __builtin_amdgcn_s_waitcnt(0);
        unsigned nloc = b.st[0], nx = b.st[1];
        if (nloc == 0u) { xcd_barrier_complete(bar, b.x, nloc, nx); b.st[0] = nloc; b.st[1] = nx; }
        const unsigned old = xb_add(&bar[XB_XSUB(b.x)], 1u);
        const unsigned gen = old / nloc;
        if (old + 1u == (gen + 1u) * nloc) {
            __builtin_amdgcn_fence(__ATOMIC_RELEASE, "agent");
            asm volatile("s_waitcnt vmcnt(0)" ::: "memory");
            const unsigned og = xb_add(&bar[XB_TOP], 1u);
            const unsigned tg = og / nx;
            if (og + 1u == (tg + 1u) * nx) xb_add(&bar[XB_TOPGEN], 1u);
            else XB_SPIN(xb_ld(&bar[XB_TOPGEN]) == tg, bar);
            __builtin_amdgcn_fence(__ATOMIC_ACQUIRE, "agent");
            xb_add(&bar[XB_XGEN(b.x)], 1u);
            asm volatile("s_waitcnt vmcnt(0)" ::: "memory");
        } else {
            XB_SPIN(xb_ld(&bar[XB_XGEN(b.x)]) == gen, bar);
            __builtin_amdgcn_fence(__ATOMIC_ACQUIRE, "agent");
            asm volatile("s_waitcnt vmcnt(0)" ::: "memory");
        }
    }
    __syncthreads();
}

#ifndef PH_SKIP
#define PH_SKIP 0
#endif
#define PH_ON(k) (((PH_SKIP) >> (k)) & 1) == 0
#ifndef PH_DUP
#define PH_DUP 0
#endif
#define PH_REP(k) for (int rep_ = 0; rep_ < 1 + (((PH_DUP) >> (k)) & 1); ++rep_)

__global__ void __launch_bounds__(NTHR, 2) mega_fwd(Args a) {
    extern __shared__ __attribute__((aligned(16))) unsigned char lds_raw[];
    cg::grid_group grid = cg::this_grid();
    LAS unsigned char* lds = (LAS unsigned char*)lds_raw;
    const int G = gridDim.x, bx = blockIdx.x, NGW = G * NWAVES;
#define PH_IDS int tid = threadIdx.x; asm volatile("" : "+v"(tid)); const int lane = tid & 63; const int wave = __builtin_amdgcn_readfirstlane(tid >> 6); const int gw = bx * NWAVES + wave; (void)lane; (void)gw; (void)wave;
    unsigned char* ws = a.ws;
    {
        for (int u = threadIdx.x; u < (LDS_BYTES - RING_BYTES) / 4; u += NTHR) ((LAS unsigned*)(lds + RING_BYTES))[u] = 0u;
        __syncthreads();
    }
    const XcdBarrier xbar = xcd_barrier_post((unsigned*)(ws + WS_BAR), (volatile LAS unsigned*)(lds + RING_BYTES + 320 + 32));
#define SEAM() xcd_barrier(xbar)
    bf16* Win_t = (bf16*)(ws + WS_WIN); bf16* Wup_t = (bf16*)(ws + WS_WUP); bf16* Wglu_t = (bf16*)(ws + WS_WGLU); bf16* Wout_t = (bf16*)(ws + WS_WOUT);
    bf16* Wffn_t = (bf16*)(ws + WS_WFFN); bf16* Wdown_t = (bf16*)(ws + WS_WDOWN);
    bf16* qkvu = (bf16*)(ws + WS_RA); bf16* ubuf = (bf16*)(ws + WS_UB); bf16* obuf = (bf16*)(ws + WS_RA); bf16* act = (bf16*)(ws + WS_RA);
    bf16* hbuf = (bf16*)(ws + WS_RH); bf16* attn = (bf16*)(ws + WS_ATTN); bf16* ybuf = (bf16*)(ws + WS_Y); bf16* h2 = (bf16*)(ws + WS_RH);
    bf16* opart = (bf16*)(ws + WS_OPART); float* lse = (float*)(ws + WS_LSE); float* Ebuf = (float*)(ws + WS_E); bf16* HB = (bf16*)(ws + WS_HB);
    bf16* msbuf = (bf16*)(ws + WS_RF); bf16* fbuf = (bf16*)(ws + WS_RF);
    bf16* gates = (bf16*)a.out;

    if (PH_ON(0)) PH_REP(0) {
        PH_IDS
        for (int i = bx * NTHR + tid; i < T; i += G * NTHR) { ((float*)(ws + WS_ROWSS))[i] = 0.f; ((float*)(ws + WS_ROWSS1))[i] = 0.f; ((float*)(ws + WS_ROWSS2))[i] = 0.f;
            if (i < 64 * 64) { ((unsigned*)(ws + WS_PCNT))[i] = 0u; ((unsigned*)(ws + WS_PCNT1))[i] = 0u; ((unsigned*)(ws + WS_PCNT2))[i] = 0u; } }
        LAS float* scr = (LAS float*)(lds + wave * 16384);
        constexpr int I_IN = (DM / 64) * (INW / 32), I_UP = (AOW / 64) * (DM / 32), I_GLU = (SSMW / 64) * (DM / 32), I_OUT = (DM / 64) * (DM / 32), I_FFN = (DM / 64) * (DFF / 32), I_DN = (DFF / 64) * (DM / 32);
        constexpr int NITEMS = I_IN;
#define P0_ITEM(t, it_) do { t = tr_make(a.w_in, DM, INW, Win_t, 0, (it_)); } while (0)
        for (int it = gw; it < NITEMS; it += 2 * NGW) {
            TrItem t0, t1; float w0[32], w1[32];
            const bool two = it + NGW < NITEMS;
            P0_ITEM(t0, it); tr_load(t0, w0, lane);
            if (two) { P0_ITEM(t1, it + NGW); tr_load(t1, w1, lane); }
            tr_finish(t0, w0, scr, lane);
            if (two) tr_finish(t1, w1, scr, lane);
        }
#undef P0_ITEM
        for (int m = gw; m < T; m += 2 * NGW) rms_row2_to_bf16(a.x + (size_t)m * DM, a.x + (size_t)(m + NGW) * DM, a.norm_mix_pre, hbuf + (size_t)m * LDH, hbuf + (size_t)(m + NGW) * LDH, lane);
    }
    grid.sync();

    if (PH_ON(1)) {
        pg8::Gemm g{hbuf, Win_t, T, INW, DM, LDH, LDH}; pg8::StaticOrder S; S.init(T, INW, G, bx, 1 + (((PH_DUP) >> 1) & 1));
        pg8::EpiIn E{qkvu, ubuf, gates};
        pg8::gemm_phase<pg8::EpiIn, pg8::StaticOrder, PG8_ALIGN, PG8_SP2>(lds, g, S, E);
        if (bx >= G / 2) {
            PH_IDS
            LAS float* scr = (LAS float*)(lds + wave * 16384);
            constexpr int I_FFN = (DM / 64) * (DFF / 32);
            constexpr int I_DN2 = (DFF / 64) * (DM / 32), I_UP2 = (AOW / 64) * (DM / 32), I_GLU2 = (SSMW / 64) * (DM / 32), I_OUT2 = (DM / 64) * (DM / 32);
            for (int it = (bx - G / 2) * NWAVES + wave; it < 2 * I_FFN + I_DN2 + I_UP2 + 2 * I_GLU2 + I_OUT2; it += (G - G / 2) * NWAVES) {
                int r = it;
                if (r < I_UP2) { p0_transpose(a.w_attn_up, AOW, DM, Wup_t, 0, r, scr, lane); continue; } r -= I_UP2;
                if (r < I_GLU2) { p0_transpose(a.w_glu_v, SSMW, DM, Wglu_t, 1, r, scr, lane); continue; } r -= I_GLU2;
                if (r < I_GLU2) { p0_transpose(a.w_glu_g, SSMW, DM, Wglu_t, 2, r, scr, lane); continue; } r -= I_GLU2;
                if (r < I_OUT2) { p0_transpose(a.w_out, DM, DM, Wout_t, 0, r, scr, lane); continue; } r -= I_OUT2;
                if (r < I_FFN) { p0_transpose(a.w_ffn_gate, DM, DFF, Wffn_t, 1, r, scr, lane, a.norm_ffn_pre); continue; } r -= I_FFN;
                if (r < I_FFN) { p0_transpose(a.w_ffn_up, DM, DFF, Wffn_t, 2, r, scr, lane, a.norm_ffn_pre); continue; } r -= I_FFN;
                p0_transpose(a.w_ffn_down, DFF, DM, Wdown_t, 0, r, scr, lane);
            }
            __syncthreads();
            if (bx >= G - NG) ssm_tables(a, bx - (G - NG), lds, tid);
        }
    }
    SEAM();

    if (PH_ON(2)) PH_REP(2) {
        PH_IDS
        LAS unsigned char* vl = lds + wave * 16384;
        PH_REP(12) for (int w = gw; w < BATCH * NH * (SEQ / 32); w += NGW) {
            const int bh = w / (SEQ / 32), tile = w % (SEQ / 32);
            attn_wave_tile(qkvu, opart, lse, bh / NH, bh % NH, tile, vl, lane);
        }
        PH_REP(13) for (int w = gw; w < NG * BATCH * (NCHUNK / 32); w += NGW) {
            const int g = w / (BATCH * (NCHUNK / 32)), r = w % (BATCH * (NCHUNK / 32));
            ssm_estate_unit(ubuf, (const bf16*)(ws + WS_WT), Ebuf, vl, g, r / (NCHUNK / 32), r % (NCHUNK / 32), lane);
        }
    }
    SEAM();

    if (PH_ON(3)) PH_REP(3) {
        PH_IDS
        for (int u = bx; u < BATCH * NG * 2; u += G) {
            const int b = u >> 7, g = (u >> 1) & 63, p = (u & 1) * 32 + (tid & 31), seg = tid >> 5;
            const float lr = ((const float*)(ws + WS_LAML))[(g * NP + p) * 2], li = ((const float*)(ws + WS_LAML))[(g * NP + p) * 2 + 1];
            const size_t base = (((size_t)(b * NG + g)) * NCHUNK + 32 * seg) * 128 + p;
            const size_t hbase = (((((size_t)(b * NG + g)) * 16 + seg) * 8 + (p >> 4)) * 32) * 16 + (p & 15);
            float er[32], ei[32];
#pragma unroll
            for (int k = 0; k < 32; ++k) { er[k] = Ebuf[base + (size_t)k * 128]; ei[k] = Ebuf[base + (size_t)k * 128 + 64]; }
            float hr = 0.f, hi_ = 0.f;
#pragma unroll
            for (int k = 0; k < 32; ++k) { const float nr = lr * hr - li * hi_ + er[k], ni = lr * hi_ + li * hr + ei[k]; hr = nr; hi_ = ni; }
            LAS float* se = (LAS float*)lds;
            se[(seg * 32 + (tid & 31)) * 2] = hr; se[(seg * 32 + (tid & 31)) * 2 + 1] = hi_;
            float pr = lr, pi = li;
#pragma unroll
            for (int q = 0; q < 5; ++q) { const float nr = pr * pr - pi * pi, ni = 2.f * pr * pi; pr = nr; pi = ni; }
            __syncthreads();
            hr = 0.f; hi_ = 0.f;
            for (int s2 = 0; s2 < seg; ++s2) { const float sr = se[(s2 * 32 + (tid & 31)) * 2], si = se[(s2 * 32 + (tid & 31)) * 2 + 1]; const float nr = pr * hr - pi * hi_ + sr, ni = pr * hi_ + pi * hr + si; hr = nr; hi_ = ni; }
#pragma unroll
            for (int k = 0; k < 32; ++k) {
                HB[hbase + k * 16] = (bf16)(pk2(hr, 0.f) & 0xffffu); HB[hbase + 4 * 512 + k * 16] = (bf16)(pk2(hi_, 0.f) & 0xffffu);
                const float nr = lr * hr - li * hi_ + er[k], ni = lr * hi_ + li * hr + ei[k]; hr = nr; hi_ = ni;
            }
            __syncthreads();
        }
        for (size_t idx = (size_t)bx * NTHR + tid; idx < (size_t)T * 64; idx += (size_t)G * NTHR) {
            const size_t tok = idx >> 6; const int j = (int)(idx >> 4) & 3, ch = (int)idx & 15;
            const float l0 = lse[tok * NH + j], l1 = lse[tok * NH + 4 + j], l2 = lse[tok * NH + 8 + j];
            const float m = fmaxf(l0, fmaxf(l1, l2));
            float w0 = __builtin_amdgcn_exp2f(l0 - m), w1 = __builtin_amdgcn_exp2f(l1 - m), w2 = __builtin_amdgcn_exp2f(l2 - m);
            const float inv = 1.0f / (w0 + w1 + w2); w0 *= inv; w1 *= inv; w2 *= inv;
            const v4u o0 = *(const v4u*)(opart + (tok * NH + j) * HD + ch * 8), o1 = *(const v4u*)(opart + (tok * NH + 4 + j) * HD + ch * 8), o2 = *(const v4u*)(opart + (tok * NH + 8 + j) * HD + ch * 8);
            v4u r;
            r.x = pk2(w0 * bflo(o0.x) + w1 * bflo(o1.x) + w2 * bflo(o2.x), w0 * bfhi(o0.x) + w1 * bfhi(o1.x) + w2 * bfhi(o2.x));
            r.y = pk2(w0 * bflo(o0.y) + w1 * bflo(o1.y) + w2 * bflo(o2.y), w0 * bfhi(o0.y) + w1 * bfhi(o1.y) + w2 * bfhi(o2.y));
            r.z = pk2(w0 * bflo(o0.z) + w1 * bflo(o1.z) + w2 * bflo(o2.z), w0 * bfhi(o0.z) + w1 * bfhi(o1.z) + w2 * bfhi(o2.z));
            r.w = pk2(w0 * bflo(o0.w) + w1 * bflo(o1.w) + w2 * bflo(o2.w), w0 * bfhi(o0.w) + w1 * bfhi(o1.w) + w2 * bfhi(o2.w));
            *(v4u*)(attn + tok * LDATT + j * HD + ch * 8) = r;
        }
    }
    SEAM();

    if (PH_ON(4)) PH_REP(4) {
        PH_IDS
        for (int bu = bx; bu < BATCH * (NCHUNK / 32) * 2 * (NG / 8); bu += G) {
            const int go = bu & 7, mg = (bu >> 3) & 1, nt = (bu >> 4) & 15, b = bu >> 8, g = go * 8 + wave;
            if (mg) ssm_out_unit<1>(ubuf, (const bf16*)(ws + WS_A3), HB, lds, wave, g, b, nt, lane);
            else ssm_out_unit<0>(ubuf, (const bf16*)(ws + WS_A3), HB, lds, wave, g, b, nt, lane);
            __syncthreads();
#pragma unroll
            for (int it = 0; it < 8; ++it) { const int id = it * NTHR + tid, row = id >> 4, ch = id & 15, n = row >> 3, il = row & 7;
                const v4u v = *(LAS v4u*)(lds + row * 256 + ((ch ^ (n & 15)) * 16));
                *(v4u*)(ybuf + (size_t)(b * SEQ + (32 * nt + n) * CL + 8 * mg + il) * LDY + go * 128 + ch * 8) = v; }
            __syncthreads();
        }
    }
    SEAM();

    if (PH_ON(5)) {
        pg8::Gemm g{ybuf, Wglu_t, T, 2 * DM, SSMW, LDY, LDY}; pg8::StaticOrder S; S.init(T, 2 * DM, G, bx, 1 + (((PH_DUP) >> 5) & 1));
        pg8::EpiGlu E{gates, msbuf};
        pg8::gemm_phase<pg8::EpiGlu, pg8::StaticOrder, PG8_ALIGN, PG8_SP2>(lds, g, S, E);
    }
    SEAM();

    if (PH_ON(6)) {
        pg8::Gemm g{attn, Wup_t, T, DM, AOW, LDATT, LDATT}; pg8::StaticOrder S; S.init(T, DM, G, bx);
        pg8::EpiMerge E{gates, msbuf};
        pg8::gemm_phase<pg8::EpiMerge, pg8::StaticOrder, PG8_ALIGN, PG8_SP2>(lds, g, S, E);
    }
    SEAM();

    if (PH_ON(7)) {
        pg8::Gemm g{msbuf, Wout_t, T, DM, DM, LDH, LDH}; pg8::PanelOrder S; S.init(G, bx);
        pg8::EpiNormMid E{a.x, (bf16*)(ws + WS_X1B), a.norm_mix_post, (float*)(ws + WS_ROWSS1), (unsigned*)(ws + WS_PCNT1), (float*)(ws + WS_ROWSS2)};
        pg8::gemm_phase<pg8::EpiNormMid, pg8::PanelOrder, PG8_ALIGN, PG8_SP2>(lds, g, S, E);
    }
    SEAM();

    if (PH_ON(9)) {
        pg8::Gemm g{(const bf16*)(ws + WS_X1B), Wffn_t, T, 2 * DFF, DM, DM, LDH}; pg8::StaticOrder S; S.init(T, 2 * DFF, G, bx, 1 + (((PH_DUP) >> 9) & 1));
        LAS float* rs = (LAS float*)(lds + RING_BYTES + 4096); const int rbase = (G == 256) ? (bx & 7) * 2048 : 0;
        for (int i = threadIdx.x; i < 2048; i += NTHR) rs[i] = rsqrtf(((const float*)(ws + WS_ROWSS2))[rbase + i] * (1.f / DM) + EPS);
        __syncthreads();
        pg8::EpiFfn E{act, (const float*)(ws + WS_ROWSS2), rs, rbase};
        pg8::gemm_phase<pg8::EpiFfn, pg8::StaticOrder, PG8_ALIGN, PG8_SP2>(lds, g, S, E);
    }
    SEAM();

    if (PH_ON(10)) {
        pg8::Gemm g{act, Wdown_t, T, DM, DFF, LDACT, LDACT}; pg8::PanelOrder S; S.init(G, bx);
        pg8::EpiNormOut E{a.out, (const bf16*)(ws + WS_X1B), a.norm_ffn_post, (float*)(ws + WS_ROWSS), (unsigned*)(ws + WS_PCNT)};
        pg8::gemm_phase<pg8::EpiNormOut, pg8::PanelOrder, PG8_ALIGN, PG8_SP2>(lds, g, S, E);
    }
}

extern "C" void kernel_launch(void* const* d_in, const int* in_sizes, int n_in, void* d_out, int out_size, void* d_ws, size_t ws_size, hipStream_t stream) {
    static int grid = 0;
    if (grid == 0) {
        if (n_in != 21 || in_sizes[0] != T * DM || out_size != T * DM || ws_size < WS_END) { fprintf(stderr, "kernel_launch: unexpected shapes (n_in %d, in0 %d, out %d, ws %zu < %zu); nothing launched\n", n_in, n_in > 0 ? in_sizes[0] : -1, out_size, ws_size, (size_t)WS_END); grid = -1; return; }
        int dev = 0, cus = 0, per_cu = 0;
        if (hipGetDevice(&dev) != hipSuccess || hipDeviceGetAttribute(&cus, hipDeviceAttributeMultiprocessorCount, dev) != hipSuccess) { grid = -1; return; }
        if (hipFuncSetAttribute((const void*)mega_fwd, hipFuncAttributeMaxDynamicSharedMemorySize, LDS_BYTES) != hipSuccess) { fprintf(stderr, "kernel_launch: hipFuncSetAttribute failed\n"); grid = -1; return; }
        if (hipOccupancyMaxActiveBlocksPerMultiprocessor(&per_cu, (const void*)mega_fwd, NTHR, LDS_BYTES) != hipSuccess || per_cu < 1) { fprintf(stderr, "kernel_launch: occupancy query reports %d blocks per CU; nothing launched\n", per_cu); (void)hipGetLastError(); grid = -1; return; }
        grid = cus;
    }
    if (grid < 0) return;
    Args a{};
    a.x = (const float*)d_in[0]; a.norm_mix_pre = (const float*)d_in[1]; a.w_in = (const float*)d_in[2]; a.w_attn_up = (const float*)d_in[3];
    a.a_re = (const float*)d_in[4]; a.a_im = (const float*)d_in[5]; a.log_dt = (const float*)d_in[6]; a.b_re = (const float*)d_in[7]; a.b_im = (const float*)d_in[8];
    a.c_re = (const float*)d_in[9]; a.c_im = (const float*)d_in[10]; a.ssm_d = (const float*)d_in[11];
    a.w_glu_v = (const float*)d_in[12]; a.w_glu_g = (const float*)d_in[13]; a.w_out = (const float*)d_in[14]; a.norm_mix_post = (const float*)d_in[15]; a.norm_ffn_pre = (const float*)d_in[16];
    a.w_ffn_gate = (const float*)d_in[17]; a.w_ffn_up = (const float*)d_in[18]; a.w_ffn_down = (const float*)d_in[19]; a.norm_ffn_post = (const float*)d_in[20];
    a.out = (float*)d_out; a.ws = (unsigned char*)d_ws;
    if (hipMemsetAsync((char*)d_ws + WS_BAR, 0, WS_BAR_BYTES, stream) != hipSuccess) { fprintf(stderr, "kernel_launch: hipMemsetAsync failed\n"); return; }
    void* args[] = {&a};
    const hipError_t e = hipLaunchCooperativeKernel((const void*)mega_fwd, dim3(grid), dim3(NTHR), args, LDS_BYTES, stream);
    if (e != hipSuccess) fprintf(stderr, "kernel_launch: cooperative launch failed: %s (grid %d)\n", hipGetErrorString(e), grid);
}
```

```cpp
#include <hip/hip_runtime.h>
#include <hip/hip_cooperative_groups.h>
#include <cstdio>
#include <cstdint>
namespace cg = cooperative_groups;
namespace pg8 {
#define PG8_LAS __attribute__((address_space(3)))
typedef unsigned short bf16_t;
typedef short bf16x8 __attribute__((ext_vector_type(8)));
typedef float f32x4 __attribute__((ext_vector_type(4)));
typedef unsigned u32x4 __attribute__((ext_vector_type(4)));
constexpr int BM = 256, BK = 64, HALF = 128, HTB = HALF * BK * 2  , STAGE_BYTES = 8 * HTB, NXCD = 8, WGM = 8;

__host__ __device__ __forceinline__ int lds_byte(int r, int c) { const int st = (r >> 4) * 2 + (c >> 5), rr = r & 15, cc = c & 31, ob = rr * 64 + cc * 2; return st * 1024 + (ob ^ (((ob >> 9) & 1) << 5)); }
__host__ __device__ __forceinline__ void stage_rc(int b, int& R, int& C) { const int st = b / 1024, sb = b % 1024, swz = sb ^ (((sb >> 9) & 1) << 5); R = (st >> 1) * 16 + swz / 64; C = (st & 1) * 32 + (swz % 64) / 2; }
__host__ __device__ __forceinline__ int perm32(int rho) { const int n = rho >> 4, i = rho & 15; return 8 * (i >> 2) + 4 * n + (i & 3); }

struct Unit { int pm, pn; };
struct Gemm { const bf16_t* A; const bf16_t* Bt; int M, N, K, lda, ldb; };

struct StaticOrder {
    int nM, nN, nwg, G, c, rep;
    __host__ __device__ void init(int M, int N, int G_, int c_, int rep_ = 1) { nM = M / BM; nN = N / BM; nwg = nM * nN; G = G_; c = c_; rep = rep_; }
    __host__ __device__ bool next(int i, Unit& u) const {
        const long L = (long)i * G + c; if (L >= (long)nwg * rep) return false;
        int wgid = (int)(L % nwg); { const int q = nwg / NXCD, r = nwg % NXCD, xcd = wgid % NXCD, off = wgid / NXCD; wgid = (xcd < r ? xcd * (q + 1) : r * (q + 1) + (xcd - r) * q) + off; }
        const int nig = WGM * nN, gid = wgid / nig, fm = gid * WGM, gsz = (nM - fm) < WGM ? (nM - fm) : WGM;
        u.pm = fm + ((wgid % nig) % gsz); u.pn = (wgid % nig) / gsz; return true;
    }
    __device__ __forceinline__ void a_ready(const Unit&) const {}
    __device__ __forceinline__ void done(const Unit&) const {}
};

__device__ __forceinline__ unsigned cvt_pk_bf16(float lo, float hi) { unsigned r; asm volatile("v_cvt_pk_bf16_f32 %0, %1, %2" : "=v"(r) : "v"(lo), "v"(hi)); return r; }
typedef float f32x2 __attribute__((ext_vector_type(2)));
template <class Epi, class Sched, bool ALIGN_EPI = false, bool SP2 = false>
__device__ __forceinline__ void gemm_phase(PG8_LAS unsigned char* lds, const Gemm g, const Sched& S, const Epi& E) {
    int tid_ = threadIdx.x; asm volatile("" : "+v"(tid_));
    const int tid = tid_, wid = __builtin_amdgcn_readfirstlane(tid >> 6), lane = tid & 63, wr = wid >> 2, wc = wid & 3, fr = lane & 15, fq = lane >> 4;
    const int K = g.K, nt = K / BK;
    unsigned voffA[2], voffB[2];
#pragma unroll
    for (int i = 0; i < 2; ++i) { int R, C; stage_rc(tid * 16 + i * 8192, R, C); const int Rb = Epi::PERM ? ((R & ~31) + perm32(R & 31)) : R;
        voffA[i] = (unsigned)(R * g.lda + C) * 2u; voffB[i] = (unsigned)(Rb * g.ldb + C) * 2u; }
    const size_t kstep = (size_t)(BK * 2);
    const size_t hstepA = (size_t)HALF * g.lda * 2, hstepB = (size_t)HALF * g.ldb * 2;
    const size_t tstepA = 2 * hstepA, tstepB = 2 * hstepB;
    const unsigned ldsw = (unsigned)wid * 1024u;
    const int aoff = lds_byte(wr * 64 + fr, fq * 8), boff = lds_byte(wc * 32 + fr, fq * 8);
#define PG8_SA(b, h) (((b) * 2 + (h)) * HTB)
#define PG8_SB(b, h) ((4 + (b) * 2 + (h)) * HTB)
#define PG8_STAGE(bufoff, gbase, voff) do { _Pragma("unroll") for (int _i = 0; _i < 2; ++_i) \
        __builtin_amdgcn_global_load_lds((const unsigned*)((const char*)(gbase) + (voff)[_i]), (PG8_LAS unsigned*)(lds + (bufoff) + ldsw + _i * 8192), 16, 0, 0); } while (0)
#define PG8_LDA(dst, b, h) do { _Pragma("unroll") for (int m = 0; m < 4; ++m) _Pragma("unroll") for (int k = 0; k < 2; ++k) dst[m][k] = *(const PG8_LAS bf16x8*)(lds + PG8_SA(b, h) + aoff + m * 2048 + k * 1024); } while (0)
#define PG8_LDB(dst, b, h) do { _Pragma("unroll") for (int n = 0; n < 2; ++n) _Pragma("unroll") for (int k = 0; k < 2; ++k) dst[n][k] = *(const PG8_LAS bf16x8*)(lds + PG8_SB(b, h) + boff + n * 2048 + k * 1024); } while (0)
#define PG8_MMA(ai, bj, At, Bt) do { __builtin_amdgcn_s_setprio(1); _Pragma("unroll") for (int m = 0; m < 4; ++m) _Pragma("unroll") for (int n = 0; n < 2; ++n) _Pragma("unroll") for (int k = 0; k < 2; ++k) \
        acc[ai][bj][m][n] = __builtin_amdgcn_mfma_f32_16x16x32_bf16(Bt[n][k], At[m][k], acc[ai][bj][m][n], 0, 0, 0); __builtin_amdgcn_s_setprio(0); } while (0)
#define PG8_WAIT_V(n) asm volatile("s_waitcnt vmcnt(" #n ")" ::: "memory")
#define PG8_WAIT_L(n) asm volatile("s_waitcnt lgkmcnt(" #n ")" ::: "memory")
#define PG8_BAR __builtin_amdgcn_s_barrier()
#define PG8_SCHED __builtin_amdgcn_sched_barrier(0)
    Unit cur, nxt; int ui = 0;
    if (!S.next(0, cur)) return;
    f32x4 acc[2][2][4][2];
#pragma unroll
    for (int a = 0; a < 2; ++a)
#pragma unroll
        for (int b = 0; b < 2; ++b)
#pragma unroll
            for (int m = 0; m < 4; ++m)
#pragma unroll
                for (int n = 0; n < 2; ++n) acc[a][b][m][n] = (f32x4){0.f, 0.f, 0.f, 0.f};
    bf16x8 At[4][2], B0[2][2], B1[2][2];
    const char* cA = (const char*)g.A + (size_t)cur.pm * tstepA; const char* cB = (const char*)g.Bt + (size_t)cur.pn * tstepB;
    S.a_ready(cur);
    if constexpr (SP2) {
        PG8_STAGE(PG8_SB(0, 0), cB, voffB); PG8_STAGE(PG8_SB(0, 1), cB + hstepB, voffB); PG8_STAGE(PG8_SA(0, 0), cA, voffA); PG8_STAGE(PG8_SA(0, 1), cA + hstepA, voffA);
        if (wr == 1) PG8_BAR;
        PG8_WAIT_V(2); PG8_BAR;
        PG8_STAGE(PG8_SB(1, 0), cB + kstep, voffB); PG8_STAGE(PG8_SA(1, 0), cA + kstep, voffA); PG8_STAGE(PG8_SB(1, 1), cB + hstepB + kstep, voffB);
        PG8_WAIT_V(6); PG8_BAR;
    } else {
        PG8_STAGE(PG8_SB(0, 0), cB, voffB); PG8_STAGE(PG8_SA(0, 0), cA, voffA); PG8_STAGE(PG8_SB(0, 1), cB + hstepB, voffB); PG8_STAGE(PG8_SA(0, 1), cA + hstepA, voffA);
        if (wr == 1) PG8_BAR;
        PG8_WAIT_V(4); PG8_BAR;
        PG8_STAGE(PG8_SB(1, 0), cB + kstep, voffB); PG8_STAGE(PG8_SA(1, 0), cA + kstep, voffA); PG8_STAGE(PG8_SB(1, 1), cB + hstepB + kstep, voffB);
        PG8_WAIT_V(6); PG8_BAR;
    }
    for (;;) {
        const bool has_next = S.next(ui + 1, nxt);
        const char* nA = has_next ? (const char*)g.A + (size_t)nxt.pm * tstepA : cA; const char* nB = has_next ? (const char*)g.Bt + (size_t)nxt.pn * tstepB : cB;
        for (int t = 0; t < nt; t += 2) {
            const bool last = (t == nt - 2);
            const char* a1 = cA + (size_t)(t + 1) * kstep;
            const char* a2 = last ? nA : cA + (size_t)(t + 2) * kstep; const char* b2 = last ? nB : cB + (size_t)(t + 2) * kstep;
            const char* a3 = a2 + kstep; const char* b3 = b2 + kstep;
            if (last && has_next) S.a_ready(nxt);
            if constexpr (SP2) {
            PG8_LDB(B0, 0, 0); PG8_LDB(B1, 0, 1); PG8_SCHED; PG8_LDA(At, 0, 0); PG8_STAGE(PG8_SA(1, 1), a1 + hstepA, voffA);
            PG8_WAIT_V(8); PG8_WAIT_L(0); PG8_BAR; PG8_MMA(0, 0, At, B0); PG8_MMA(0, 1, At, B1); PG8_BAR; PG8_SCHED;
            PG8_LDA(At, 0, 1); PG8_STAGE(PG8_SB(0, 0), b2, voffB); PG8_STAGE(PG8_SB(0, 1), b2 + hstepB, voffB); PG8_STAGE(PG8_SA(0, 0), a2, voffA);
            PG8_WAIT_V(8); PG8_WAIT_L(0); PG8_BAR; PG8_MMA(1, 0, At, B0); PG8_MMA(1, 1, At, B1); PG8_BAR; PG8_SCHED;
            PG8_LDB(B0, 1, 0); PG8_LDB(B1, 1, 1); PG8_SCHED; PG8_LDA(At, 1, 0); PG8_STAGE(PG8_SA(0, 1), a2 + hstepA, voffA);
            PG8_WAIT_V(8); PG8_WAIT_L(0); PG8_BAR; PG8_MMA(0, 0, At, B0); PG8_MMA(0, 1, At, B1); PG8_BAR; PG8_SCHED;
            PG8_LDA(At, 1, 1); PG8_STAGE(PG8_SB(1, 0), b3, voffB); PG8_STAGE(PG8_SB(1, 1), b3 + hstepB, voffB); PG8_STAGE(PG8_SA(1, 0), a3, voffA);
            PG8_WAIT_V(8); PG8_WAIT_L(0); PG8_BAR; PG8_MMA(1, 0, At, B0); PG8_MMA(1, 1, At, B1); PG8_BAR; PG8_SCHED;
            } else {
            PG8_LDB(B0, 0, 0); PG8_SCHED; PG8_LDA(At, 0, 0); PG8_STAGE(PG8_SA(1, 1), a1 + hstepA, voffA);
            PG8_WAIT_L(8); PG8_BAR; PG8_WAIT_L(0); PG8_MMA(0, 0, At, B0); PG8_BAR; PG8_SCHED;
            PG8_LDB(B1, 0, 1); PG8_STAGE(PG8_SB(0, 0), b2, voffB);
            PG8_BAR; PG8_WAIT_L(0); PG8_MMA(0, 1, At, B1); PG8_BAR;
            PG8_LDA(At, 0, 1); PG8_STAGE(PG8_SA(0, 0), a2, voffA);
            PG8_BAR; PG8_WAIT_L(0); PG8_MMA(1, 0, At, B0); PG8_BAR; PG8_SCHED;
            PG8_STAGE(PG8_SB(0, 1), b2 + hstepB, voffB);
            PG8_WAIT_V(6); PG8_BAR; PG8_MMA(1, 1, At, B1); PG8_BAR;
            PG8_LDB(B0, 1, 0); PG8_SCHED; PG8_LDA(At, 1, 0); PG8_STAGE(PG8_SA(0, 1), a2 + hstepA, voffA);
            PG8_WAIT_L(8); PG8_BAR; PG8_WAIT_L(0); PG8_MMA(0, 0, At, B0); PG8_BAR; PG8_SCHED;
            PG8_LDB(B1, 1, 1); PG8_STAGE(PG8_SB(1, 0), b3, voffB);
            PG8_BAR; PG8_WAIT_L(0); PG8_MMA(0, 1, At, B1); PG8_BAR;
            PG8_LDA(At, 1, 1); PG8_STAGE(PG8_SA(1, 0), a3, voffA);
            PG8_BAR; PG8_WAIT_L(0); PG8_MMA(1, 0, At, B0); PG8_BAR; PG8_SCHED;
            PG8_STAGE(PG8_SB(1, 1), b3 + hstepB, voffB);
            PG8_WAIT_V(6); PG8_BAR; PG8_MMA(1, 1, At, B1); PG8_BAR;
            }
        }
        if constexpr (ALIGN_EPI) { if (wr == 0) PG8_BAR; }
        if constexpr (!Epi::AFTER_DRAIN) { E(acc, cur, wr, wc, fr, fq); S.done(cur); }
        if (!has_next) break;
#pragma unroll
        for (int a = 0; a < 2; ++a)
#pragma unroll
            for (int b = 0; b < 2; ++b)
#pragma unroll
                for (int m = 0; m < 4; ++m)
#pragma unroll
                    for (int n = 0; n < 2; ++n) acc[a][b][m][n] = (f32x4){0.f, 0.f, 0.f, 0.f};
        cur = nxt; cA = nA; cB = nB; ++ui;
        if constexpr (ALIGN_EPI) { if (wr == 1) PG8_BAR; }
    }
    PG8_WAIT_V(0);
    if constexpr (!ALIGN_EPI) { if (wr == 0) PG8_BAR; }
    PG8_BAR;
    if constexpr (Epi::AFTER_DRAIN) { E.fused(acc, cur, wr, wc, fr, fq, lds, wid, lane); S.done(cur); }
#undef PG8_SA
#undef PG8_SB
#undef PG8_STAGE
#undef PG8_LDA
#undef PG8_LDB
#undef PG8_MMA
#undef PG8_WAIT_V
#undef PG8_WAIT_L
#undef PG8_BAR
#undef PG8_SCHED
}
}
#ifndef PG8_SP2
#define PG8_SP2 true
#endif
#ifndef PG8_ALIGN
#define PG8_ALIGN true
#endif

constexpr int BATCH = 2, SEQ = 8192, DM = 2048, T = BATCH * SEQ;
constexpr int HD = 128, NH = 12, HQ = 1536, SSMW = 1024, NG = 64, NP = 64, NC = 16;
constexpr int DFF = 5632, INW = 9728, QKVU = 5632, NGATE = INW - QKVU, AOW = 512;
constexpr int CL = 16, NCHUNK = SEQ / CL;
constexpr int A3W = CL * NC + 2 * NP;
constexpr float EPS = 1e-6f, LOG2E = 1.4426950408889634f;
constexpr int NWAVES = 8, NTHR = 512;
constexpr int PADE = 64;
constexpr int LDH = DM + PADE, LDQ = 3 * HQ + PADE, LDACT = DFF + PADE, LDATT = AOW + PADE, LDY = SSMW + PADE;

constexpr size_t WS_ROWSS1 = 196608, WS_ROWSS2 = 262144, WS_PCNT1 = 327680, WS_PCNT2 = 344064;
constexpr size_t WS_ROWSS = 65536, WS_PCNT = 131072;
constexpr size_t WS_BAR = 4096, WS_BAR_BYTES = 16384;
constexpr size_t WS_WFFN = 1u << 20;
constexpr size_t WS_WDOWN = WS_WFFN + (size_t)2 * DFF * LDH * 2;
constexpr size_t WS_WOUT = WS_WDOWN + (size_t)DM * LDACT * 2;
constexpr size_t WS_WIN = WS_WOUT + (size_t)DM * LDH * 2;
constexpr size_t WS_WUP = WS_WIN + (size_t)INW * LDH * 2;
constexpr size_t WS_WGLU = WS_WUP + (size_t)DM * LDATT * 2;
constexpr size_t WS_A3 = WS_WGLU + (size_t)2 * DM * LDY * 2;
constexpr size_t WS_WT = WS_A3 + (size_t)NG * 256 * A3W * 2;
constexpr size_t WS_LAML = WS_WT + (size_t)NG * 128 * 256 * 2;
constexpr size_t WS_X1B = WS_WIN;
static_assert(WS_X1B + (size_t)T * DM * 2 <= WS_LAML, "x1 overlay fits in the dead weight/table region");
constexpr size_t WS_RA = WS_LAML + 65536;
constexpr size_t WS_UB = WS_RA + (size_t)T * LDQ * 2;
constexpr size_t WS_RH = WS_RA + (size_t)T * LDACT * 2;
static_assert(WS_UB + (size_t)T * SSMW * 2 <= WS_RH, "u buffer fits behind qkv");
constexpr size_t WS_ATTN = WS_RH, WS_Y = WS_RH + (size_t)T * LDATT * 2;
static_assert(WS_Y + (size_t)T * LDY * 2 <= WS_RH + (size_t)T * LDH * 2, "attn + y fit in the h region");
constexpr size_t WS_RF = WS_RH + (size_t)T * LDH * 2;
constexpr size_t WS_OPART = WS_RF, WS_LSE = WS_OPART + (size_t)T * NH * HD * 2, WS_E = WS_LSE + (size_t)T * NH * 4;
constexpr size_t WS_HB = WS_E + (size_t)BATCH * NCHUNK * NG * 128 * 4, WS_END = WS_HB + (size_t)BATCH * NCHUNK * NG * 128 * 2;
static_assert(WS_END <= 536870912ull, "d_ws map exceeds 512 MiB");
static_assert(WS_RF + (size_t)T * LDH * 2 <= WS_END, "ms/f fit in the partials region");

constexpr int RING_BYTES = 131072, LDS_BYTES = 147456;

#define GAS __attribute__((address_space(1)))
#define LAS __attribute__((address_space(3)))
typedef unsigned short bf16;
typedef unsigned v4u __attribute__((ext_vector_type(4)));
typedef unsigned v2u __attribute__((ext_vector_type(2)));
typedef float f32x4 __attribute__((ext_vector_type(4)));
typedef float f32x16 __attribute__((ext_vector_type(16)));
typedef short bf16x8 __attribute__((ext_vector_type(8)));
typedef short v4i16_t __attribute__((ext_vector_type(4)));
typedef float f32x2_t __attribute__((ext_vector_type(2)));
typedef __bf16 bf16x2_t __attribute__((ext_vector_type(2)));

__device__ __forceinline__ unsigned pk2(float lo, float hi) { f32x2_t v = {lo, hi}; bf16x2_t b = __builtin_convertvector(v, bf16x2_t); return __builtin_bit_cast(unsigned, b); }
__device__ __forceinline__ float bflo(unsigned w) { return __uint_as_float(w << 16); }
__device__ __forceinline__ float bfhi(unsigned w) { return __uint_as_float(w & 0xffff0000u); }
__device__ __forceinline__ float sigmoidf_(float x) { return __builtin_amdgcn_rcpf(1.0f + __expf(-x)); }
__device__ __forceinline__ float gelu_tanh(float x) { const float z = 0.7978845608028654f * (x + 0.044715f * x * x * x); const float e = __expf(2.0f * z); return 0.5f * x * (2.0f - 2.0f * __builtin_amdgcn_rcpf(1.0f + e)); }
__device__ __forceinline__ float wave_sum(float v) {
#pragma unroll
    for (int o = 1; o < 64; o <<= 1) v += __shfl_xor(v, o);
    return v;
}
__device__ __forceinline__ int crow(int reg, int h) { return (reg & 3) + 8 * (reg >> 2) + 4 * h; }
#define MFMA32(a, b, c) __builtin_amdgcn_mfma_f32_32x32x16_bf16((a), (b), (c), 0, 0, 0)

namespace pg8 {
__device__ __forceinline__ u32x4 pack8(const f32x4 v0, const f32x4 v1) { u32x4 w; w.x = pk2(v0[0], v0[1]); w.y = pk2(v0[2], v0[3]); w.z = pk2(v1[0], v1[1]); w.w = pk2(v1[2], v1[3]); return w; }
__device__ __forceinline__ void unpack8(const u32x4 w, f32x4& v0, f32x4& v1) { v0 = (f32x4){bflo(w.x), bfhi(w.x), bflo(w.y), bfhi(w.y)}; v1 = (f32x4){bflo(w.z), bfhi(w.z), bflo(w.w), bfhi(w.w)}; }
__device__ __forceinline__ size_t gaddr(size_t row, int col) { return ((row >> 4) * (size_t)(NGATE / 8) + (size_t)(col >> 3)) * 128 + (row & 15) * 8; }
__device__ __forceinline__ size_t gaddr8(size_t row, int pnt, int wc, int fq) { return ((((row >> 4) * 16 + (size_t)pnt) * 16 + (size_t)(wc * 4 + fq)) * 256) + (row & 15) * 16; }
__device__ __forceinline__ unsigned q8(float g) { return (unsigned)(g * 255.0f + 0.5f); }
__device__ __forceinline__ unsigned q8x4(const f32x4 g) { return q8(g[0]) | (q8(g[1]) << 8) | (q8(g[2]) << 16) | (q8(g[3]) << 24); }
__device__ __forceinline__ f32x4 dq8x4(unsigned w) { return (f32x4){(float)(w & 0xffu), (float)((w >> 8) & 0xffu), (float)((w >> 16) & 0xffu), (float)(w >> 24)} * (1.0f / 255.0f); }
__device__ __forceinline__ f32x4 sig4(const f32x4 v) { return (f32x4){sigmoidf_(v[0]), sigmoidf_(v[1]), sigmoidf_(v[2]), sigmoidf_(v[3])}; }

struct EpiPlain {
    static constexpr bool PERM = true, AFTER_DRAIN = false;
    bf16_t* O; int ldc;
    __device__ __forceinline__ void operator()(const f32x4 (&acc)[2][2][4][2], const Unit& u, int wr, int wc, int fr, int fq) const {
        const int row0 = u.pm * BM + wr * 64 + fr, col0 = u.pn * BM + wc * 32 + 8 * fq;
#pragma unroll
        for (int ai = 0; ai < 2; ++ai)
#pragma unroll
            for (int m = 0; m < 4; ++m) { bf16_t* rowp = O + (size_t)(row0 + ai * HALF + m * 16) * ldc + col0;
#pragma unroll
                for (int bj = 0; bj < 2; ++bj) __builtin_nontemporal_store(pack8(acc[ai][bj][m][0], acc[ai][bj][m][1]), (u32x4*)(rowp + bj * HALF)); }
    }
};
struct EpiIn {
    static constexpr bool PERM = true, AFTER_DRAIN = false;
    bf16_t* qkv; bf16_t* ubuf; bf16_t* gates;
    __device__ __forceinline__ void operator()(const f32x4 (&acc)[2][2][4][2], const Unit& u, int wr, int wc, int fr, int fq) const {
        const int row0 = u.pm * BM + wr * 64 + fr; const int colt = u.pn * BM;
        if (colt < 3 * HQ) {
            const int col0 = colt + wc * 32 + 8 * fq;
#pragma unroll
            for (int ai = 0; ai < 2; ++ai)
#pragma unroll
                for (int m = 0; m < 4; ++m) { bf16_t* rowp = qkv + (size_t)(row0 + ai * HALF + m * 16) * LDQ + col0;
#pragma unroll
                    for (int bj = 0; bj < 2; ++bj) __builtin_nontemporal_store(pack8(acc[ai][bj][m][0], acc[ai][bj][m][1]), (u32x4*)(rowp + bj * HALF)); }
        } else if (colt < QKVU) {
            const int uc0 = colt - 3 * HQ + wc * 32 + 8 * fq;
#pragma unroll
            for (int ai = 0; ai < 2; ++ai)
#pragma unroll
                for (int m = 0; m < 4; ++m) { const int row = row0 + ai * HALF + m * 16, b = row / SEQ, t = row % SEQ;
#pragma unroll
                    for (int bj = 0; bj < 2; ++bj) { const int uc = uc0 + bj * HALF;
                        __builtin_nontemporal_store(pack8(acc[ai][bj][m][0], acc[ai][bj][m][1]), (u32x4*)(ubuf + (((((size_t)(b * NG + (uc >> 4))) * 16 + (t >> 9)) * 16 + (t & 15)) * 32 + ((t >> 4) & 31)) * NC + (uc & 15))); } }
        } else {
            const int pnt = (colt - QKVU) / BM;
#pragma unroll
            for (int ai = 0; ai < 2; ++ai)
#pragma unroll
                for (int m = 0; m < 4; ++m) { const size_t row = (size_t)(row0 + ai * HALF + m * 16);
                    u32x4 w; w.x = q8x4(sig4(acc[ai][0][m][0])); w.y = q8x4(sig4(acc[ai][0][m][1])); w.z = q8x4(sig4(acc[ai][1][m][0])); w.w = q8x4(sig4(acc[ai][1][m][1]));
                    __builtin_nontemporal_store(w, (u32x4*)((unsigned char*)gates + gaddr8(row, pnt, wc, fq))); }
        }
    }
};
struct EpiGlu {
    static constexpr bool PERM = true, AFTER_DRAIN = false;
    const bf16_t* gates; bf16_t* ms;
    __device__ __forceinline__ void operator()(const f32x4 (&acc)[2][2][4][2], const Unit& u, int wr, int wc, int fr, int fq) const {
        const int row0 = u.pm * BM + wr * 64 + fr, col0 = u.pn * HALF + wc * 32 + 8 * fq;
#pragma unroll
        for (int ai = 0; ai < 2; ++ai)
#pragma unroll
            for (int m = 0; m < 4; ++m) { const size_t row = (size_t)(row0 + ai * HALF + m * 16);
                const f32x4 v0 = acc[ai][0][m][0] * sig4(acc[ai][1][m][0]), v1 = acc[ai][0][m][1] * sig4(acc[ai][1][m][1]);
                __builtin_nontemporal_store(pack8(v0, v1), (u32x4*)(ms + row * LDH + col0)); }
    }
};
struct EpiMerge {
    static constexpr bool PERM = true, AFTER_DRAIN = false, REMAP = false;
    const bf16_t* gates; bf16_t* ms;
    __device__ __forceinline__ void operator()(const f32x4 (&acc)[2][2][4][2], const Unit& u, int wr, int wc, int fr, int fq) const {
        const int row0 = u.pm * BM + wr * 64 + fr, col0 = u.pn * BM + wc * 32 + 8 * fq;
#pragma unroll
        for (int ai = 0; ai < 2; ++ai)
#pragma unroll
            for (int m = 0; m < 4; ++m) { const size_t row = (size_t)(row0 + ai * HALF + m * 16);
                const u32x4 ga = *(const u32x4*)((const unsigned char*)gates + gaddr8(row, u.pn, wc, fq)), gs = *(const u32x4*)((const unsigned char*)gates + gaddr8(row, 8 + u.pn, wc, fq));
#pragma unroll
                for (int bj = 0; bj < 2; ++bj) { const int col = col0 + bj * HALF;
                    const f32x4 g0 = dq8x4(bj ? ga.z : ga.x), g1 = dq8x4(bj ? ga.w : ga.y), h0 = dq8x4(bj ? gs.z : gs.x), h1 = dq8x4(bj ? gs.w : gs.y);
                    f32x4 s0, s1; unpack8(*(const u32x4*)(ms + row * LDH + col), s0, s1);
                    __builtin_nontemporal_store(pack8(g0 * acc[ai][bj][m][0] + h0 * s0, g1 * acc[ai][bj][m][1] + h1 * s1), (u32x4*)(ms + row * LDH + col)); } }
    }
};
struct EpiFfn {
    static constexpr bool PERM = true, AFTER_DRAIN = false, REMAP = false;
    bf16_t* act; const float* rowss; const PG8_LAS float* rs; int rbase;
    __device__ __forceinline__ void operator()(const f32x4 (&acc)[2][2][4][2], const Unit& u, int wr, int wc, int fr, int fq) const {
        const int row0 = u.pm * BM + wr * 64 + fr, col0 = u.pn * HALF + wc * 32 + 8 * fq;
#pragma unroll
        for (int ai = 0; ai < 2; ++ai)
#pragma unroll
            for (int m = 0; m < 4; ++m) { const size_t row = (size_t)(row0 + ai * HALF + m * 16);
                const int ri = (int)row - rbase; const float r = ((unsigned)ri < 2048u) ? rs[ri] : rsqrtf(rowss[row] * (1.f / DM) + EPS);
                const f32x4 a0 = acc[ai][0][m][0] * r, a1 = acc[ai][0][m][1] * r;
                __builtin_nontemporal_store(pack8(a0 * sig4(a0) * (acc[ai][1][m][0] * r), a1 * sig4(a1) * (acc[ai][1][m][1] * r)), (u32x4*)(act + row * LDACT + col0)); }
    }
};
struct PanelOrder {
    int G, vcu;
    __device__ void init(int G_, int bx) { G = G_; vcu = (G_ % 8 == 0) ? (bx % 8) * (G_ / 8) + bx / 8 : bx; }
    __device__ bool next(int i, Unit& u) const { const int L = i * G + vcu; if (L >= (T / BM) * (DM / BM)) return false; u.pm = L >> 3; u.pn = L & 7; return true; }
    __device__ __forceinline__ void a_ready(const Unit&) const {}
    __device__ __forceinline__ void done(const Unit&) const {}
};
struct EpiNormOut {
    static constexpr bool PERM = true, AFTER_DRAIN = false, REMAP = false;
    float* out; const bf16_t* x1b; const float* gain; float* rowss; unsigned* pcnt;
    __device__ __forceinline__ void operator()(const f32x4 (&acc)[2][2][4][2], const Unit& u, int wr, int wc, int fr, int fq) const {
        const int row0 = u.pm * BM + wr * 64 + fr;
#pragma unroll
        for (int ai = 0; ai < 2; ++ai)
#pragma unroll
            for (int m = 0; m < 4; ++m) { float q = 0.f;
#pragma unroll
                for (int bj = 0; bj < 2; ++bj)
#pragma unroll
                    for (int n = 0; n < 2; ++n) { const f32x4 v = acc[ai][bj][m][n]; q += (v[0] * v[0] + v[1] * v[1]) + (v[2] * v[2] + v[3] * v[3]); }
                q += __shfl_xor(q, 16); q += __shfl_xor(q, 32);
                if (fq == 0) { const float old = __hip_atomic_fetch_add(rowss + row0 + ai * HALF + m * 16, q, __ATOMIC_RELAXED, __HIP_MEMORY_SCOPE_AGENT); asm volatile("" :: "v"(old)); } }
        asm volatile("s_waitcnt vmcnt(0)" ::: "memory");
        unsigned* cw = pcnt + 64 * u.pm;
        if ((threadIdx.x & 63) == 0) (void)__hip_atomic_fetch_add(cw, 1u, __ATOMIC_RELAXED, __HIP_MEMORY_SCOPE_AGENT);
        { unsigned sp = 0; while ((unsigned)__builtin_amdgcn_readfirstlane(__hip_atomic_load(cw, __ATOMIC_RELAXED, __HIP_MEMORY_SCOPE_AGENT)) < 64u) { __builtin_amdgcn_s_sleep(2); if (++sp > (1u << 20)) break; } }
        asm volatile("" ::: "memory");
        const int col0 = u.pn * BM + wc * 32 + 8 * fq;
#pragma unroll
        for (int ai = 0; ai < 2; ++ai)
#pragma unroll
            for (int m = 0; m < 4; ++m) { const int row = row0 + ai * HALF + m * 16;
                const float rstd = rsqrtf(__hip_atomic_load(rowss + row, __ATOMIC_RELAXED, __HIP_MEMORY_SCOPE_AGENT) * (1.f / DM) + EPS);
#pragma unroll
                for (int bj = 0; bj < 2; ++bj) { float* op = out + (size_t)row * DM + col0 + bj * HALF; const float* gp = gain + col0 + bj * HALF;
                    f32x4 x0, x1; unpack8(*(const u32x4*)(x1b + (size_t)row * DM + col0 + bj * HALF), x0, x1); const f32x4 g0 = *(const f32x4*)gp, g1 = *(const f32x4*)(gp + 4);
                    __builtin_nontemporal_store(x0 + acc[ai][bj][m][0] * rstd * g0, (f32x4*)op); __builtin_nontemporal_store(x1 + acc[ai][bj][m][1] * rstd * g1, (f32x4*)(op + 4)); } }
    }
};
struct EpiNormMid {
    static constexpr bool PERM = true, AFTER_DRAIN = false, REMAP = false;
    const float* x; bf16_t* x1o; const float* gpost; float* rowss1; unsigned* pcnt1; float* rowss2;
    __device__ __forceinline__ static void arrive_wait(unsigned* cw) {
        asm volatile("s_waitcnt vmcnt(0)" ::: "memory");
        if ((threadIdx.x & 63) == 0) (void)__hip_atomic_fetch_add(cw, 1u, __ATOMIC_RELAXED, __HIP_MEMORY_SCOPE_AGENT);
        unsigned sp = 0; while ((unsigned)__builtin_amdgcn_readfirstlane(__hip_atomic_load(cw, __ATOMIC_RELAXED, __HIP_MEMORY_SCOPE_AGENT)) < 64u) { __builtin_amdgcn_s_sleep(2); if (++sp > (1u << 20)) break; }
        asm volatile("" ::: "memory");
    }
    __device__ __forceinline__ void operator()(const f32x4 (&acc_)[2][2][4][2], const Unit& u, int wr, int wc, int fr, int fq) const {
        f32x4 (&acc)[2][2][4][2] = const_cast<f32x4 (&)[2][2][4][2]>(acc_);
        const int row0 = u.pm * BM + wr * 64 + fr, col0 = u.pn * BM + wc * 32 + 8 * fq;
#pragma unroll
        for (int ai = 0; ai < 2; ++ai)
#pragma unroll
            for (int m = 0; m < 4; ++m) { float q = 0.f;
#pragma unroll
                for (int bj = 0; bj < 2; ++bj)
#pragma unroll
                    for (int n = 0; n < 2; ++n) { const f32x4 v = acc[ai][bj][m][n]; q += (v[0] * v[0] + v[1] * v[1]) + (v[2] * v[2] + v[3] * v[3]); }
                q += __shfl_xor(q, 16); q += __shfl_xor(q, 32);
                if (fq == 0) { const float old = __hip_atomic_fetch_add(rowss1 + row0 + ai * HALF + m * 16, q, __ATOMIC_RELAXED, __HIP_MEMORY_SCOPE_AGENT); asm volatile("" :: "v"(old)); } }
        arrive_wait(pcnt1 + 64 * u.pm);
#pragma unroll
        for (int ai = 0; ai < 2; ++ai)
#pragma unroll
            for (int m = 0; m < 4; ++m) { const int row = row0 + ai * HALF + m * 16; float q = 0.f;
                const float rstd = rsqrtf(__hip_atomic_load(rowss1 + row, __ATOMIC_RELAXED, __HIP_MEMORY_SCOPE_AGENT) * (1.f / DM) + EPS);
#pragma unroll
                for (int bj = 0; bj < 2; ++bj) { const size_t off = (size_t)row * DM + col0 + bj * HALF; const float* gp = gpost + col0 + bj * HALF;
                    const f32x4 x0 = __builtin_nontemporal_load((const f32x4*)(x + off)), x1 = __builtin_nontemporal_load((const f32x4*)(x + off + 4)), g0 = *(const f32x4*)gp, g1 = *(const f32x4*)(gp + 4);
                    const f32x4 v0 = x0 + acc[ai][bj][m][0] * rstd * g0, v1 = x1 + acc[ai][bj][m][1] * rstd * g1;
                    acc[ai][bj][m][0] = v0; acc[ai][bj][m][1] = v1;
                    *(u32x4*)(x1o + off) = pack8(v0, v1);
                    q += (v0[0] * v0[0] + v0[1] * v0[1]) + (v0[2] * v0[2] + v0[3] * v0[3]) + (v1[0] * v1[0] + v1[1] * v1[1]) + (v1[2] * v1[2] + v1[3] * v1[3]); }
                q += __shfl_xor(q, 16); q += __shfl_xor(q, 32);
                if (fq == 0) { const float old = __hip_atomic_fetch_add(rowss2 + row, q, __ATOMIC_RELAXED, __HIP_MEMORY_SCOPE_AGENT); asm volatile("" :: "v"(old)); } }
    }
};
}

struct Args {
    const float* x; const float* norm_mix_pre; const float* w_in; const float* w_attn_up;
    const float* a_re; const float* a_im; const float* log_dt; const float* b_re; const float* b_im; const float* c_re; const float* c_im; const float* ssm_d;
    const float* w_glu_v; const float* w_glu_g; const float* w_out; const float* norm_mix_post; const float* norm_ffn_pre;
    const float* w_ffn_gate; const float* w_ffn_up; const float* w_ffn_down; const float* norm_ffn_post;
    float* out; unsigned char* ws;
};

struct TrItem { const float* W; bf16* WT; const float* kg; int K, N, k0, n0, drow0; };
__device__ __forceinline__ void tr_load(const TrItem& t, float (&wv)[32], int lane) {
#pragma unroll
    for (int i = 0; i < 32; ++i) { const int kk = 2 * i + (lane >> 5); wv[i] = __builtin_nontemporal_load(t.W + (size_t)(t.k0 + kk) * t.N + t.n0 + (lane & 31)); }
    if (t.kg) {
#pragma unroll
        for (int i = 0; i < 32; ++i) wv[i] *= t.kg[t.k0 + 2 * i + (lane >> 5)]; }
}
__device__ __forceinline__ void tr_finish(const TrItem& t, const float (&wv)[32], LAS float* scr, int lane) {
    const int ldb = t.K + PADE;
#pragma unroll
    for (int i = 0; i < 32; ++i) { const int kk = 2 * i + (lane >> 5); scr[kk * 33 + (lane & 31)] = wv[i]; }
    asm volatile("s_waitcnt lgkmcnt(0)" ::: "memory");
    const int c = lane & 7;
#pragma unroll
    for (int j = 0; j < 4; ++j) { const int n = (lane >> 3) + 8 * j; const LAS float* s = scr + (8 * c) * 33 + n;
        v4u o; o.x = pk2(s[0 * 33], s[1 * 33]); o.y = pk2(s[2 * 33], s[3 * 33]); o.z = pk2(s[4 * 33], s[5 * 33]); o.w = pk2(s[6 * 33], s[7 * 33]);
        *(v4u*)(t.WT + (size_t)(t.drow0 + n) * ldb + t.k0 + 8 * c) = o; }
    asm volatile("s_waitcnt lgkmcnt(0)" ::: "memory");
}
__device__ __forceinline__ TrItem tr_make(const float* W, int K, int N, bf16* WT, int mode, int item, const float* kg = nullptr) {
    const int nblk = N / 32, kb = item / nblk, nb = item % nblk, n0 = 32 * nb;
    TrItem t; t.W = W; t.WT = WT; t.kg = kg; t.K = K; t.N = N; t.k0 = 64 * kb; t.n0 = n0; t.drow0 = (mode == 0) ? n0 : ((n0 >> 7) * 256 + (mode - 1) * 128 + (n0 & 127));
    return t;
}
__device__ __forceinline__ void p0_transpose(const float* W, int K, int N, bf16* WT, int mode, int item, LAS float* scr, int lane, const float* kg = nullptr) {
    const TrItem t = tr_make(W, K, N, WT, mode, item, kg); float wv[32]; tr_load(t, wv, lane); tr_finish(t, wv, scr, lane);
}
__device__ __forceinline__ void rms_row_to_bf16(const float* xrow, const float* gain, bf16* orow, int lane) {
    f32x4 v[8]; float s = 0.f;
#pragma unroll
    for (int j = 0; j < 8; ++j) { v[j] = *(const f32x4*)(xrow + 4 * (lane + 64 * j)); s += (v[j].x * v[j].x + v[j].y * v[j].y) + (v[j].z * v[j].z + v[j].w * v[j].w); }
    const float rstd = rsqrtf(wave_sum(s) * (1.f / DM) + EPS);
#pragma unroll
    for (int j = 0; j < 8; ++j) { const f32x4 g = *(const f32x4*)(gain + 4 * (lane + 64 * j)); v2u o; o.x = pk2(v[j].x * rstd * g.x, v[j].y * rstd * g.y); o.y = pk2(v[j].z * rstd * g.z, v[j].w * rstd * g.w);
        *(v2u*)(orow + 4 * (lane + 64 * j)) = o; }
}

__device__ __forceinline__ void rms_row2_to_bf16(const float* x0, const float* x1, const float* gain, bf16* o0, bf16* o1, int lane) {
    f32x4 v[8], w[8]; float s = 0.f, q = 0.f;
#pragma unroll
    for (int j = 0; j < 8; ++j) { v[j] = __builtin_nontemporal_load((const f32x4*)(x0 + 4 * (lane + 64 * j))); w[j] = __builtin_nontemporal_load((const f32x4*)(x1 + 4 * (lane + 64 * j))); }
#pragma unroll
    for (int j = 0; j < 8; ++j) { s += (v[j].x * v[j].x + v[j].y * v[j].y) + (v[j].z * v[j].z + v[j].w * v[j].w); q += (w[j].x * w[j].x + w[j].y * w[j].y) + (w[j].z * w[j].z + w[j].w * w[j].w); }
    const float rs = rsqrtf(wave_sum(s) * (1.f / DM) + EPS), rq = rsqrtf(wave_sum(q) * (1.f / DM) + EPS);
#pragma unroll
    for (int j = 0; j < 8; ++j) { const f32x4 g = *(const f32x4*)(gain + 4 * (lane + 64 * j));
        v2u a; a.x = pk2(v[j].x * rs * g.x, v[j].y * rs * g.y); a.y = pk2(v[j].z * rs * g.z, v[j].w * rs * g.w); *(v2u*)(o0 + 4 * (lane + 64 * j)) = a;
        v2u b; b.x = pk2(w[j].x * rq * g.x, w[j].y * rq * g.y); b.y = pk2(w[j].z * rq * g.z, w[j].w * rq * g.w); *(v2u*)(o1 + 4 * (lane + 64 * j)) = b; }
}
__device__ __forceinline__ void ssm_tables(const Args& a, int g, LAS unsigned char* lds, int tid) {
    LAS float* pw = (LAS float*)lds;
    LAS float* beta = pw + 64 * 17 * 2;
    LAS float* gam = beta + 64 * 16 * 2;
    LAS float* kt = gam + 16 * 64 * 2;
    unsigned char* ws = a.ws;
    if (tid < 64) {
        const int p = tid;
        const double dt = exp((double)a.log_dt[g]);
        const double are = (double)a.a_re[g * NP + p], aim = (double)a.a_im[g * NP + p];
        const double mag = exp(are * dt), ang = aim * dt;
        const double lr = mag * cos(ang), li = mag * sin(ang);
        const double den = are * are + aim * aim;
        const double cr = ((lr - 1.0) * are + li * aim) / den, ci = (li * are - (lr - 1.0) * aim) / den;
        double pr = 1.0, pi = 0.0;
        for (int d = 0; d <= CL; ++d) { pw[(p * 17 + d) * 2] = (float)pr; pw[(p * 17 + d) * 2 + 1] = (float)pi; const double nr = pr * lr - pi * li, ni = pr * li + pi * lr; pr = nr; pi = ni; }
        for (int c = 0; c < NC; ++c) { const double br = (double)a.b_re[(g * NP + p) * NC + c], bi = (double)a.b_im[(g * NP + p) * NC + c];
            beta[(p * 16 + c) * 2] = (float)(cr * br - ci * bi); beta[(p * 16 + c) * 2 + 1] = (float)(cr * bi + ci * br); }
        float* lamL = (float*)(ws + WS_LAML) + (g * NP + p) * 2;
        lamL[0] = pw[(p * 17 + CL) * 2]; lamL[1] = pw[(p * 17 + CL) * 2 + 1];
    }
    for (int idx = tid; idx < NC * NP; idx += NTHR) { gam[idx * 2] = a.c_re[g * NC * NP + idx]; gam[idx * 2 + 1] = a.c_im[g * NC * NP + idx]; }
    __syncthreads();
    for (int e = tid; e < CL * 256; e += NTHR) {
        const int d = e >> 8, c = (e >> 4) & 15, c2 = e & 15; float s = 0.f;
        for (int p = 0; p < NP; ++p) { const float gr = gam[(c * 64 + p) * 2], gi = gam[(c * 64 + p) * 2 + 1], wr_ = pw[(p * 17 + d) * 2], wi_ = pw[(p * 17 + d) * 2 + 1], br = beta[(p * 16 + c2) * 2], bi = beta[(p * 16 + c2) * 2 + 1];
            const float zr = gr * wr_ - gi * wi_, zi = gr * wi_ + gi * wr_; s += zr * br - zi * bi; }
        if (d == 0 && c == c2) s += a.ssm_d[g * NC + c];
        kt[e] = s;
    }
    __syncthreads();
    bf16* A3 = (bf16*)(ws + WS_A3) + (size_t)g * 256 * A3W;
    for (int cidx = tid; cidx < 256 * (A3W / 8); cidx += NTHR) {
        const int row = cidx / (A3W / 8), cc = cidx % (A3W / 8), i = row >> 4, c = row & 15; float v[8];
        if (cc < 32) { const int j = cc >> 1, c0 = (cc & 1) * 8;
#pragma unroll
            for (int e = 0; e < 8; ++e) v[e] = (j <= i) ? kt[((i - j) * 16 + c) * 16 + c0 + e] : 0.f;
        } else { const int pidx0 = (cc - 32) * 8, part = pidx0 >> 6, p0 = pidx0 & 63;
#pragma unroll
            for (int e = 0; e < 8; ++e) { const int p = p0 + e; const float gr = gam[(c * 64 + p) * 2], gi = gam[(c * 64 + p) * 2 + 1], wr_ = pw[(p * 17 + i + 1) * 2], wi_ = pw[(p * 17 + i + 1) * 2 + 1];
                v[e] = part ? -(gr * wi_ + gi * wr_) : (gr * wr_ - gi * wi_); }
        }
        v4u o; o.x = pk2(v[0], v[1]); o.y = pk2(v[2], v[3]); o.z = pk2(v[4], v[5]); o.w = pk2(v[6], v[7]);
        *(v4u*)(A3 + ((((size_t)(row >> 5)) * 24 + (cc >> 1)) * 64 + ((cc & 1) * 32 + (row & 31))) * 8) = o;
    }
    bf16* WTt = (bf16*)(ws + WS_WT) + (size_t)g * 128 * 256;
    for (int cidx = tid; cidx < 128 * 32; cidx += NTHR) {
        const int row = cidx >> 5, cc = cidx & 31, part = row >> 6, p = row & 63, j = cc >> 1, c0 = (cc & 1) * 8; float v[8];
        const float wr_ = pw[(p * 17 + (CL - 1 - j)) * 2], wi_ = pw[(p * 17 + (CL - 1 - j)) * 2 + 1];
#pragma unroll
        for (int e = 0; e < 8; ++e) { const float br = beta[(p * 16 + c0 + e) * 2], bi = beta[(p * 16 + c0 + e) * 2 + 1]; v[e] = part ? (wr_ * bi + wi_ * br) : (wr_ * br - wi_ * bi); }
        v4u o; o.x = pk2(v[0], v[1]); o.y = pk2(v[2], v[3]); o.z = pk2(v[4], v[5]); o.w = pk2(v[6], v[7]);
        *(v4u*)(WTt + ((((size_t)(row >> 5)) * 16 + (cc >> 1)) * 64 + ((cc & 1) * 32 + (row & 31))) * 8) = o;
    }
    __syncthreads();
}

__device__ __forceinline__ unsigned voff_b(int row, int ch) { return 256u * row + 16u * (ch ^ (((row & 3) << 2) | ((row >> 2) & 3))); }
__device__ __forceinline__ v4i16_t trrd(LAS unsigned char* p) { return __builtin_amdgcn_ds_read_tr16_b64_v4i16((LAS v4i16_t*)p); }
__device__ __forceinline__ void attn_wave_tile(const bf16* qkvu, bf16* opart, float* lse, int b, int h, int tile, LAS unsigned char* vl, int lane) {
    asm volatile("" : "+v"(lane));
    const int g = h >> 2, dl = 2 * g;
    const int tps = (SEQ >> dl) >> 5, res = tile / tps, m0 = (tile % tps) * 32;
    const int r32 = lane & 31, hi = lane >> 5;
    const float sl2 = exp2f(-8.0f * (float)(h + 1) / 12.0f) * LOG2E * (float)(1 << dl);
    const float sc2 = LOG2E * 0.08838834764831845f;
    const bf16* base = qkvu + (size_t)(b * SEQ + res) * LDQ + h * HD;
    const bf16* qrow = base + ((size_t)(m0 + r32) << dl) * LDQ;
    LAS unsigned char* kl = vl + 8192;
    const int lrow = lane >> 4, lch = lane & 15;
    v4u kst[8];
#pragma unroll
    for (int it = 0; it < 8; ++it) kst[it] = *(const v4u*)(base + ((size_t)(m0 + it * 4 + lrow) << dl) * LDQ + lch * 8);
#pragma unroll
    for (int it = 0; it < 8; ++it) *(LAS v4u*)(kl + voff_b(it * 4 + lrow, lch)) = kst[it];
    bf16x8 qf[8];
#pragma unroll
    for (int kk = 0; kk < 8; ++kk) qf[kk] = *(LAS bf16x8*)(kl + voff_b(r32, 2 * kk + hi));
    int Ld = r32 - 4 * hi; asm volatile("" : "+v"(Ld));
    const float bl = -sl2 * (float)Ld;
#define ATT_KLOAD(kt_) do { _Pragma("unroll") for (int it = 0; it < 8; ++it) { int kidx_ = m0 - 128 + 32 * (kt_) + it * 4 + lrow; kidx_ = kidx_ < 0 ? 0 : kidx_; \
        kst[it] = *(const v4u*)((const char*)base + (unsigned)(((unsigned)kidx_ << dl) * (unsigned)(LDQ * 2) + (unsigned)(2 * HQ) + (unsigned)(lch * 16))); } } while (0)
    ATT_KLOAD(0);
    f32x16 S[5];
    float mx = -INFINITY;
#pragma unroll
    for (int kt = 0; kt < 5; ++kt) {
#pragma unroll
        for (int it = 0; it < 8; ++it) *(LAS v4u*)(kl + voff_b(it * 4 + lrow, lch)) = kst[it];
        if (kt < 4) ATT_KLOAD(kt + 1);
        __builtin_amdgcn_sched_barrier(0);
        f32x16 s = {};
#pragma unroll
        for (int kk = 0; kk < 8; ++kk) { const bf16x8 kf = *(LAS bf16x8*)(kl + voff_b(r32, 2 * kk + hi)); s = MFMA32(kf, qf[kk], s); }
        const bool tneg = (m0 - 128 + 32 * kt) < 0;
#pragma unroll
        for (int r = 0; r < 16; ++r) { const int C = 128 - 32 * kt - ((r & 3) + 8 * (r >> 2));
            float v = fmaf(s[r], sc2, bl) - sl2 * (float)C;
            if (kt == 0) v = (C + Ld > 128) ? -INFINITY : v;
            if (kt == 4) v = (C + Ld < 0) ? -INFINITY : v;
            if (kt < 4) v = tneg ? -INFINITY : v;
            s[r] = v; mx = fmaxf(mx, v); }
        S[kt] = s;
        __builtin_amdgcn_sched_barrier(0);
    }
#undef ATT_KLOAD
    v4u vst[2][8];
#define ATT_VLOAD(buf, kt_) do { _Pragma("unroll") for (int it = 0; it < 8; ++it) { int vidx_ = m0 - 128 + 32 * (kt_) + it * 4 + (lane >> 4); vidx_ = vidx_ < 0 ? 0 : vidx_; \
        vst[buf][it] = *(const v4u*)((const char*)base + (unsigned)(((unsigned)vidx_ << dl) * (unsigned)(LDQ * 2) + (unsigned)(4 * HQ) + (unsigned)((lane & 15) * 16))); } } while (0)
    ATT_VLOAD(0, 0); ATT_VLOAD(1, 1);
    __builtin_amdgcn_sched_barrier(0);
    mx = fmaxf(mx, __shfl_xor(mx, 32));
    float l = 0.f;
    v4u Pp[5][2];
#pragma unroll
    for (int kt = 0; kt < 5; ++kt) {
#pragma unroll
        for (int r = 0; r < 16; ++r) { const float p = __builtin_amdgcn_exp2f(S[kt][r] - mx); S[kt][r] = p; l += p; }
#pragma unroll
        for (int s = 0; s < 2; ++s) { Pp[kt][s].x = pk2(S[kt][8 * s + 0], S[kt][8 * s + 1]); Pp[kt][s].y = pk2(S[kt][8 * s + 2], S[kt][8 * s + 3]); Pp[kt][s].z = pk2(S[kt][8 * s + 4], S[kt][8 * s + 5]); Pp[kt][s].w = pk2(S[kt][8 * s + 6], S[kt][8 * s + 7]); }
    }
    l += __shfl_xor(l, 32);
    f32x16 O[4];
#pragma unroll
    for (int dv = 0; dv < 4; ++dv) O[dv] = (f32x16){};
    const int q4 = (lane & 15) >> 2, p4 = lane & 3, blk = (lane >> 4) & 1;
#pragma unroll
    for (int kt = 0; kt < 5; ++kt) {
#pragma unroll
        for (int it = 0; it < 8; ++it) { const int row = it * 4 + (lane >> 4); *(LAS v4u*)(vl + voff_b(row, lane & 15)) = vst[kt & 1][it]; }
        if (kt < 3) ATT_VLOAD(kt & 1, kt + 2);
        __builtin_amdgcn_sched_barrier(0);
#pragma unroll
        for (int s = 0; s < 2; ++s) {
            const bf16x8 pf = __builtin_bit_cast(bf16x8, Pp[kt][s]);
#pragma unroll
            for (int dv = 0; dv < 4; ++dv) {
                const int c = 4 * dv + 2 * blk + (p4 >> 1);
                const v4i16_t lo = trrd(vl + voff_b(16 * s + 4 * hi + q4, c) + 8 * (p4 & 1));
                const v4i16_t hh = trrd(vl + voff_b(16 * s + 8 + 4 * hi + q4, c) + 8 * (p4 & 1));
                const bf16x8 vf = __builtin_shufflevector(lo, hh, 0, 1, 2, 3, 4, 5, 6, 7);
                O[dv] = MFMA32(vf, pf, O[dv]);
            }
        }
        __builtin_amdgcn_sched_barrier(0);
    }
#undef ATT_VLOAD
    const float inv = 1.0f / l;
    const size_t tok = (size_t)b * SEQ + ((size_t)(m0 + r32) << dl) + res;
#pragma unroll
    for (int dv = 0; dv < 4; ++dv)
#pragma unroll
        for (int gq = 0; gq < 4; ++gq) { v2u o; o.x = pk2(O[dv][4 * gq] * inv, O[dv][4 * gq + 1] * inv); o.y = pk2(O[dv][4 * gq + 2] * inv, O[dv][4 * gq + 3] * inv);
            *(LAS v2u*)(vl + voff_b(r32, 4 * dv + gq) + 8 * hi) = o; }
#pragma unroll
    for (int it = 0; it < 8; ++it) { const int row = it * 4 + (lane >> 4); const v4u v = *(LAS v4u*)(vl + voff_b(row, lane & 15));
        const size_t tk = (size_t)b * SEQ + ((size_t)(m0 + row) << dl) + res;
        *(v4u*)(opart + (tk * NH + h) * HD + (lane & 15) * 8) = v; }
    if (hi == 0) lse[tok * NH + h] = mx + __log2f(l);
}

__device__ __forceinline__ void ssm_estate_unit(const bf16* ubuf, const bf16* WTt, float* E, LAS unsigned char* el, int g, int b, int nt, int lane) {
    const int r32 = lane & 31, hi = lane >> 5, chunk = 32 * nt + r32;
    const bf16* up = ubuf + ((((size_t)(b * NG + g)) * 16 + nt) * 16 * 32 + r32) * NC + 8 * hi;
    const bf16* wp = WTt + ((size_t)g * 4 * 16 * 64 + lane) * 8;
    f32x16 acc[4];
#pragma unroll
    for (int mt = 0; mt < 4; ++mt) acc[mt] = (f32x16){};
#pragma unroll 8
    for (int j = 0; j < CL; ++j) {
        const bf16x8 bf = *(const bf16x8*)(up + j * 512);
#pragma unroll
        for (int mt = 0; mt < 4; ++mt) { const bf16x8 af = *(const bf16x8*)(wp + (mt * 16 + j) * 512); acc[mt] = MFMA32(af, bf, acc[mt]); }
    }
#pragma unroll
    for (int mt = 0; mt < 4; ++mt)
#pragma unroll
        for (int gq = 0; gq < 4; ++gq) *(LAS f32x4*)(el + r32 * 512 + (((8 * mt + 2 * gq + hi) ^ r32) * 16)) = (f32x4){acc[mt][4 * gq], acc[mt][4 * gq + 1], acc[mt][4 * gq + 2], acc[mt][4 * gq + 3]};
    float* ep = E + (((size_t)(b * NG + g)) * NCHUNK + 32 * nt) * 128;
#pragma unroll
    for (int it = 0; it < 16; ++it) { const int id = it * 64 + lane, n = id >> 5, pc = id & 31; const f32x4 v = *(LAS f32x4*)(el + id * 16); *(f32x4*)(ep + n * 128 + ((pc ^ n) * 4)) = v; }
}
template <int mg> __device__ __forceinline__ void ssm_out_unit(const bf16* ubuf, const bf16* A3, const bf16* HB, LAS unsigned char* yt, int wave, int g, int b, int nt, int lane) {
    const int r32 = lane & 31, hi = lane >> 5, chunk = 32 * nt + r32;
    const bf16* up = ubuf + ((((size_t)(b * NG + g)) * 16 + nt) * 16 * 32 + r32) * NC + 8 * hi;
    const bf16* hp = HB + ((((size_t)(b * NG + g)) * 16 + nt) * 8 * 32 + r32) * 16 + 8 * hi;
    const bf16* ap = A3 + (((size_t)(g * 8 + 4 * mg)) * 24 * 64 + lane) * 8;
    f32x16 acc[4];
#pragma unroll
    for (int mt = 0; mt < 4; ++mt) acc[mt] = (f32x16){};
    constexpr int jmax = 8 * mg + 8;
#pragma unroll 8
    for (int j = 0; j < jmax; ++j) {
        const bf16x8 bf = *(const bf16x8*)(up + j * 512);
#pragma unroll
        for (int mt = 0; mt < 4; ++mt) { const bf16x8 af = *(const bf16x8*)(ap + (mt * 24 + j) * 512); acc[mt] = MFMA32(af, bf, acc[mt]); }
    }
#pragma unroll 8
    for (int ks = 0; ks < 8; ++ks) {
        const bf16x8 bf = *(const bf16x8*)(hp + ks * 512);
#pragma unroll
        for (int mt = 0; mt < 4; ++mt) { const bf16x8 af = *(const bf16x8*)(ap + (mt * 24 + 16 + ks) * 512); acc[mt] = MFMA32(af, bf, acc[mt]); }
    }
#pragma unroll
    for (int mt = 0; mt < 4; ++mt)
#pragma unroll
        for (int gq = 0; gq < 4; ++gq) {
            const int il = 2 * mt + (gq >> 1), ch = (wave * 2 + (gq & 1)) ^ (r32 & 15);
            v2u o; o.x = pk2(gelu_tanh(acc[mt][4 * gq]), gelu_tanh(acc[mt][4 * gq + 1])); o.y = pk2(gelu_tanh(acc[mt][4 * gq + 2]), gelu_tanh(acc[mt][4 * gq + 3]));
            *(LAS v2u*)(yt + (r32 * 8 + il) * 256 + ch * 16 + 8 * hi) = o;
        }
}

template <int NR> __device__ __forceinline__ void norm1_rows(const float* x, const bf16* o, const float* gpost, const float* gpre, float* x1, bf16* h2, int m, int mstep, int lane) {
    f32x4 v[NR][8], xv[NR][8]; float s[NR], s1[NR];
#pragma unroll
    for (int r = 0; r < NR; ++r) { const size_t row = (size_t)(m + r * mstep);
#pragma unroll
        for (int j = 0; j < 4; ++j) { const v4u w = __builtin_nontemporal_load((const v4u*)(o + row * LDH + 8 * (lane + 64 * j)));
            v[r][2 * j] = (f32x4){bflo(w.x), bfhi(w.x), bflo(w.y), bfhi(w.y)}; v[r][2 * j + 1] = (f32x4){bflo(w.z), bfhi(w.z), bflo(w.w), bfhi(w.w)}; }
#pragma unroll
        for (int j = 0; j < 8; ++j) xv[r][j] = __builtin_nontemporal_load((const f32x4*)(x + row * DM + 8 * (lane + 64 * (j >> 1)) + 4 * (j & 1))); }
#pragma unroll
    for (int r = 0; r < NR; ++r) { s[r] = 0.f;
#pragma unroll
        for (int j = 0; j < 8; ++j) s[r] += (v[r][j].x * v[r][j].x + v[r][j].y * v[r][j].y) + (v[r][j].z * v[r][j].z + v[r][j].w * v[r][j].w); }
#pragma unroll
    for (int r = 0; r < NR; ++r) { const size_t row = (size_t)(m + r * mstep); const float rstd = rsqrtf(wave_sum(s[r]) * (1.f / DM) + EPS); s1[r] = 0.f;
#pragma unroll
        for (int j = 0; j < 8; ++j) { const int e0 = 8 * (lane + 64 * (j >> 1)) + 4 * (j & 1); const f32x4 gv = *(const f32x4*)(gpost + e0);
            v[r][j] = xv[r][j] + v[r][j] * rstd * gv; s1[r] += (v[r][j].x * v[r][j].x + v[r][j].y * v[r][j].y) + (v[r][j].z * v[r][j].z + v[r][j].w * v[r][j].w); *(f32x4*)(x1 + row * DM + e0) = v[r][j]; } }
#pragma unroll
    for (int r = 0; r < NR; ++r) { const size_t row = (size_t)(m + r * mstep); const float rstd1 = rsqrtf(wave_sum(s1[r]) * (1.f / DM) + EPS);
#pragma unroll
        for (int j = 0; j < 4; ++j) { const int e0 = 8 * (lane + 64 * j); const f32x4 g0 = *(const f32x4*)(gpre + e0), g1 = *(const f32x4*)(gpre + e0 + 4);
            const f32x4 a = v[r][2 * j] * rstd1 * g0, c = v[r][2 * j + 1] * rstd1 * g1; v4u ov; ov.x = pk2(a.x, a.y); ov.y = pk2(a.z, a.w); ov.z = pk2(c.x, c.y); ov.w = pk2(c.z, c.w);
            *(v4u*)(h2 + row * LDH + e0) = ov; } }
}
template <int NR> __device__ __forceinline__ void norm2_rows(const bf16* f, const float* gpost, float* out, int m, int mstep, int lane) {
    f32x4 v[NR][8], xv[NR][8]; float s[NR];
#pragma unroll
    for (int r = 0; r < NR; ++r) { const size_t row = (size_t)(m + r * mstep);
#pragma unroll
        for (int j = 0; j < 4; ++j) { const v4u w = __builtin_nontemporal_load((const v4u*)(f + row * LDH + 8 * (lane + 64 * j)));
            v[r][2 * j] = (f32x4){bflo(w.x), bfhi(w.x), bflo(w.y), bfhi(w.y)}; v[r][2 * j + 1] = (f32x4){bflo(w.z), bfhi(w.z), bflo(w.w), bfhi(w.w)}; }
#pragma unroll
        for (int j = 0; j < 8; ++j) xv[r][j] = *(const f32x4*)(out + row * DM + 8 * (lane + 64 * (j >> 1)) + 4 * (j & 1)); }
#pragma unroll
    for (int r = 0; r < NR; ++r) { s[r] = 0.f;
#pragma unroll
        for (int j = 0; j < 8; ++j) s[r] += (v[r][j].x * v[r][j].x + v[r][j].y * v[r][j].y) + (v[r][j].z * v[r][j].z + v[r][j].w * v[r][j].w); }
#pragma unroll
    for (int r = 0; r < NR; ++r) { const size_t row = (size_t)(m + r * mstep); const float rstd = rsqrtf(wave_sum(s[r]) * (1.f / DM) + EPS);
#pragma unroll
        for (int j = 0; j < 8; ++j) { const int e0 = 8 * (lane + 64 * (j >> 1)) + 4 * (j & 1); const f32x4 gv = *(const f32x4*)(gpost + e0);
            __builtin_nontemporal_store(xv[r][j] + v[r][j] * rstd * gv, (f32x4*)(out + row * DM + e0)); } }
}

#define XB_TMO      128
#define XB_XCNT(j)  (256  + 64 * (j))
#define XB_XSUB(j)  (1280 + 64 * (j))
#define XB_XGEN(j)  (2304 + 64 * (j))
#define XB_TOP      3328
#define XB_TOPGEN   3392
#define XCD_BAR_WORDS 3456
#define XB_SPIN_CAP (1u << 18)

__device__ __forceinline__ unsigned xb_ld(unsigned* p)              { return __hip_atomic_load(p, __ATOMIC_RELAXED, __HIP_MEMORY_SCOPE_AGENT); }
__device__ __forceinline__ unsigned xb_add(unsigned* p, unsigned v) { return __hip_atomic_fetch_add(p, v, __ATOMIC_RELAXED, __HIP_MEMORY_SCOPE_AGENT); }
__device__ __forceinline__ unsigned xb_xcc_id() { return (unsigned)__builtin_amdgcn_s_getreg((3 << 11) | 20) & 0xFu; }
#define XB_SPIN(cond, bar) do { unsigned _sp = 0; while (cond) { __builtin_amdgcn_s_sleep(1); \
    if ((++_sp & 255u) == 0u) { if (xb_ld(&(bar)[XB_TMO])) break; if (_sp > XB_SPIN_CAP) { atomicAdd(&(bar)[XB_TMO], 1u); break; } } } } while (0)

struct XcdBarrier {
    unsigned* bar; unsigned x;
    volatile LAS unsigned* st;
};

__device__ __forceinline__ XcdBarrier xcd_barrier_post(unsigned* bar, volatile LAS unsigned* st) {
    XcdBarrier b; b.bar = bar; b.x = xb_xcc_id(); b.st = st;
    if (threadIdx.x == 0) (void)xb_add(&bar[XB_XCNT(b.x)], 1u);
    return b;
}
__device__ __forceinline__ void xcd_barrier_complete(unsigned* bar, unsigned x, unsigned& nloc, unsigned& nx) {
    const unsigned G = gridDim.x * gridDim.y * gridDim.z;
    unsigned sum, cnt, mine, sp = 0u;
    for (;;) {
        sum = 0u; cnt = 0u; mine = 0u;
#pragma unroll
        for (unsigned j = 0; j < 16; ++j) { const unsigned c = xb_ld(&bar[XB_XCNT(j)]); sum += c; cnt += (c > 0u) ? 1u : 0u; mine = (j == x) ? c : mine; }
        if (sum == G) break;
        __builtin_amdgcn_s_sleep(1);
        if ((++sp & 255u) == 0u) { if (xb_ld(&bar[XB_TMO])) break; if (sp > XB_SPIN_CAP) { atomicAdd(&bar[XB_TMO], 1u); break; } }
    }
    nloc = mine > 0u ? mine : 1u; nx = cnt > 0u ? cnt : 1u;
}

__device__ __forceinline__ void xcd_barrier(const XcdBarrier& b) {
    asm volatile("s_waitcnt vmcnt(0)" ::: "memory");
    __syncthreads();
    if (threadIdx.x == 0) {
        unsigned* bar = b.bar;
        __builtin_amdgcn_s_waitcnt(0);
        unsigned nloc = b.st[0], nx = b.st[1];
        if (nloc == 0u) { xcd_barrier_complete(bar, b.x, nloc, nx); b.st[0] = nloc; b.st[1] = nx; }
        const unsigned old = xb_add(&bar[XB_XSUB(b.x)], 1u);
        const unsigned gen = old / nloc;
        if (old + 1u == (gen + 1u) * nloc) {
            __builtin_amdgcn_fence(__ATOMIC_RELEASE, "agent");
            asm volatile("s_waitcnt vmcnt(0)" ::: "memory");
            const unsigned og = xb_add(&bar[XB_TOP], 1u);
            const unsigned tg = og / nx;
            if (og + 1u == (tg + 1u) * nx) xb_add(&bar[XB_TOPGEN], 1u);
            else XB_SPIN(xb_ld(&bar[XB_TOPGEN]) == tg, bar);
            __builtin_amdgcn_fence(__ATOMIC_ACQUIRE, "agent");
            xb_add(&bar[XB_XGEN(b.x)], 1u);
            asm volatile("s_waitcnt vmcnt(0)" ::: "memory");
        } else {
            XB_SPIN(xb_ld(&bar[XB_XGEN(b.x)]) == gen, bar);
            __builtin_amdgcn_fence(__ATOMIC_ACQUIRE, "agent");
            asm volatile("s_waitcnt vmcnt(0)" ::: "memory");
        }
    }
    __syncthreads();
}

#ifndef PH_SKIP
#define PH_SKIP 0
#endif
#define PH_ON(k) (((PH_SKIP) >> (k)) & 1) == 0
#ifndef PH_DUP
#define PH_DUP 0
#endif
#define PH_REP(k) for (int rep_ = 0; rep_ < 1 + (((PH_DUP) >> (k)) & 1); ++rep_)

__global__ void __launch_bounds__(NTHR, 2) mega_fwd(Args a) {
    extern __shared__ __attribute__((aligned(16))) unsigned char lds_raw[];
    cg::grid_group grid = cg::this_grid();
    LAS unsigned char* lds = (LAS unsigned char*)lds_raw;
    const int G = gridDim.x, bx = blockIdx.x, NGW = G * NWAVES;
#define PH_IDS int tid = threadIdx.x; asm volatile("" : "+v"(tid)); const int lane = tid & 63; const int wave = __builtin_amdgcn_readfirstlane(tid >> 6); const int gw = bx * NWAVES + wave; (void)lane; (void)gw; (void)wave;
    unsigned char* ws = a.ws;
    {
        for (int u = threadIdx.x; u < (LDS_BYTES - RING_BYTES) / 4; u += NTHR) ((LAS unsigned*)(lds + RING_BYTES))[u] = 0u;
        __syncthreads();
    }
    const XcdBarrier xbar = xcd_barrier_post((unsigned*)(ws + WS_BAR), (volatile LAS unsigned*)(lds + RING_BYTES + 320 + 32));
#define SEAM() xcd_barrier(xbar)
    bf16* Win_t = (bf16*)(ws + WS_WIN); bf16* Wup_t = (bf16*)(ws + WS_WUP); bf16* Wglu_t = (bf16*)(ws + WS_WGLU); bf16* Wout_t = (bf16*)(ws + WS_WOUT);
    bf16* Wffn_t = (bf16*)(ws + WS_WFFN); bf16* Wdown_t = (bf16*)(ws + WS_WDOWN);
    bf16* qkvu = (bf16*)(ws + WS_RA); bf16* ubuf = (bf16*)(ws + WS_UB); bf16* obuf = (bf16*)(ws + WS_RA); bf16* act = (bf16*)(ws + WS_RA);
    bf16* hbuf = (bf16*)(ws + WS_RH); bf16* attn = (bf16*)(ws + WS_ATTN); bf16* ybuf = (bf16*)(ws + WS_Y); bf16* h2 = (bf16*)(ws + WS_RH);
    bf16* opart = (bf16*)(ws + WS_OPART); float* lse = (float*)(ws + WS_LSE); float* Ebuf = (float*)(ws + WS_E); bf16* HB = (bf16*)(ws + WS_HB);
    bf16* msbuf = (bf16*)(ws + WS_RF); bf16* fbuf = (bf16*)(ws + WS_RF);
    bf16* gates = (bf16*)a.out;

    if (PH_ON(0)) PH_REP(0) {
        PH_IDS
        for (int i = bx * NTHR + tid; i < T; i += G * NTHR) { ((float*)(ws + WS_ROWSS))[i] = 0.f; ((float*)(ws + WS_ROWSS1))[i] = 0.f; ((float*)(ws + WS_ROWSS2))[i] = 0.f;
            if (i < 64 * 64) { ((unsigned*)(ws + WS_PCNT))[i] = 0u; ((unsigned*)(ws + WS_PCNT1))[i] = 0u; ((unsigned*)(ws + WS_PCNT2))[i] = 0u; } }
        LAS float* scr = (LAS float*)(lds + wave * 16384);
        constexpr int I_IN = (DM / 64) * (INW / 32), I_UP = (AOW / 64) * (DM / 32), I_GLU = (SSMW / 64) * (DM / 32), I_OUT = (DM / 64) * (DM / 32), I_FFN = (DM / 64) * (DFF / 32), I_DN = (DFF / 64) * (DM / 32);
        constexpr int NITEMS = I_IN;
#define P0_ITEM(t, it_) do { t = tr_make(a.w_in, DM, INW, Win_t, 0, (it_)); } while (0)
        for (int it = gw; it < NITEMS; it += 2 * NGW) {
            TrItem t0, t1; float w0[32], w1[32];
            const bool two = it + NGW < NITEMS;
            P0_ITEM(t0, it); tr_load(t0, w0, lane);
            if (two) { P0_ITEM(t1, it + NGW); tr_load(t1, w1, lane); }
            tr_finish(t0, w0, scr, lane);
            if (two) tr_finish(t1, w1, scr, lane);
        }
#undef P0_ITEM
        for (int m = gw; m < T; m += 2 * NGW) rms_row2_to_bf16(a.x + (size_t)m * DM, a.x + (size_t)(m + NGW) * DM, a.norm_mix_pre, hbuf + (size_t)m * LDH, hbuf + (size_t)(m + NGW) * LDH, lane);
    }
    grid.sync();

    if (PH_ON(1)) {
        pg8::Gemm g{hbuf, Win_t, T, INW, DM, LDH, LDH}; pg8::StaticOrder S; S.init(T, INW, G, bx, 1 + (((PH_DUP) >> 1) & 1));
        pg8::EpiIn E{qkvu, ubuf, gates};
        pg8::gemm_phase<pg8::EpiIn, pg8::StaticOrder, PG8_ALIGN, PG8_SP2>(lds, g, S, E);
        if (bx >= G / 2) {
            PH_IDS
            LAS float* scr = (LAS float*)(lds + wave * 16384);
            constexpr int I_FFN = (DM / 64) * (DFF / 32);
            constexpr int I_DN2 = (DFF / 64) * (DM / 32), I_UP2 = (AOW / 64) * (DM / 32), I_GLU2 = (SSMW / 64) * (DM / 32), I_OUT2 = (DM / 64) * (DM / 32);
            for (int it = (bx - G / 2) * NWAVES + wave; it < 2 * I_FFN + I_DN2 + I_UP2 + 2 * I_GLU2 + I_OUT2; it += (G - G / 2) * NWAVES) {
                int r = it;
                if (r < I_UP2) { p0_transpose(a.w_attn_up, AOW, DM, Wup_t, 0, r, scr, lane); continue; } r -= I_UP2;
                if (r < I_GLU2) { p0_transpose(a.w_glu_v, SSMW, DM, Wglu_t, 1, r, scr, lane); continue; } r -= I_GLU2;
                if (r < I_GLU2) { p0_transpose(a.w_glu_g, SSMW, DM, Wglu_t, 2, r, scr, lane); continue; } r -= I_GLU2;
                if (r < I_OUT2) { p0_transpose(a.w_out, DM, DM, Wout_t, 0, r, scr, lane); continue; } r -= I_OUT2;
                if (r < I_FFN) { p0_transpose(a.w_ffn_gate, DM, DFF, Wffn_t, 1, r, scr, lane, a.norm_ffn_pre); continue; } r -= I_FFN;
                if (r < I_FFN) { p0_transpose(a.w_ffn_up, DM, DFF, Wffn_t, 2, r, scr, lane, a.norm_ffn_pre); continue; } r -= I_FFN;
                p0_transpose(a.w_ffn_down, DFF, DM, Wdown_t, 0, r, scr, lane);
            }
            __syncthreads();
            if (bx >= G - NG) ssm_tables(a, bx - (G - NG), lds, tid);
        }
    }
    SEAM();

    if (PH_ON(2)) PH_REP(2) {
        PH_IDS
        LAS unsigned char* vl = lds + wave * 16384;
        PH_REP(12) for (int w = gw; w < BATCH * NH * (SEQ / 32); w += NGW) {
            const int bh = w / (SEQ / 32), tile = w % (SEQ / 32);
            attn_wave_tile(qkvu, opart, lse, bh / NH, bh % NH, tile, vl, lane);
        }
        PH_REP(13) for (int w = gw; w < NG * BATCH * (NCHUNK / 32); w += NGW) {
            const int g = w / (BATCH * (NCHUNK / 32)), r = w % (BATCH * (NCHUNK / 32));
            ssm_estate_unit(ubuf, (const bf16*)(ws + WS_WT), Ebuf, vl, g, r / (NCHUNK / 32), r % (NCHUNK / 32), lane);
        }
    }
    SEAM();

    if (PH_ON(3)) PH_REP(3) {
        PH_IDS
        for (int u = bx; u < BATCH * NG * 2; u += G) {
            const int b = u >> 7, g = (u >> 1) & 63, p = (u & 1) * 32 + (tid & 31), seg = tid >> 5;
            const float lr = ((const float*)(ws + WS_LAML))[(g * NP + p) * 2], li = ((const float*)(ws + WS_LAML))[(g * NP + p) * 2 + 1];
            const size_t base = (((size_t)(b * NG + g)) * NCHUNK + 32 * seg) * 128 + p;
            const size_t hbase = (((((size_t)(b * NG + g)) * 16 + seg) * 8 + (p >> 4)) * 32) * 16 + (p & 15);
            float er[32], ei[32];
#pragma unroll
            for (int k = 0; k < 32; ++k) { er[k] = Ebuf[base + (size_t)k * 128]; ei[k] = Ebuf[base + (size_t)k * 128 + 64]; }
            float hr = 0.f, hi_ = 0.f;
#pragma unroll
            for (int k = 0; k < 32; ++k) { const float nr = lr * hr - li * hi_ + er[k], ni = lr * hi_ + li * hr + ei[k]; hr = nr; hi_ = ni; }
            LAS float* se = (LAS float*)lds;
            se[(seg * 32 + (tid & 31)) * 2] = hr; se[(seg * 32 + (tid & 31)) * 2 + 1] = hi_;
            float pr = lr, pi = li;
#pragma unroll
            for (int q = 0; q < 5; ++q) { const float nr = pr * pr - pi * pi, ni = 2.f * pr * pi; pr = nr; pi = ni; }
            __syncthreads();
            hr = 0.f; hi_ = 0.f;
            for (int s2 = 0; s2 < seg; ++s2) { const float sr = se[(s2 * 32 + (tid & 31)) * 2], si = se[(s2 * 32 + (tid & 31)) * 2 + 1]; const float nr = pr * hr - pi * hi_ + sr, ni = pr * hi_ + pi * hr + si; hr = nr; hi_ = ni; }
#pragma unroll
            for (int k = 0; k < 32; ++k) {
                HB[hbase + k * 16] = (bf16)(pk2(hr, 0.f) & 0xffffu); HB[hbase + 4 * 512 + k * 16] = (bf16)(pk2(hi_, 0.f) & 0xffffu);
                const float nr = lr * hr - li * hi_ + er[k], ni = lr * hi_ + li * hr + ei[k]; hr = nr; hi_ = ni;
            }
            __syncthreads();
        }
        for (size_t idx = (size_t)bx * NTHR + tid; idx < (size_t)T * 64; idx += (size_t)G * NTHR) {
            const size_t tok = idx >> 6; const int j = (int)(idx >> 4) & 3, ch = (int)idx & 15;
            const float l0 = lse[tok * NH + j], l1 = lse[tok * NH + 4 + j], l2 = lse[tok * NH + 8 + j];
            const float m = fmaxf(l0, fmaxf(l1, l2));
            float w0 = __builtin_amdgcn_exp2f(l0 - m), w1 = __builtin_amdgcn_exp2f(l1 - m), w2 = __builtin_amdgcn_exp2f(l2 - m);
            const float inv = 1.0f / (w0 + w1 + w2); w0 *= inv; w1 *= inv; w2 *= inv;
            const v4u o0 = *(const v4u*)(opart + (tok * NH + j) * HD + ch * 8), o1 = *(const v4u*)(opart + (tok * NH + 4 + j) * HD + ch * 8), o2 = *(const v4u*)(opart + (tok * NH + 8 + j) * HD + ch * 8);
            v4u r;
            r.x = pk2(w0 * bflo(o0.x) + w1 * bflo(o1.x) + w2 * bflo(o2.x), w0 * bfhi(o0.x) + w1 * bfhi(o1.x) + w2 * bfhi(o2.x));
            r.y = pk2(w0 * bflo(o0.y) + w1 * bflo(o1.y) + w2 * bflo(o2.y), w0 * bfhi(o0.y) + w1 * bfhi(o1.y) + w2 * bfhi(o2.y));
            r.z = pk2(w0 * bflo(o0.z) + w1 * bflo(o1.z) + w2 * bflo(o2.z), w0 * bfhi(o0.z) + w1 * bfhi(o1.z) + w2 * bfhi(o2.z));
            r.w = pk2(w0 * bflo(o0.w) + w1 * bflo(o1.w) + w2 * bflo(o2.w), w0 * bfhi(o0.w) + w1 * bfhi(o1.w) + w2 * bfhi(o2.w));
            *(v4u*)(attn + tok * LDATT + j * HD + ch * 8) = r;
        }
    }
    SEAM();

    if (PH_ON(4)) PH_REP(4) {
        PH_IDS
        for (int bu = bx; bu < BATCH * (NCHUNK / 32) * 2 * (NG / 8); bu += G) {
            const int go = bu & 7, mg = (bu >> 3) & 1, nt = (bu >> 4) & 15, b = bu >> 8, g = go * 8 + wave;
            if (mg) ssm_out_unit<1>(ubuf, (const bf16*)(ws + WS_A3), HB, lds, wave, g, b, nt, lane);
            else ssm_out_unit<0>(ubuf, (const bf16*)(ws + WS_A3), HB, lds, wave, g, b, nt, lane);
            __syncthreads();
#pragma unroll
            for (int it = 0; it < 8; ++it) { const int id = it * NTHR + tid, row = id >> 4, ch = id & 15, n = row >> 3, il = row & 7;
                const v4u v = *(LAS v4u*)(lds + row * 256 + ((ch ^ (n & 15)) * 16));
                *(v4u*)(ybuf + (size_t)(b * SEQ + (32 * nt + n) * CL + 8 * mg + il) * LDY + go * 128 + ch * 8) = v; }
            __syncthreads();
        }
    }
    SEAM();

    if (PH_ON(5)) {
        pg8::Gemm g{ybuf, Wglu_t, T, 2 * DM, SSMW, LDY, LDY}; pg8::StaticOrder S; S.init(T, 2 * DM, G, bx, 1 + (((PH_DUP) >> 5) & 1));
        pg8::EpiGlu E{gates, msbuf};
        pg8::gemm_phase<pg8::EpiGlu, pg8::StaticOrder, PG8_ALIGN, PG8_SP2>(lds, g, S, E);
    }
    SEAM();

    if (PH_ON(6)) {
        pg8::Gemm g{attn, Wup_t, T, DM, AOW, LDATT, LDATT}; pg8::StaticOrder S; S.init(T, DM, G, bx);
        pg8::EpiMerge E{gates, msbuf};
        pg8::gemm_phase<pg8::EpiMerge, pg8::StaticOrder, PG8_ALIGN, PG8_SP2>(lds, g, S, E);
    }
    SEAM();

    if (PH_ON(7)) {
        pg8::Gemm g{msbuf, Wout_t, T, DM, DM, LDH, LDH}; pg8::PanelOrder S; S.init(G, bx);
        pg8::EpiNormMid E{a.x, (bf16*)(ws + WS_X1B), a.norm_mix_post, (float*)(ws + WS_ROWSS1), (unsigned*)(ws + WS_PCNT1), (float*)(ws + WS_ROWSS2)};
        pg8::gemm_phase<pg8::EpiNormMid, pg8::PanelOrder, PG8_ALIGN, PG8_SP2>(lds, g, S, E);
    }
    SEAM();

    if (PH_ON(9)) {
        pg8::Gemm g{(const bf16*)(ws + WS_X1B), Wffn_t, T, 2 * DFF, DM, DM, LDH}; pg8::StaticOrder S; S.init(T, 2 * DFF, G, bx, 1 + (((PH_DUP) >> 9) & 1));
        LAS float* rs = (LAS float*)(lds + RING_BYTES + 4096); const int rbase = (G == 256) ? (bx & 7) * 2048 : 0;
        for (int i = threadIdx.x; i < 2048; i += NTHR) rs[i] = rsqrtf(((const float*)(ws + WS_ROWSS2))[rbase + i] * (1.f / DM) + EPS);
        __syncthreads();
        pg8::EpiFfn E{act, (const float*)(ws + WS_ROWSS2), rs, rbase};
        pg8::gemm_phase<pg8::EpiFfn, pg8::StaticOrder, PG8_ALIGN, PG8_SP2>(lds, g, S, E);
    }
    SEAM();

    if (PH_ON(10)) {
        pg8::Gemm g{act, Wdown_t, T, DM, DFF, LDACT, LDACT}; pg8::PanelOrder S; S.init(G, bx);
        pg8::EpiNormOut E{a.out, (const bf16*)(ws + WS_X1B), a.norm_ffn_post, (float*)(ws + WS_ROWSS), (unsigned*)(ws + WS_PCNT)};
        pg8::gemm_phase<pg8::EpiNormOut, pg8::PanelOrder, PG8_ALIGN, PG8_SP2>(lds, g, S, E);
    }
}

extern "C" void kernel_launch(void* const* d_in, const int* in_sizes, int n_in, void* d_out, int out_size, void* d_ws, size_t ws_size, hipStream_t stream) {
    static int grid = 0;
    if (grid == 0) {
        if (n_in != 21 || in_sizes[0] != T * DM || out_size != T * DM || ws_size < WS_END) { fprintf(stderr, "kernel_launch: unexpected shapes (n_in %d, in0 %d, out %d, ws %zu < %zu); nothing launched\n", n_in, n_in > 0 ? in_sizes[0] : -1, out_size, ws_size, (size_t)WS_END); grid = -1; return; }
        int dev = 0, cus = 0, per_cu = 0;
        if (hipGetDevice(&dev) != hipSuccess || hipDeviceGetAttribute(&cus, hipDeviceAttributeMultiprocessorCount, dev) != hipSuccess) { grid = -1; return; }
        if (hipFuncSetAttribute((const void*)mega_fwd, hipFuncAttributeMaxDynamicSharedMemorySize, LDS_BYTES) != hipSuccess) { fprintf(stderr, "kernel_launch: hipFuncSetAttribute failed\n"); grid = -1; return; }
        if (hipOccupancyMaxActiveBlocksPerMultiprocessor(&per_cu, (const void*)mega_fwd, NTHR, LDS_BYTES) != hipSuccess || per_cu < 1) { fprintf(stderr, "kernel_launch: occupancy query reports %d blocks per CU; nothing launched\n", per_cu); (void)hipGetLastError(); grid = -1; return; }
        grid = cus;
    }
    if (grid < 0) return;
    Args a{};
    a.x = (const float*)d_in[0]; a.norm_mix_pre = (const float*)d_in[1]; a.w_in = (const float*)d_in[2]; a.w_attn_up = (const float*)d_in[3];
    a.a_re = (const float*)d_in[4]; a.a_im = (const float*)d_in[5]; a.log_dt = (const float*)d_in[6]; a.b_re = (const float*)d_in[7]; a.b_im = (const float*)d_in[8];
    a.c_re = (const float*)d_in[9]; a.c_im = (const float*)d_in[10]; a.ssm_d = (const float*)d_in[11];
    a.w_glu_v = (const float*)d_in[12]; a.w_glu_g = (const float*)d_in[13]; a.w_out = (const float*)d_in[14]; a.norm_mix_post = (const float*)d_in[15]; a.norm_ffn_pre = (const float*)d_in[16];
    a.w_ffn_gate = (const float*)d_in[17]; a.w_ffn_up = (const float*)d_in[18]; a.w_ffn_down = (const float*)d_in[19]; a.norm_ffn_post = (const float*)d_in[20];
    a.out = (float*)d_out; a.ws = (unsigned char*)d_ws;
    if (hipMemsetAsync((char*)d_ws + WS_BAR, 0, WS_BAR_BYTES, stream) != hipSuccess) { fprintf(stderr, "kernel_launch: hipMemsetAsync failed\n"); return; }
    void* args[] = {&a};
    const hipError_t e = hipLaunchCooperativeKernel((const void*)mega_fwd, dim3(grid), dim3(NTHR), args, LDS_BYTES, stream);
    if (e != hipSuccess) fprintf(stderr, "kernel_launch: cooperative launch failed: %s (grid %d)\n", hipGetErrorString(e), grid);
}
```
